# Optimizing an MI355X kernel written in HIP

```python
import jax, jax.numpy as jnp
from jax import lax
import numpy as np

D_MODEL = 1024
BATCH = 16
SEQ = 4096
DEPTH = 4
DEC_BATCH = 32
DEC_SEQ = 64
PAST_LEN = 2048

CHUNK = 64
N_A_LAYERS = DEPTH // 2
N_B_LAYERS = DEPTH - N_A_LAYERS
TOK_WIDTH = D_MODEL // 2
MEM_WIDTH = D_MODEL // 2
A_CHUNK = 128
A_GROUPS = 8
A_GROUP_DIM = TOK_WIDTH // A_GROUPS
B_HEADS = 8
B_HEAD_DIM = TOK_WIDTH // B_HEADS
B_LEFT_CHUNKS = 8
B_WINDOW = B_LEFT_CHUNKS * CHUNK
REL_CLIP = 256
N_REL = 2 * REL_CLIP + 1
CACHE_B_LEN = min(B_WINDOW, PAST_LEN)
N_MEM = 256
MEM_HEADS = 4
MEM_HEAD_DIM = MEM_WIDTH // MEM_HEADS
D_FF = 128 * ((8 * D_MODEL // 3 + 127) // 128)
CONV_W = 3
EPS = 1e-6
NEG_INF = -1e30

kernel_name = 'yoco_gmlp_chunkband_streaming_step'


def rmsnorm(x, g):
    xf = x.astype(jnp.float32)
    y = xf * lax.rsqrt(jnp.mean(xf * xf, axis=-1, keepdims=True) + EPS)
    return (y * g.astype(jnp.float32)).astype(x.dtype)


def spatial_gate(u, v, w_s, b_s):
    bsz, L, _ = v.shape
    n_chunks = -(-L // A_CHUNK)
    pad = n_chunks * A_CHUNK - L
    vp = jnp.pad(v, ((0, 0), (0, pad), (0, 0))).reshape(bsz, n_chunks, A_CHUNK, A_GROUPS, A_GROUP_DIM)
    mask = jnp.tril(jnp.ones((A_CHUNK, A_CHUNK), dtype=bool))
    w = jnp.where(mask[None], w_s, jnp.zeros_like(w_s))
    s = jnp.einsum('gij,bcjgd->bcigd', w, vp) + b_s.T[None, None, :, :, None]
    s = s.reshape(bsz, n_chunks * A_CHUNK, TOK_WIDTH)[:, :L]
    return u * s


def mem_attend(q, k, v):
    bsz, L, _ = q.shape
    q = q.reshape(bsz, L, MEM_HEADS, MEM_HEAD_DIM)
    s = jnp.einsum('blhd,bmhd->bhlm', q, k).astype(jnp.float32) * (MEM_HEAD_DIM ** -0.5)
    p = jax.nn.softmax(s, axis=-1).astype(v.dtype)
    return jnp.einsum('bhlm,bmhd->blhd', p, v).reshape(bsz, L, MEM_WIDTH)


def band_attend(q, k, v, q_pos, k_pos, rel_bias):
    s = jnp.einsum('bqhd,bkhd->bhqk', q, k).astype(jnp.float32) * (B_HEAD_DIM ** -0.5)
    rel = jnp.clip(q_pos[:, None] - k_pos[None, :], -REL_CLIP, REL_CLIP) + REL_CLIP
    bias = rel_bias.astype(jnp.float32)[:, rel]
    q_chunk = q_pos[:, None] // CHUNK
    valid = ((k_pos[None, :] >= 0)
             & (k_pos[None, :] < (q_chunk + 1) * CHUNK)
             & (k_pos[None, :] >= (q_chunk - B_LEFT_CHUNKS) * CHUNK))
    s = jnp.where(valid[None, None], s + bias[None], NEG_INF)
    p = jax.nn.softmax(s, axis=-1).astype(v.dtype)
    return jnp.einsum('bhqk,bkhd->bqhd', p, v)


def band_attention_prompt(q, k, v, rel_bias):
    bsz, S = q.shape[0], q.shape[1]
    n_chunks = S // CHUNK
    band = B_WINDOW + CHUNK
    kp = jnp.pad(k, ((0, 0), (B_WINDOW, 0), (0, 0), (0, 0)))
    vp = jnp.pad(v, ((0, 0), (B_WINDOW, 0), (0, 0), (0, 0)))
    qc = q.reshape(bsz, n_chunks, CHUNK, B_HEADS, B_HEAD_DIM).transpose(1, 0, 2, 3, 4)

    def one_chunk(args):
        c, qb = args
        start = c * CHUNK
        kb = lax.dynamic_slice_in_dim(kp, start, band, axis=1)
        vb = lax.dynamic_slice_in_dim(vp, start, band, axis=1)
        q_pos = start + jnp.arange(CHUNK, dtype=jnp.int32)
        k_pos = start - B_WINDOW + jnp.arange(band, dtype=jnp.int32)
        return band_attend(qb, kb, vb, q_pos, k_pos, rel_bias)

    out = lax.map(one_chunk, (jnp.arange(n_chunks, dtype=jnp.int32), qc))
    return out.transpose(1, 0, 2, 3, 4).reshape(bsz, S, B_HEADS, B_HEAD_DIM)


def band_attention_sample(q, k_new, v_new, cache_k, cache_v, rel_bias):
    L = q.shape[1]
    C = cache_k.shape[1]
    kb = jnp.concatenate([cache_k, k_new], axis=1)
    vb = jnp.concatenate([cache_v, v_new], axis=1)
    q_pos = PAST_LEN + jnp.arange(L, dtype=jnp.int32)
    k_pos = PAST_LEN - C + jnp.arange(C + L, dtype=jnp.int32)
    return band_attend(q, kb, vb, q_pos, k_pos, rel_bias)


def causal_dwconv(a, prev, w, b):
    L = a.shape[1]
    ap = jnp.concatenate([prev, a], axis=1)
    y = b + w[0] * ap[:, 0:L]
    for i in range(1, CONV_W):
        y = y + w[i] * ap[:, i:i + L]
    return y, ap[:, L:]


def trunk(h, is_prompt, mem_k, mem_v, conv_prev, b_cache_k, b_cache_v,
          g_mix, w_in_a, g_v, w_s, b_s, g_kv, w_kv, w_in_b, rel_bias,
          w_out, g_ffn, w_up, conv_w, conv_b, w_down, g_final):
    bsz, L, _ = h.shape
    a_v_rows, conv_states = [], []
    k_sh = v_sh = None
    for l in range(DEPTH):
        xn = rmsnorm(h, g_mix[l])
        if l < N_A_LAYERS:
            z = xn @ w_in_a[l]
            u, v = jnp.split(jax.nn.gelu(z[..., :2 * TOK_WIDTH]), 2, axis=-1)
            v = rmsnorm(v, g_v[l])
            if not is_prompt:
                a_v_rows.append(v)
            tok = spatial_gate(u, v, w_s[l], b_s[l])
            q_mem = z[..., 2 * TOK_WIDTH:]
        else:
            if l == N_A_LAYERS:
                kv = rmsnorm(h, g_kv) @ w_kv
                k_sh = kv[..., :TOK_WIDTH].reshape(bsz, L, B_HEADS, B_HEAD_DIM)
                v_sh = kv[..., TOK_WIDTH:].reshape(bsz, L, B_HEADS, B_HEAD_DIM)
            j = l - N_A_LAYERS
            z = xn @ w_in_b[j]
            q = z[..., :TOK_WIDTH].reshape(bsz, L, B_HEADS, B_HEAD_DIM)
            if is_prompt:
                o = band_attention_prompt(q, k_sh, v_sh, rel_bias[j])
            else:
                o = band_attention_sample(q, k_sh, v_sh, b_cache_k, b_cache_v, rel_bias[j])
            tok = o.reshape(bsz, L, TOK_WIDTH)
            q_mem = z[..., TOK_WIDTH:]
        mo = mem_attend(q_mem, mem_k[l], mem_v[l])
        h = h + jnp.concatenate([tok, mo], axis=-1) @ w_out[l]
        up = rmsnorm(h, g_ffn[l]) @ w_up[l]
        a, gate = jnp.split(up, 2, axis=-1)
        a_c, cs = causal_dwconv(a, conv_prev[l], conv_w[l], conv_b[l])
        conv_states.append(cs)
        h = h + (jax.nn.gelu(a_c) * gate) @ w_down[l]
    a_v = jnp.stack(a_v_rows) if a_v_rows else None
    return rmsnorm(h, g_final), a_v, k_sh, v_sh, jnp.stack(conv_states)


def setup_inputs(seed: int = 0) -> dict:
    key = jax.random.key(seed)
    ks = iter(jax.random.split(key, 32))

    def nrm(shape, scale=1.0):
        return jax.random.normal(next(ks), shape, jnp.float32) * scale

    def gain(shape):
        return 1.0 + 0.05 * nrm(shape)

    return {
        'x_prompt': nrm((BATCH, SEQ, D_MODEL)),
        'x_sample': nrm((DEC_BATCH, DEC_SEQ, D_MODEL)),
        'mem_prompt': nrm((BATCH, N_MEM, D_MODEL)),
        'cache_mem_k': nrm((DEPTH, DEC_BATCH, N_MEM, MEM_HEADS, MEM_HEAD_DIM)),
        'cache_mem_v': nrm((DEPTH, DEC_BATCH, N_MEM, MEM_HEADS, MEM_HEAD_DIM)),
        'cache_b_k': nrm((DEC_BATCH, CACHE_B_LEN, B_HEADS, B_HEAD_DIM)),
        'cache_b_v': nrm((DEC_BATCH, CACHE_B_LEN, B_HEADS, B_HEAD_DIM)),
        'state_conv': nrm((DEPTH, DEC_BATCH, CONV_W - 1, D_FF)),
        'g_mix': gain((DEPTH, D_MODEL)),
        'w_in_a': nrm((N_A_LAYERS, D_MODEL, 2 * TOK_WIDTH + MEM_WIDTH), D_MODEL ** -0.5),
        'g_v': gain((N_A_LAYERS, TOK_WIDTH)),
        'w_s': nrm((N_A_LAYERS, A_GROUPS, A_CHUNK, A_CHUNK), A_CHUNK ** -0.5),
        'b_s': 1.0 + 0.1 * nrm((N_A_LAYERS, A_GROUPS, A_CHUNK)),
        'g_kv': gain((D_MODEL,)),
        'w_kv': nrm((D_MODEL, 2 * TOK_WIDTH), D_MODEL ** -0.5),
        'w_in_b': nrm((N_B_LAYERS, D_MODEL, TOK_WIDTH + MEM_WIDTH), D_MODEL ** -0.5),
        'rel_bias': nrm((N_B_LAYERS, B_HEADS, N_REL), 0.5),
        'g_mem': gain((DEPTH, D_MODEL)),
        'w_mem_kv': nrm((DEPTH, D_MODEL, 2 * MEM_WIDTH), D_MODEL ** -0.5),
        'w_out': nrm((DEPTH, TOK_WIDTH + MEM_WIDTH, D_MODEL), (TOK_WIDTH + MEM_WIDTH) ** -0.5),
        'g_ffn': gain((DEPTH, D_MODEL)),
        'w_up': nrm((DEPTH, D_MODEL, 2 * D_FF), D_MODEL ** -0.5),
        'conv_w': nrm((DEPTH, CONV_W, D_FF), CONV_W ** -0.5),
        'conv_b': nrm((DEPTH, D_FF), 0.01),
        'w_down': nrm((DEPTH, D_FF, D_MODEL), D_FF ** -0.5),
        'g_final': gain((D_MODEL,)),
    }


def reference(x_prompt, x_sample, mem_prompt, cache_mem_k, cache_mem_v, cache_b_k, cache_b_v, state_conv,
              g_mix, w_in_a, g_v, w_s, b_s, g_kv, w_kv, w_in_b, rel_bias, g_mem, w_mem_kv,
              w_out, g_ffn, w_up, conv_w, conv_b, w_down, g_final):
    bsz = mem_prompt.shape[0]
    mem_n = rmsnorm(mem_prompt[None], g_mem[:, None, None, :])
    mkv = jnp.einsum('lbnd,lde->lbne', mem_n, w_mem_kv)
    mem_k_p = mkv[..., :MEM_WIDTH].reshape(DEPTH, bsz, N_MEM, MEM_HEADS, MEM_HEAD_DIM)
    mem_v_p = mkv[..., MEM_WIDTH:].reshape(DEPTH, bsz, N_MEM, MEM_HEADS, MEM_HEAD_DIM)
    conv0 = jnp.zeros((DEPTH, bsz, CONV_W - 1, D_FF), x_prompt.dtype)

    y_p, _, k_p, v_p, conv_p = trunk(
        x_prompt, True, mem_k_p, mem_v_p, conv0, None, None,
        g_mix, w_in_a, g_v, w_s, b_s, g_kv, w_kv, w_in_b, rel_bias,
        w_out, g_ffn, w_up, conv_w, conv_b, w_down, g_final)
    y_s, a_v_s, k_s, v_s, conv_s = trunk(
        x_sample, False, cache_mem_k, cache_mem_v, state_conv, cache_b_k, cache_b_v,
        g_mix, w_in_a, g_v, w_s, b_s, g_kv, w_kv, w_in_b, rel_bias,
        w_out, g_ffn, w_up, conv_w, conv_b, w_down, g_final)

    return (y_p, y_s, mem_k_p, mem_v_p, k_p[:, -B_WINDOW:], v_p[:, -B_WINDOW:], conv_p,
            a_v_s, k_s, v_s, conv_s)
```

```cpp
#include <hip/hip_runtime.h>
#include <hip/hip_cooperative_groups.h>
#include <cstdio>
#include <cstdint>
namespace cg = cooperative_groups;
namespace pg8 {
#define PG8_LAS __attribute__((address_space(3)))
typedef unsigned short bf16_t;
typedef short bf16x8 __attribute__((ext_vector_type(8)));
typedef float f32x4 __attribute__((ext_vector_type(4)));
typedef unsigned u32x4 __attribute__((ext_vector_type(4)));
constexpr int BM = 256, BK = 64, HALF = 128, HTB = HALF * BK * 2  , STAGE_BYTES = 8 * HTB, NXCD = 8, WGM = 8;

__host__ __device__ __forceinline__ int lds_byte(int r, int c) { const int st = (r >> 4) * 2 + (c >> 5), rr = r & 15, cc = c & 31, ob = rr * 64 + cc * 2; return st * 1024 + (ob ^ (((ob >> 9) & 1) << 5)); }
__host__ __device__ __forceinline__ void stage_rc(int b, int& R, int& C) { const int st = b / 1024, sb = b % 1024, swz = sb ^ (((sb >> 9) & 1) << 5); R = (st >> 1) * 16 + swz / 64; C = (st & 1) * 32 + (swz % 64) / 2; }
__host__ __device__ __forceinline__ int perm32(int rho) { const int n = rho >> 4, i = rho & 15; return 8 * (i >> 2) + 4 * n + (i & 3); }

struct Unit { int pm, pn; };
struct Gemm { const bf16_t* A; const bf16_t* Bt; int M, N, K; };

struct StaticOrder {
    int nM, nN, nwg, G, c;
    __host__ __device__ void init(int M, int N, int G_, int c_) { nM = M / BM; nN = N / BM; nwg = nM * nN; G = G_; c = c_; }
    __host__ __device__ bool next(int i, Unit& u) const {
        const long L = (long)i * G + c; if (L >= nwg) return false;
        int wgid = (int)L; { const int q = nwg / NXCD, r = nwg % NXCD, xcd = wgid % NXCD, off = wgid / NXCD; wgid = (xcd < r ? xcd * (q + 1) : r * (q + 1) + (xcd - r) * q) + off; }
        const int nig = WGM * nN, gid = wgid / nig, fm = gid * WGM, gsz = (nM - fm) < WGM ? (nM - fm) : WGM;
        u.pm = fm + ((wgid % nig) % gsz); u.pn = (wgid % nig) / gsz; return true;
    }
    __device__ __forceinline__ void a_ready(const Unit&) const {}
    __device__ __forceinline__ void done(const Unit&) const {}
};

__device__ __forceinline__ unsigned cvt_pk_bf16(float lo, float hi) { unsigned r; asm volatile("v_cvt_pk_bf16_f32 %0, %1, %2" : "=v"(r) : "v"(lo), "v"(hi)); return r; }
template <class Epi, class Sched, bool ALIGN_EPI = false, bool SP2 = false>
__device__ __forceinline__ void gemm_phase(PG8_LAS unsigned char* lds, const Gemm g, const Sched& S, const Epi& E, const int tid) {
    const int wid = __builtin_amdgcn_readfirstlane(tid >> 6), lane = tid & 63, wr = wid >> 2, wc = wid & 3, fr = lane & 15, fq = lane >> 4;
    const int K = g.K, nt = K / BK;
    unsigned voffA[2], voffB[2];
#pragma unroll
    for (int i = 0; i < 2; ++i) { int R, C; stage_rc(tid * 16 + i * 8192, R, C); const int Rb = Epi::PERM ? ((R & ~31) + perm32(R & 31)) : R;
        voffA[i] = (unsigned)(R * K + C) * 2u; voffB[i] = (unsigned)(Rb * K + C) * 2u; }
    const size_t kstep = (size_t)(BK * 2);
    const size_t hstep = (size_t)HALF * K * 2;
    const size_t tstep = 2 * hstep;
    const unsigned ldsw = (unsigned)wid * 1024u;
    const int aoff = lds_byte(wr * 64 + fr, fq * 8), boff = lds_byte(wc * 32 + fr, fq * 8);
#define PG8_SA(b, h) (((b) * 2 + (h)) * HTB)
#define PG8_SB(b, h) ((4 + (b) * 2 + (h)) * HTB)
#define PG8_STAGE(bufoff, gbase, voff) do { _Pragma("unroll") for (int _i = 0; _i < 2; ++_i) \
        __builtin_amdgcn_global_load_lds((const unsigned*)((const char*)(gbase) + (voff)[_i]), (PG8_LAS unsigned*)(lds + (bufoff) + ldsw + _i * 8192), 16, 0, 0); } while (0)
#define PG8_LDA(dst, b, h) do { _Pragma("unroll") for (int m = 0; m < 4; ++m) _Pragma("unroll") for (int k = 0; k < 2; ++k) dst[m][k] = *(const PG8_LAS bf16x8*)(lds + PG8_SA(b, h) + aoff + m * 2048 + k * 1024); } while (0)
#define PG8_LDB(dst, b, h) do { _Pragma("unroll") for (int n = 0; n < 2; ++n) _Pragma("unroll") for (int k = 0; k < 2; ++k) dst[n][k] = *(const PG8_LAS bf16x8*)(lds + PG8_SB(b, h) + boff + n * 2048 + k * 1024); } while (0)
#define PG8_MMA(ai, bj, At, Bt) do { __builtin_amdgcn_s_setprio(1); _Pragma("unroll") for (int m = 0; m < 4; ++m) _Pragma("unroll") for (int n = 0; n < 2; ++n) _Pragma("unroll") for (int k = 0; k < 2; ++k) \
        acc[ai][bj][m][n] = __builtin_amdgcn_mfma_f32_16x16x32_bf16(Bt[n][k], At[m][k], acc[ai][bj][m][n], 0, 0, 0); __builtin_amdgcn_s_setprio(0); } while (0)
#define PG8_WAIT_V(n) asm volatile("s_waitcnt vmcnt(" #n ")" ::: "memory")
#define PG8_WAIT_L(n) asm volatile("s_waitcnt lgkmcnt(" #n ")" ::: "memory")
#define PG8_BAR __builtin_amdgcn_s_barrier()
#define PG8_SCHED __builtin_amdgcn_sched_barrier(0)
    Unit cur, nxt; int ui = 0;
    if (!S.next(0, cur)) return;
    f32x4 acc[2][2][4][2];
#pragma unroll
    for (int a = 0; a < 2; ++a)
#pragma unroll
        for (int b = 0; b < 2; ++b)
#pragma unroll
            for (int m = 0; m < 4; ++m)
#pragma unroll
                for (int n = 0; n < 2; ++n) acc[a][b][m][n] = (f32x4){0.f, 0.f, 0.f, 0.f};
    bf16x8 At[4][2], B0[2][2], B1[2][2];
    const char* cA = (const char*)g.A + (size_t)cur.pm * tstep; const char* cB = (const char*)g.Bt + (size_t)cur.pn * tstep;
    S.a_ready(cur);
    if constexpr (SP2) {
        PG8_STAGE(PG8_SB(0, 0), cB, voffB); PG8_STAGE(PG8_SB(0, 1), cB + hstep, voffB); PG8_STAGE(PG8_SA(0, 0), cA, voffA); PG8_STAGE(PG8_SA(0, 1), cA + hstep, voffA);
        if (wr == 1) PG8_BAR;
        PG8_WAIT_V(2); PG8_BAR;
        PG8_STAGE(PG8_SB(1, 0), cB + kstep, voffB); PG8_STAGE(PG8_SA(1, 0), cA + kstep, voffA); PG8_STAGE(PG8_SB(1, 1), cB + hstep + kstep, voffB);
        PG8_WAIT_V(6); PG8_BAR;
    } else {
        PG8_STAGE(PG8_SB(0, 0), cB, voffB); PG8_STAGE(PG8_SA(0, 0), cA, voffA); PG8_STAGE(PG8_SB(0, 1), cB + hstep, voffB); PG8_STAGE(PG8_SA(0, 1), cA + hstep, voffA);
        if (wr == 1) PG8_BAR;
        PG8_WAIT_V(4); PG8_BAR;
        PG8_STAGE(PG8_SB(1, 0), cB + kstep, voffB); PG8_STAGE(PG8_SA(1, 0), cA + kstep, voffA); PG8_STAGE(PG8_SB(1, 1), cB + hstep + kstep, voffB);
        PG8_WAIT_V(6); PG8_BAR;
    }
    for (;;) {
        const bool has_next = S.next(ui + 1, nxt);
        const char* nA = has_next ? (const char*)g.A + (size_t)nxt.pm * tstep : cA; const char* nB = has_next ? (const char*)g.Bt + (size_t)nxt.pn * tstep : cB;
        for (int t = 0; t < nt; t += 2) {
            const bool last = (t == nt - 2);
            const char* a1 = cA + (size_t)(t + 1) * kstep;
            const char* a2 = last ? nA : cA + (size_t)(t + 2) * kstep; const char* b2 = last ? nB : cB + (size_t)(t + 2) * kstep;
            const char* a3 = a2 + kstep; const char* b3 = b2 + kstep;
            if (last && has_next) S.a_ready(nxt);
            if constexpr (SP2) {
            PG8_LDB(B0, 0, 0); PG8_LDB(B1, 0, 1); PG8_SCHED; PG8_LDA(At, 0, 0); PG8_STAGE(PG8_SA(1, 1), a1 + hstep, voffA);
            PG8_WAIT_V(8); PG8_WAIT_L(0); PG8_BAR; PG8_MMA(0, 0, At, B0); PG8_MMA(0, 1, At, B1); PG8_BAR; PG8_SCHED;
            PG8_LDA(At, 0, 1); PG8_STAGE(PG8_SB(0, 0), b2, voffB); PG8_STAGE(PG8_SB(0, 1), b2 + hstep, voffB); PG8_STAGE(PG8_SA(0, 0), a2, voffA);
            PG8_WAIT_V(8); PG8_WAIT_L(0); PG8_BAR; PG8_MMA(1, 0, At, B0); PG8_MMA(1, 1, At, B1); PG8_BAR; PG8_SCHED;
            PG8_LDB(B0, 1, 0); PG8_LDB(B1, 1, 1); PG8_SCHED; PG8_LDA(At, 1, 0); PG8_STAGE(PG8_SA(0, 1), a2 + hstep, voffA);
            PG8_WAIT_V(8); PG8_WAIT_L(0); PG8_BAR; PG8_MMA(0, 0, At, B0); PG8_MMA(0, 1, At, B1); PG8_BAR; PG8_SCHED;
            PG8_LDA(At, 1, 1); PG8_STAGE(PG8_SB(1, 0), b3, voffB); PG8_STAGE(PG8_SB(1, 1), b3 + hstep, voffB); PG8_STAGE(PG8_SA(1, 0), a3, voffA);
            PG8_WAIT_V(8); PG8_WAIT_L(0); PG8_BAR; PG8_MMA(1, 0, At, B0); PG8_MMA(1, 1, At, B1); PG8_BAR; PG8_SCHED;
            } else {
            PG8_LDB(B0, 0, 0); PG8_SCHED; PG8_LDA(At, 0, 0); PG8_STAGE(PG8_SA(1, 1), a1 + hstep, voffA);
            PG8_WAIT_L(8); PG8_BAR; PG8_WAIT_L(0); PG8_MMA(0, 0, At, B0); PG8_BAR; PG8_SCHED;
            PG8_LDB(B1, 0, 1); PG8_STAGE(PG8_SB(0, 0), b2, voffB);
            PG8_BAR; PG8_WAIT_L(0); PG8_MMA(0, 1, At, B1); PG8_BAR;
            PG8_LDA(At, 0, 1); PG8_STAGE(PG8_SA(0, 0), a2, voffA);
            PG8_BAR; PG8_WAIT_L(0); PG8_MMA(1, 0, At, B0); PG8_BAR; PG8_SCHED;
            PG8_STAGE(PG8_SB(0, 1), b2 + hstep, voffB);
            PG8_WAIT_V(6); PG8_BAR; PG8_MMA(1, 1, At, B1); PG8_BAR;
            PG8_LDB(B0, 1, 0); PG8_SCHED; PG8_LDA(At, 1, 0); PG8_STAGE(PG8_SA(0, 1), a2 + hstep, voffA);
            PG8_WAIT_L(8); PG8_BAR; PG8_WAIT_L(0); PG8_MMA(0, 0, At, B0); PG8_BAR; PG8_SCHED;
            PG8_LDB(B1, 1, 1); PG8_STAGE(PG8_SB(1, 0), b3, voffB);
            PG8_BAR; PG8_WAIT_L(0); PG8_MMA(0, 1, At, B1); PG8_BAR;
            PG8_LDA(At, 1, 1); PG8_STAGE(PG8_SA(1, 0), a3, voffA);
            PG8_BAR; PG8_WAIT_L(0); PG8_MMA(1, 0, At, B0); PG8_BAR; PG8_SCHED;
            PG8_STAGE(PG8_SB(1, 1), b3 + hstep, voffB);
            PG8_WAIT_V(6); PG8_BAR; PG8_MMA(1, 1, At, B1); PG8_BAR;
            }
        }
        if constexpr (ALIGN_EPI) { if (wr == 0) PG8_BAR; }
        if constexpr (!Epi::AFTER_DRAIN) { E(acc, cur, wr, wc, fr, fq); S.done(cur); }
        if (!has_next) break;
#pragma unroll
        for (int a = 0; a < 2; ++a)
#pragma unroll
            for (int b = 0; b < 2; ++b)
#pragma unroll
                for (int m = 0; m < 4; ++m)
#pragma unroll
                    for (int n = 0; n < 2; ++n) acc[a][b][m][n] = (f32x4){0.f, 0.f, 0.f, 0.f};
        cur = nxt; cA = nA; cB = nB; ++ui;
        if constexpr (ALIGN_EPI) { if (wr == 1) PG8_BAR; }
    }
    PG8_WAIT_V(0);
    if constexpr (!ALIGN_EPI) { if (wr == 0) PG8_BAR; }
    PG8_BAR;
    if constexpr (Epi::AFTER_DRAIN) { E.fused(acc, cur, wr, wc, fr, fq, lds, wid, lane); S.done(cur); }
#undef PG8_SA
#undef PG8_SB
#undef PG8_STAGE
#undef PG8_LDA
#undef PG8_LDB
#undef PG8_MMA
#undef PG8_WAIT_V
#undef PG8_WAIT_L
#undef PG8_BAR
#undef PG8_SCHED
}
}

#define LAS __attribute__((address_space(3)))
typedef unsigned short bf16_t;
typedef short bf16x8 __attribute__((ext_vector_type(8)));
typedef float f32x4 __attribute__((ext_vector_type(4)));
typedef float f32x16 __attribute__((ext_vector_type(16)));
typedef unsigned u32x4 __attribute__((ext_vector_type(4)));
typedef unsigned u32x2 __attribute__((ext_vector_type(2)));
using pg8::cvt_pk_bf16;

constexpr int NWAVES = 8, NTHR = 512;
constexpr int DM = 1024, DFF = 2816, SEQ = 4096, NB = 16, NBS = 32, DSEQ = 64;
constexpr int MP = NB * SEQ, MS = NBS * DSEQ, MT = MP + MS;
constexpr int NBLK64 = MT / 64;
constexpr float EPS = 1e-6f, LOG2E = 1.4426950408889634f;
constexpr int LDS_BYTES = 147456;

constexpr size_t OUT_Y = 0;
constexpr size_t OUT_MK = (size_t)MT * DM;
constexpr size_t OUT_MV = OUT_MK + (size_t)4 * 16 * 256 * 512;
constexpr size_t OUT_BK = OUT_MV + (size_t)4 * 16 * 256 * 512;
constexpr size_t OUT_BV = OUT_BK + (size_t)16 * 512 * 512;
constexpr size_t OUT_CP = OUT_BV + (size_t)16 * 512 * 512;
constexpr size_t OUT_AV = OUT_CP + (size_t)4 * 16 * 2 * DFF;
constexpr size_t OUT_SK = OUT_AV + (size_t)2 * 32 * 64 * 512;
constexpr size_t OUT_SV = OUT_SK + (size_t)32 * 64 * 512;
constexpr size_t OUT_CS = OUT_SV + (size_t)32 * 64 * 512;
constexpr size_t OUT_END = OUT_CS + (size_t)4 * 32 * 2 * DFF;

constexpr size_t al256(size_t x) { return (x + 255) & ~(size_t)255; }
constexpr size_t WS_SSQ = 0;
constexpr size_t WS_RMEM = al256(WS_SSQ + (size_t)11 * MT * 4);
constexpr size_t WS_WINA = al256(WS_RMEM + 4096 * 4);
constexpr size_t WS_WB = WS_WINA + (size_t)2 * 1536 * 1024 * 2;
constexpr size_t WS_WMEM = WS_WB + (size_t)3072 * 1024 * 2;
constexpr size_t WS_WOUT = WS_WMEM + (size_t)4096 * 1024 * 2;
constexpr size_t WS_WUP = WS_WOUT + (size_t)4096 * 1024 * 2;
constexpr size_t WS_WDOWN = WS_WUP + (size_t)4 * 5632 * 1024 * 2;
constexpr size_t WS_WSB = WS_WDOWN + (size_t)4 * 1024 * 2816 * 2;
constexpr size_t WS_MPB = WS_WSB + (size_t)2 * 8 * 128 * 128 * 2;
constexpr size_t WS_HB = WS_MPB + (size_t)4096 * 1024 * 2;
constexpr size_t WS_MEMK = WS_HB + (size_t)MT * 1024 * 2;
constexpr size_t WS_MEMVT = WS_MEMK + (size_t)4 * 48 * 256 * 512 * 2;
constexpr size_t WS_PK = WS_MEMVT + (size_t)4 * 48 * 256 * 512 * 2;
constexpr size_t WS_PVT = WS_PK + (size_t)MP * 512 * 2;
constexpr size_t WS_SK = WS_PVT + (size_t)MP * 512 * 2;
constexpr size_t WS_SVT = WS_SK + (size_t)32 * 576 * 512 * 2;
constexpr size_t WS_TAIL = WS_SVT + (size_t)32 * 576 * 512 * 2;
constexpr size_t WS_HEAD = WS_TAIL + (size_t)NBLK64 * 2 * DFF * 4;
constexpr size_t WS_OVL = WS_HEAD + (size_t)NBLK64 * 4 * DFF * 4;
constexpr size_t WS_ACT = WS_OVL;
constexpr size_t WS_U = WS_OVL;
constexpr size_t WS_VT = WS_U + (size_t)MT * 512 * 2;
constexpr size_t WS_QM = WS_VT + (size_t)MT * 512 * 2;
constexpr size_t WS_CAT = WS_QM + (size_t)MT * 512 * 2;
constexpr size_t WS_END = WS_OVL + (size_t)MT * DFF * 2;
static_assert(WS_CAT + (size_t)MT * 1024 * 2 <= WS_END, "overlay");
static_assert(WS_END <= (size_t)1073741824, "workspace budget");

__device__ __forceinline__ float bf2f(unsigned short b) { return __builtin_bit_cast(float, (unsigned)b << 16); }
__device__ __forceinline__ unsigned short f2bf(float f) { unsigned u = __builtin_bit_cast(unsigned, f); return (unsigned short)((u + 0x7fffu + ((u >> 16) & 1u)) >> 16); }
__device__ __forceinline__ float gelu_t(float x) {
    const float t = x * (1.0f + 0.044715f * x * x);
    const float e = __builtin_amdgcn_exp2f(-2.302208198f * t);
    return x * __builtin_amdgcn_rcpf(1.0f + e);
}
__device__ __forceinline__ float rs_from(float ssq, float invn) { return rsqrtf(ssq * invn + EPS); }
__device__ __forceinline__ u32x4 pack8(const f32x4& a, const f32x4& b) { u32x4 w; w.x = cvt_pk_bf16(a[0], a[1]); w.y = cvt_pk_bf16(a[2], a[3]); w.z = cvt_pk_bf16(b[0], b[1]); w.w = cvt_pk_bf16(b[2], b[3]); return w; }
__device__ __forceinline__ float wave_sum(float v) {
#pragma unroll
    for (int o = 1; o < 64; o <<= 1) v += __shfl_xor(v, o);
    return v;
}
#define MFMA32(a, b, c) __builtin_amdgcn_mfma_f32_32x32x16_bf16((a), (b), (c), 0, 0, 0)
__device__ __forceinline__ int crow(int r, int hi) { return (r & 3) + 8 * (r >> 2) + 4 * hi; }

typedef f32x4 AccT[2][2][4][2];

struct EpiInA {
    static constexpr bool PERM = true, AFTER_DRAIN = false;
    const float* ssq; bf16_t* U; bf16_t* VT; bf16_t* QM; float* ssqv; float qscale;
    __device__ __forceinline__ void operator()(const AccT& acc, const pg8::Unit& u, int wr, int wc, int fr, int fq) const {
        const int row0 = u.pm * 256 + wr * 64 + fr; const int ty = u.pn >> 1; const int cb = (u.pn & 1) * 256 + wc * 32 + 8 * fq;
#pragma unroll
        for (int ai = 0; ai < 2; ++ai)
#pragma unroll
            for (int m = 0; m < 4; ++m) {
                const int row = row0 + ai * 128 + m * 16; const float r = rs_from(ssq[row], 1.0f / 1024.0f);
                if (ty == 0) {
#pragma unroll
                    for (int bj = 0; bj < 2; ++bj) { f32x4 a = acc[ai][bj][m][0] * r, b = acc[ai][bj][m][1] * r;
#pragma unroll
                        for (int e = 0; e < 4; ++e) { a[e] = gelu_t(a[e]); b[e] = gelu_t(b[e]); }
                        *(u32x4*)(U + (size_t)row * 512 + cb + bj * 128) = pack8(a, b); }
                } else if (ty == 2) {
                    const float s = r * qscale;
#pragma unroll
                    for (int bj = 0; bj < 2; ++bj) { f32x4 a = acc[ai][bj][m][0] * s, b = acc[ai][bj][m][1] * s;
                        *(u32x4*)(QM + (size_t)row * 512 + cb + bj * 128) = pack8(a, b); }
                } else {
                    float ss = 0.f; bf16_t* vt = VT + (size_t)(row >> 7) * 512 * 128 + (row & 127);
#pragma unroll
                    for (int bj = 0; bj < 2; ++bj)
#pragma unroll
                        for (int n = 0; n < 2; ++n)
#pragma unroll
                            for (int e = 0; e < 4; ++e) { const unsigned short hb = f2bf(gelu_t(acc[ai][bj][m][n][e] * r)); const float vr = bf2f(hb); ss += vr * vr;
                                vt[(size_t)(cb + bj * 128 + 4 * n + e) * 128] = hb; }
                    ss += __shfl_xor(ss, 16); ss += __shfl_xor(ss, 32);
                    if (fq == 0) atomicAdd(ssqv + row, ss);
                }
            }
    }
};

struct EpiInB {
    static constexpr bool PERM = true, AFTER_DRAIN = false;
    const float* ssq; bf16_t* Q; bf16_t* QM; bf16_t* PK; bf16_t* PVT; bf16_t* SK; bf16_t* SVT; float* out; float qscale, mscale;
    __device__ __forceinline__ void operator()(const AccT& acc, const pg8::Unit& u, int wr, int wc, int fr, int fq) const {
        const int row0 = u.pm * 256 + wr * 64 + fr; const int ty = u.pn >> 1; const int cb = (u.pn & 1) * 256 + wc * 32 + 8 * fq;
        const bool samp = u.pm >= 256;
#pragma unroll
        for (int ai = 0; ai < 2; ++ai)
#pragma unroll
            for (int m = 0; m < 4; ++m) {
                const int row = row0 + ai * 128 + m * 16; const float r = rs_from(ssq[row], 1.0f / 1024.0f);
                if (ty < 2) {
                    const float s = r * (ty == 0 ? qscale : mscale); bf16_t* dst = (ty == 0 ? Q : QM) + (size_t)row * 512 + cb;
#pragma unroll
                    for (int bj = 0; bj < 2; ++bj) { f32x4 a = acc[ai][bj][m][0] * s, b = acc[ai][bj][m][1] * s; *(u32x4*)(dst + bj * 128) = pack8(a, b); }
                } else if (ty == 2) {
                    bf16_t* dst; float* fo = nullptr;
                    if (!samp) { dst = PK + (size_t)row * 512 + cb; const int t = row & 4095; if (t >= 3584) fo = out + OUT_BK + ((size_t)(row >> 12) * 512 + (t - 3584)) * 512 + cb; }
                    else { const int rs = row - MP, bs = rs >> 6, t = rs & 63; dst = SK + ((size_t)bs * 576 + 512 + t) * 512 + cb; fo = out + OUT_SK + (size_t)rs * 512 + cb; }
#pragma unroll
                    for (int bj = 0; bj < 2; ++bj) { f32x4 a = acc[ai][bj][m][0] * r, b = acc[ai][bj][m][1] * r; *(u32x4*)(dst + bj * 128) = pack8(a, b);
                        if (fo) { *(f32x4*)(fo + bj * 128) = a; *(f32x4*)(fo + bj * 128 + 4) = b; } }
                } else {
                    bf16_t* dst; size_t cst; float* fo = nullptr;
                    if (!samp) { const int b = row >> 12, t = row & 4095; dst = PVT + (size_t)b * 512 * 4096 + t; cst = 4096; if (t >= 3584) fo = out + OUT_BV + ((size_t)b * 512 + (t - 3584)) * 512 + cb; }
                    else { const int rs = row - MP, bs = rs >> 6, t = rs & 63; dst = SVT + (size_t)bs * 512 * 576 + 512 + t; cst = 576; fo = out + OUT_SV + (size_t)rs * 512 + cb; }
#pragma unroll
                    for (int bj = 0; bj < 2; ++bj) { f32x4 a = acc[ai][bj][m][0] * r, b = acc[ai][bj][m][1] * r;
#pragma unroll
                        for (int e = 0; e < 4; ++e) { dst[(size_t)(cb + bj * 128 + e) * cst] = f2bf(a[e]); dst[(size_t)(cb + bj * 128 + 4 + e) * cst] = f2bf(b[e]); }
                        if (fo) { *(f32x4*)(fo + bj * 128) = a; *(f32x4*)(fo + bj * 128 + 4) = b; } }
                }
            }
    }
};

struct EpiRes {
    static constexpr bool PERM = true, AFTER_DRAIN = false;
    const float* res_p; const float* res_s; float* hout; bf16_t* hb; float* ssq_next;
    __device__ __forceinline__ void operator()(const AccT& acc, const pg8::Unit& u, int wr, int wc, int fr, int fq) const {
        const int row0 = u.pm * 256 + wr * 64 + fr; const int cb = u.pn * 256 + wc * 32 + 8 * fq;
        const float* rin = (u.pm < 256) ? res_p : res_s;
#pragma unroll
        for (int ai = 0; ai < 2; ++ai)
#pragma unroll
            for (int m = 0; m < 4; ++m) {
                const int row = row0 + ai * 128 + m * 16; float ss = 0.f;
#pragma unroll
                for (int bj = 0; bj < 2; ++bj) { const size_t o = (size_t)row * 1024 + cb + bj * 128;
                    f32x4 a = *(const f32x4*)(rin + o) + acc[ai][bj][m][0], b = *(const f32x4*)(rin + o + 4) + acc[ai][bj][m][1];
                    *(f32x4*)(hout + o) = a; *(f32x4*)(hout + o + 4) = b; *(u32x4*)(hb + o) = pack8(a, b);
                    ss += (a[0] * a[0] + a[1] * a[1]) + (a[2] * a[2] + a[3] * a[3]) + (b[0] * b[0] + b[1] * b[1]) + (b[2] * b[2] + b[3] * b[3]); }
                ss += __shfl_xor(ss, 16); ss += __shfl_xor(ss, 32);
                if (fq == 0) atomicAdd(ssq_next + row, ss);
            }
    }
};

struct EpiUp {
    static constexpr bool PERM = true, AFTER_DRAIN = false;
    const float* ssq; const float* cw; const float* cbias; bf16_t* ACT; float* tail; float* head;
    __device__ __forceinline__ void operator()(const AccT& acc, const pg8::Unit& u, int wr, int wc, int fr, int fq) const {
        const int f0 = u.pn * 128 + wc * 32 + 8 * fq; const int lane = fq * 16 + fr;
        const int s1 = (lane & 48) | ((fr - 1) & 15), s2 = (lane & 48) | ((fr - 2) & 15);
        f32x4 w0[2], w1[2], w2[2], bb[2];
#pragma unroll
        for (int n = 0; n < 2; ++n) { w0[n] = *(const f32x4*)(cw + f0 + 4 * n); w1[n] = *(const f32x4*)(cw + DFF + f0 + 4 * n); w2[n] = *(const f32x4*)(cw + 2 * DFF + f0 + 4 * n); bb[n] = *(const f32x4*)(cbias + f0 + 4 * n); }
#pragma unroll
        for (int ai = 0; ai < 2; ++ai) {
            const int blk = u.pm * 4 + ai * 2 + wr; const int rowb = blk * 64;
            f32x4 p1[2], p2[2];
#pragma unroll
            for (int n = 0; n < 2; ++n) { p1[n] = (f32x4){0.f, 0.f, 0.f, 0.f}; p2[n] = p1[n]; }
#pragma unroll
            for (int m = 0; m < 4; ++m) {
                const int row = rowb + 16 * m + fr; const float r = rs_from(ssq[row], 1.0f / 1024.0f);
                f32x4 a[2], g[2], o[2], pp[2];
#pragma unroll
                for (int n = 0; n < 2; ++n) { a[n] = acc[ai][0][m][n] * r; g[n] = acc[ai][1][m][n] * r;
                    f32x4 c1, c2;
#pragma unroll
                    for (int e = 0; e < 4; ++e) { c1[e] = __shfl(a[n][e], s1); c2[e] = __shfl(a[n][e], s2); }
                    f32x4 a1, a2;
#pragma unroll
                    for (int e = 0; e < 4; ++e) { a1[e] = fr >= 1 ? c1[e] : p1[n][e]; a2[e] = fr >= 2 ? c2[e] : p2[n][e]; }
                    p1[n] = c1; p2[n] = c2;
                    if (m == 0) {
#pragma unroll
                        for (int e = 0; e < 4; ++e) { if (fr == 0) { a1[e] = 0.f; a2[e] = 0.f; } else if (fr == 1) a2[e] = 0.f; }
                    }
                    pp[n] = bb[n] + w0[n] * a2 + w1[n] * a1 + w2[n] * a[n];
#pragma unroll
                    for (int e = 0; e < 4; ++e) o[n][e] = gelu_t(pp[n][e]) * g[n][e];
                }
                if (m == 0 && fr < 2) {
                    float* hp = head + ((size_t)(blk * 2 + fr) * 2) * DFF + f0;
                    *(f32x4*)(hp) = pp[0]; *(f32x4*)(hp + 4) = pp[1]; *(f32x4*)(hp + DFF) = g[0]; *(f32x4*)(hp + DFF + 4) = g[1];
                } else {
                    *(u32x4*)(ACT + (size_t)row * DFF + f0) = pack8(o[0], o[1]);
                }
                if (m == 3 && fr >= 14) { float* tp = tail + (size_t)(blk * 2 + (fr - 14)) * DFF + f0; *(f32x4*)(tp) = a[0]; *(f32x4*)(tp + 4) = a[1]; }
            }
        }
    }
};

struct EpiMem {
    static constexpr bool PERM = true, AFTER_DRAIN = false;
    const float* rmem; float* out; bf16_t* MEMK; bf16_t* MEMVT;
    __device__ __forceinline__ void operator()(const AccT& acc, const pg8::Unit& u, int wr, int wc, int fr, int fq) const {
        const int row0 = u.pm * 256 + wr * 64 + fr; const int l = u.pn >> 2, kv = (u.pn >> 1) & 1; const int cb = (u.pn & 1) * 256 + wc * 32 + 8 * fq;
#pragma unroll
        for (int ai = 0; ai < 2; ++ai)
#pragma unroll
            for (int m = 0; m < 4; ++m) {
                const int row = row0 + ai * 128 + m * 16; const float r = rmem[row]; const int b = row >> 8, n = row & 255;
                float* fo = out + (kv ? OUT_MV : OUT_MK) + ((size_t)l * 4096 + row) * 512 + cb;
#pragma unroll
                for (int bj = 0; bj < 2; ++bj) { f32x4 x = acc[ai][bj][m][0] * r, y = acc[ai][bj][m][1] * r;
                    *(f32x4*)(fo + bj * 128) = x; *(f32x4*)(fo + bj * 128 + 4) = y;
                    if (!kv) *(u32x4*)(MEMK + (((size_t)l * 48 + b) * 256 + n) * 512 + cb + bj * 128) = pack8(x, y);
                    else { bf16_t* d = MEMVT + (((size_t)l * 48 + b) * 512 + cb + bj * 128) * 256 + n;
#pragma unroll
                        for (int e = 0; e < 4; ++e) { d[(size_t)e * 256] = f2bf(x[e]); d[(size_t)(4 + e) * 256] = f2bf(y[e]); } } }
            }
    }
};

__device__ __forceinline__ void tr_item(const float* src, int lsrc, int k0, int n0, const float* g, bf16_t* dst, int ldd, LAS float* scr, int lane) {
#pragma unroll 8
    for (int i = 0; i < 32; ++i) { const int kk = 2 * i + (lane >> 5); float v = src[(size_t)(k0 + kk) * lsrc + n0 + (lane & 31)]; if (g) v *= g[k0 + kk]; scr[kk * 33 + (lane & 31)] = v; }
    asm volatile("s_waitcnt lgkmcnt(0)" ::: "memory");
    const int c = lane & 7;
#pragma unroll
    for (int j = 0; j < 4; ++j) { const int n = (lane >> 3) + 8 * j; const LAS float* s = scr + (8 * c) * 33 + n;
        u32x4 o; o.x = cvt_pk_bf16(s[0 * 33], s[1 * 33]); o.y = cvt_pk_bf16(s[2 * 33], s[3 * 33]); o.z = cvt_pk_bf16(s[4 * 33], s[5 * 33]); o.w = cvt_pk_bf16(s[6 * 33], s[7 * 33]);
        *(u32x4*)(dst + (size_t)n * ldd + k0 + 8 * c) = o; }
    asm volatile("s_waitcnt lgkmcnt(0)" ::: "memory");
}
__device__ __forceinline__ void tr_plain(const float* src, int K, int N, const float* g, bf16_t* dst, int ldd, int item, LAS float* scr, int lane) {
    const int nblk = N / 32, kb = item / nblk, nb = item % nblk;
    tr_item(src, N, kb * 64, nb * 32, g, dst + (size_t)(nb * 32) * ldd, ldd, scr, lane);
}

struct Args { const float* in[26]; float* out; unsigned char* ws; int ph_lo, ph_hi, coop, pad; };
typedef __attribute__((address_space(4))) const Args* KArgs;

__device__ __forceinline__ void p0_prologue(KArgs a, LAS unsigned char* lds, int tid) {
    const int lane = tid & 63, wave = tid >> 6; const int G = gridDim.x;
    LAS float* scr = (LAS float*)(lds + wave * 8704);
    unsigned char* ws = a->ws;
    const int gw = blockIdx.x * NWAVES + wave, NGW = G * NWAVES;
    constexpr int I_INA = 16 * 48, I_SQ = 16 * 32, I_UP = 16 * 176, I_DN = 44 * 32, I_MV = 4 * 16, I_BV = 8 * 16;
    constexpr int N_INA = 2 * I_INA, N_B = 3 * I_SQ, N_MEM = 4 * I_SQ, N_OUT = 4 * I_SQ, N_UP = 4 * I_UP, N_DN = 4 * I_DN, N_MV = 128 * I_MV, N_BV = 32 * I_BV;
    constexpr int NITEMS = N_INA + N_B + N_MEM + N_OUT + N_UP + N_DN + N_MV + N_BV;
    for (int it = gw; it < NITEMS; it += NGW) {
        int r = it;
        if (r < N_INA) { const int l = r / I_INA; r %= I_INA; tr_plain(a->in[9] + (size_t)l * 1024 * 1536, 1024, 1536, a->in[8] + l * 1024, (bf16_t*)(ws + WS_WINA) + (size_t)l * 1536 * 1024, 1024, r, scr, lane); continue; } r -= N_INA;
        if (r < N_B) { const int s = r / I_SQ; r %= I_SQ;
            const float* src = s == 1 ? a->in[14] : a->in[15] + (size_t)(s >> 1) * 1024 * 1024; const float* g = s == 1 ? a->in[13] : a->in[8] + (2 + (s >> 1)) * 1024;
            tr_plain(src, 1024, 1024, g, (bf16_t*)(ws + WS_WB) + (size_t)s * 1024 * 1024, 1024, r, scr, lane); continue; } r -= N_B;
        if (r < N_MEM) { const int l = r / I_SQ; r %= I_SQ; tr_plain(a->in[18] + (size_t)l * 1024 * 1024, 1024, 1024, a->in[17] + l * 1024, (bf16_t*)(ws + WS_WMEM) + (size_t)l * 1024 * 1024, 1024, r, scr, lane); continue; } r -= N_MEM;
        if (r < N_OUT) { const int l = r / I_SQ; r %= I_SQ; tr_plain(a->in[19] + (size_t)l * 1024 * 1024, 1024, 1024, nullptr, (bf16_t*)(ws + WS_WOUT) + (size_t)l * 1024 * 1024, 1024, r, scr, lane); continue; } r -= N_OUT;
        if (r < N_UP) { const int l = r / I_UP; r %= I_UP; const int kb = r / 176, nb = r % 176; const int s0 = nb * 32; const int bj = s0 / DFF, f = s0 % DFF; const int drow = (f >> 7) * 256 + bj * 128 + (f & 127);
            tr_item(a->in[21] + (size_t)l * 1024 * 5632, 5632, kb * 64, s0, a->in[20] + l * 1024, (bf16_t*)(ws + WS_WUP) + ((size_t)l * 5632 + drow) * 1024, 1024, scr, lane); continue; } r -= N_UP;
        if (r < N_DN) { const int l = r / I_DN; r %= I_DN; tr_plain(a->in[24] + (size_t)l * DFF * 1024, DFF, 1024, nullptr, (bf16_t*)(ws + WS_WDOWN) + (size_t)l * 1024 * DFF, DFF, r, scr, lane); continue; } r -= N_DN;
        if (r < N_MV) { const int mi = r / I_MV; r %= I_MV; const int l = mi >> 5, bs = mi & 31;
            tr_plain(a->in[4] + (size_t)mi * 256 * 512, 256, 512, nullptr, (bf16_t*)(ws + WS_MEMVT) + ((size_t)l * 48 + 16 + bs) * 512 * 256, 256, r, scr, lane); continue; } r -= N_MV;
        { const int bs = r / I_BV; r %= I_BV; tr_plain(a->in[6] + (size_t)bs * 512 * 512, 512, 512, nullptr, (bf16_t*)(ws + WS_SVT) + (size_t)bs * 512 * 576, 576, r, scr, lane); }
    }
    for (int m = gw; m < MT + 4096; m += NGW) {
        const bool ismem = m >= MT; const int rr = ismem ? m - MT : m;
        const float* xr = ismem ? a->in[2] + (size_t)rr * 1024 : (rr < MP ? a->in[0] + (size_t)rr * 1024 : a->in[1] + (size_t)(rr - MP) * 1024);
        bf16_t* orow = (bf16_t*)(ws + (ismem ? WS_MPB : WS_HB)) + (size_t)rr * 1024;
        f32x4 v[4]; float s = 0.f;
#pragma unroll
        for (int j = 0; j < 4; ++j) { v[j] = *((const f32x4*)xr + lane + 64 * j); s += (v[j][0] * v[j][0] + v[j][1] * v[j][1]) + (v[j][2] * v[j][2] + v[j][3] * v[j][3]); }
        s = wave_sum(s);
#pragma unroll
        for (int j = 0; j < 4; ++j) { u32x2 o; o.x = cvt_pk_bf16(v[j][0], v[j][1]); o.y = cvt_pk_bf16(v[j][2], v[j][3]); *((u32x2*)orow + lane + 64 * j) = o; }
        if (lane == 0) { if (ismem) ((float*)(ws + WS_RMEM))[rr] = rs_from(s, 1.0f / 1024.0f); else ((float*)(ws + WS_SSQ))[rr] = s; }
    }
    const size_t gt = (size_t)blockIdx.x * NTHR + tid, NT = (size_t)G * NTHR;
    { float* z = (float*)(ws + WS_SSQ) + MT; for (size_t i = gt; i < (size_t)10 * MT; i += NT) z[i] = 0.f; }
    { bf16_t* wsb = (bf16_t*)(ws + WS_WSB); const float* w = a->in[11];
      for (size_t i = gt; i < (size_t)2 * 8 * 128 * 128; i += NT) { const int jj = (int)(i & 127), ii = (int)((i >> 7) & 127); wsb[i] = jj <= ii ? f2bf(w[i]) : (unsigned short)0; } }
    {
      const f32x4* src = (const f32x4*)a->in[3]; bf16_t* dst = (bf16_t*)(ws + WS_MEMK);
      for (size_t i = gt; i < (size_t)4 * 32 * 256 * 512 / 4; i += NT) { const size_t e = i * 4; const size_t mi = e / (256 * 512), rem = e % (256 * 512); const size_t l = mi >> 5, bs = mi & 31;
          const f32x4 v = src[i]; u32x2 o; o.x = cvt_pk_bf16(v[0], v[1]); o.y = cvt_pk_bf16(v[2], v[3]); *(u32x2*)(dst + ((l * 48 + 16 + bs) * 256 * 512) + rem) = o; } }
    {
      const f32x4* src = (const f32x4*)a->in[5]; bf16_t* dst = (bf16_t*)(ws + WS_SK);
      for (size_t i = gt; i < (size_t)32 * 512 * 512 / 4; i += NT) { const size_t e = i * 4; const size_t bs = e / (512 * 512), rem = e % (512 * 512);
          const f32x4 v = src[i]; u32x2 o; o.x = cvt_pk_bf16(v[0], v[1]); o.y = cvt_pk_bf16(v[2], v[3]); *(u32x2*)(dst + bs * 576 * 512 + rem) = o; } }
}

__device__ __forceinline__ void gate_unit(LAS unsigned char* lds, int tid, int chunk, int joff, int nib, int row0,
                                          const bf16_t* wsb, const bf16_t* VT, const bf16_t* U, const float* ssqv, const float* gv, const float* bs, bf16_t* CAT, float* av_out) {
    const int g = tid >> 6, lane = tid & 63, l32 = lane & 31, half = lane >> 5;
    LAS float* rv = (LAS float*)lds;
    __syncthreads();
    if (tid < nib * 32) rv[tid] = rs_from(ssqv[row0 + tid], 1.0f / 512.0f);
    __syncthreads();
    const bf16_t* vt_g = VT + ((size_t)chunk * 512 + g * 64) * 128 + joff;
    const bf16_t* w_g = wsb + (size_t)g * 128 * 128;
#pragma unroll 1
    for (int db = 0; db < 2; ++db) {
        f32x16 acc[4];
#pragma unroll
        for (int i = 0; i < 4; ++i)
#pragma unroll
            for (int e = 0; e < 16; ++e) acc[i][e] = 0.f;
        const bf16_t* vt_d = vt_g + (size_t)(db * 32 + l32) * 128 + half * 8;
        const bf16_t* w_d = w_g + (size_t)l32 * 128 + half * 8;
#pragma unroll
        for (int ks = 0; ks < 8; ++ks) {
            if (ks < nib * 2) {
                const int j0 = ks * 16 + half * 8;
                const u32x4 raw = *(const u32x4*)(vt_d + ks * 16);
                u32x4 sc;
#pragma unroll
                for (int q = 0; q < 4; ++q) { const float lo = __builtin_bit_cast(float, raw[q] << 16) * rv[j0 + 2 * q], hi = __builtin_bit_cast(float, raw[q] & 0xffff0000u) * rv[j0 + 2 * q + 1]; sc[q] = cvt_pk_bf16(lo, hi); }
                const bf16x8 bfr = __builtin_bit_cast(bf16x8, sc);
#pragma unroll
                for (int ib = 0; ib < 4; ++ib) {
                    if (ib < nib && ks < (ib + 1) * 2) {
                        const bf16x8 af = *(const bf16x8*)(w_d + ib * 32 * 128 + ks * 16);
                        acc[ib] = MFMA32(af, bfr, acc[ib]);
                    }
                }
            }
        }
        const int c = g * 64 + db * 32 + l32; const float gvc = gv[c];
        const bf16_t* ub = U + ((size_t)row0 + 4 * half) * 512 + c; bf16_t* cbp = CAT + ((size_t)row0 + 4 * half) * 1024 + c; const float* bsp = bs + g * 128 + 4 * half;
#pragma unroll
        for (int ib = 0; ib < 4; ++ib) {
            if (ib < nib) {
#pragma unroll
                for (int e = 0; e < 16; ++e) { const int i = ib * 32 + (e & 3) + 8 * (e >> 2);
                    const float s = acc[ib][e] * gvc + bsp[i];
                    cbp[(size_t)i * 1024] = f2bf(bf2f(ub[(size_t)i * 512]) * s); }
            }
        }
    }
    if (av_out) {
        for (int e = tid; e < 64 * 512; e += NTHR) { const int t = e >> 9, c = e & 511; av_out[e] = bf2f(VT[((size_t)chunk * 512 + c) * 128 + joff + t]) * rv[t] * gv[c]; }
    }
}

template <int D, bool BAND>
__device__ __forceinline__ void attn_unit(LAS unsigned char* lds, int tid, const bf16_t* Qw, bool hasq, const bf16_t* Kb, int ldk, const bf16_t* Vtb, int ldv,
                                          int jstart, int nkb, int jlo, int jhi, bf16_t* Ow, LAS const float* btab, int relq) {
    constexpr int KROW = (D + 8) * 2, VROW = 144, KBYTES = 64 * KROW, VBYTES = D * VROW, BUF = KBYTES + VBYTES, NR = D / 64, KK = D / 16, DB = D / 32;
    const int lane = tid & 63, l32 = lane & 31, half = lane >> 5;
    bf16x8 qf[KK];
#pragma unroll
    for (int kk = 0; kk < KK; ++kk) qf[kk] = hasq ? *(const bf16x8*)(Qw + (size_t)l32 * 512 + kk * 16 + half * 8) : (bf16x8){0, 0, 0, 0, 0, 0, 0, 0};
    f32x16 O[DB];
#pragma unroll
    for (int d = 0; d < DB; ++d)
#pragma unroll
        for (int e = 0; e < 16; ++e) O[d][e] = 0.f;
    float mrun = -1e30f, lsum = 0.f;
    u32x4 kreg[NR], vreg[NR];
    auto gload = [&](int j) {
#pragma unroll
        for (int i = 0; i < NR; ++i) { const int id = tid + i * NTHR; const int kr = id / (D / 8), kc = id % (D / 8); kreg[i] = *(const u32x4*)(Kb + (long)(j * 64 + kr) * ldk + kc * 8);
            const int vr = id >> 3, vc = id & 7; vreg[i] = *(const u32x4*)(Vtb + (long)vr * ldv + j * 64 + vc * 8); }
    };
    auto lstore = [&](int buf) {
        LAS unsigned char* b = lds + buf * BUF;
#pragma unroll
        for (int i = 0; i < NR; ++i) { const int id = tid + i * NTHR; const int kr = id / (D / 8), kc = id % (D / 8); *(LAS u32x4*)(b + kr * KROW + kc * 16) = kreg[i];
            const int vr = id >> 3, vc = id & 7; *(LAS u32x4*)(b + KBYTES + vr * VROW + vc * 16) = vreg[i]; }
    };
    __syncthreads();
    gload(jstart); lstore(0);
    __syncthreads();
    for (int j = jstart; j < nkb; ++j) {
        const int cur = (j - jstart) & 1;
        if (j + 1 < nkb) gload(j + 1);
        if (hasq && j >= jlo && j <= jhi) {
            const LAS unsigned char* b = lds + cur * BUF;
            f32x16 S[2];
#pragma unroll
            for (int s = 0; s < 2; ++s) {
#pragma unroll
                for (int e = 0; e < 16; ++e) S[s][e] = 0.f;
#pragma unroll
                for (int kk = 0; kk < KK; ++kk) { const bf16x8 af = *(const LAS bf16x8*)(b + (s * 32 + l32) * KROW + (kk * 16 + half * 8) * 2); S[s] = MFMA32(af, qf[kk], S[s]); }
                if (BAND) {
#pragma unroll
                    for (int e = 0; e < 16; ++e) { const int kidx = j * 64 + s * 32 + crow(e, half); int rel = relq - kidx; rel = rel > 256 ? 256 : rel; S[s][e] += btab[rel + 63]; }
                }
            }
            float mx = S[0][0];
#pragma unroll
            for (int e = 1; e < 16; ++e) mx = fmaxf(mx, S[0][e]);
#pragma unroll
            for (int e = 0; e < 16; ++e) mx = fmaxf(mx, S[1][e]);
            mx = fmaxf(mx, __shfl_xor(mx, 32));
            const float mnew = fmaxf(mrun, mx); const float alpha = __builtin_amdgcn_exp2f(mrun - mnew); mrun = mnew;
            float ps = 0.f;
#pragma unroll
            for (int s = 0; s < 2; ++s)
#pragma unroll
                for (int e = 0; e < 16; ++e) { const float p = __builtin_amdgcn_exp2f(S[s][e] - mnew); S[s][e] = p; ps += p; }
            lsum = lsum * alpha + ps;
#pragma unroll
            for (int d = 0; d < DB; ++d)
#pragma unroll
                for (int e = 0; e < 16; ++e) O[d][e] *= alpha;
#pragma unroll
            for (int s = 0; s < 2; ++s)
#pragma unroll
                for (int t = 0; t < 2; ++t) {
                    u32x4 pk;
#pragma unroll
                    for (int q = 0; q < 4; ++q) pk[q] = cvt_pk_bf16(S[s][8 * t + 2 * q], S[s][8 * t + 2 * q + 1]);
                    const bf16x8 pb = __builtin_bit_cast(bf16x8, pk);
#pragma unroll
                    for (int d = 0; d < DB; ++d) {
                        const LAS unsigned char* vp = b + KBYTES + (d * 32 + l32) * VROW + (s * 32 + 16 * t + 4 * half) * 2;
                        const u32x2 v0 = *(const LAS u32x2*)vp, v1 = *(const LAS u32x2*)(vp + 16);
                        const u32x4 vv = {v0.x, v0.y, v1.x, v1.y};
                        O[d] = MFMA32(__builtin_bit_cast(bf16x8, vv), pb, O[d]);
                    }
                }
        }
        if (j + 1 < nkb) lstore(cur ^ 1);
        __syncthreads();
    }
    if (hasq) {
        const float l = lsum + __shfl_xor(lsum, 32); const float inv = 1.0f / l;
#pragma unroll
        for (int d = 0; d < DB; ++d)
#pragma unroll
            for (int gq = 0; gq < 4; ++gq) {
                u32x2 o; o.x = cvt_pk_bf16(O[d][4 * gq] * inv, O[d][4 * gq + 1] * inv); o.y = cvt_pk_bf16(O[d][4 * gq + 2] * inv, O[d][4 * gq + 3] * inv);
                *(u32x2*)(Ow + (size_t)l32 * 1024 + d * 32 + 8 * gq + 4 * half) = o;
            }
    }
}

__device__ __forceinline__ void mixer_phase(KArgs a, LAS unsigned char* lds, int tid_in, int l) {
    unsigned char* ws = a->ws; const int G = gridDim.x;
    bf16_t* CAT = (bf16_t*)(ws + WS_CAT);
    constexpr int N_MEMP = 16 * 16 * 4, N_MEMS = 32 * 4;
#ifndef NO_MEMATT
    {
        int tid = tid_in; asm volatile("" : "+v"(tid)); const int wave = tid >> 6;
        const bf16_t* QM = (const bf16_t*)(ws + WS_QM);
        for (int it = blockIdx.x; it < N_MEMP + N_MEMS; it += G) {
            int r = it; int bb, h, q0, nq;
            if (r < N_MEMP) { h = r & 3; const int qb = (r >> 2) & 15; bb = r >> 6; q0 = bb * SEQ + qb * 256; nq = 256; }
            else { r -= N_MEMP; h = r & 3; const int bs = r >> 2; bb = 16 + bs; q0 = MP + bs * 64; nq = 64; }
            const bool hasq = wave * 32 < nq; const int qrow = q0 + wave * 32;
            attn_unit<128, false>(lds, tid, QM + (size_t)qrow * 512 + h * 128, hasq, (const bf16_t*)(ws + WS_MEMK) + ((size_t)l * 48 + bb) * 256 * 512 + h * 128, 512,
                                  (const bf16_t*)(ws + WS_MEMVT) + (((size_t)l * 48 + bb) * 512 + h * 128) * 256, 256, 0, 4, 0, 3, CAT + (size_t)qrow * 1024 + 512 + h * 128, nullptr, 0);
        }
    }
#endif
    if (l < 2) {
#ifndef NO_GATE
        int tid = tid_in; asm volatile("" : "+v"(tid));
        for (int r = blockIdx.x; r < 512 + 32; r += G) {
            int chunk, joff, nib, row0; float* av = nullptr;
            if (r < 512) { chunk = r; joff = 0; nib = 4; row0 = r * 128; }
            else { const int bs = r - 512; chunk = 512 + (bs >> 1); joff = (bs & 1) * 64; nib = 2; row0 = MP + bs * 64; av = a->out + OUT_AV + ((size_t)l * 32 + bs) * 64 * 512; }
            gate_unit(lds, tid, chunk, joff, nib, row0, (const bf16_t*)(ws + WS_WSB) + (size_t)l * 8 * 128 * 128, (const bf16_t*)(ws + WS_VT), (const bf16_t*)(ws + WS_U),
                      (const float*)(ws + WS_SSQ) + (size_t)(9 + l) * MT, a->in[10] + l * 512, a->in[12] + l * 8 * 128, CAT, av);
        }
#endif
    } else {
#ifndef NO_BAND
        int tid = tid_in; asm volatile("" : "+v"(tid)); const int wave = tid >> 6;
        const int jl = l - 2; const bf16_t* Q = (const bf16_t*)(ws + WS_U);
        LAS float* btab = (LAS float*)(lds + 40960);
        for (int it = blockIdx.x; it < 16 * 8 * 16 + 32 * 8; it += G) {
            int r = it;
            int h, qrow, jstart, nkb, jlo, jhi, relq; const bf16_t* Kb; const bf16_t* Vtb; int ldv; bool hasq;
            if (r < 16 * 8 * 16) { h = r & 7; const int cg4 = (r >> 3) & 15; const int b = r >> 7; const int c0 = cg4 * 4;
                qrow = b * SEQ + c0 * 64 + wave * 32; hasq = true; nkb = 12; jstart = c0 >= 8 ? 0 : 8 - c0; jlo = wave >> 1; jhi = jlo + 8;
                Kb = (const bf16_t*)(ws + WS_PK) + ((long)b * SEQ + (long)(c0 - 8) * 64) * 512 + h * 64;
                Vtb = (const bf16_t*)(ws + WS_PVT) + ((long)b * 512 + h * 64) * 4096 + (long)(c0 - 8) * 64; ldv = 4096;
                relq = 512 + (wave >> 1) * 64 + (wave & 1) * 32 + (tid & 31); }
            else { r -= 16 * 8 * 16; h = r & 7; const int bs = r >> 3; qrow = MP + bs * 64 + wave * 32; hasq = wave < 2; nkb = 9; jstart = 0; jlo = 0; jhi = 8;
                Kb = (const bf16_t*)(ws + WS_SK) + (size_t)bs * 576 * 512 + h * 64; Vtb = (const bf16_t*)(ws + WS_SVT) + ((size_t)bs * 512 + h * 64) * 576; ldv = 576;
                relq = 512 + (wave & 1) * 32 + (tid & 31); }
            __syncthreads();
            if (tid < 320) btab[tid] = a->in[16][((size_t)jl * 8 + h) * 513 + 193 + tid] * LOG2E;
            attn_unit<64, true>(lds, tid, Q + (size_t)qrow * 512 + h * 64, hasq, Kb, 512, Vtb, ldv, jstart, nkb, jlo, jhi, CAT + (size_t)qrow * 1024 + h * 64, btab, relq);
        }
#endif
    }
}

__device__ __forceinline__ void fixup_phase(KArgs a, int tid, int l) {
    unsigned char* ws = a->ws; const float* tail = (const float*)(ws + WS_TAIL); const float* head = (const float*)(ws + WS_HEAD); bf16_t* ACT = (bf16_t*)(ws + WS_ACT);
    const float* cw = a->in[22] + (size_t)l * 3 * DFF; const float* sc = a->in[7] + (size_t)l * 32 * 2 * DFF;
    const size_t gt = (size_t)blockIdx.x * NTHR + tid, NT = (size_t)gridDim.x * NTHR;
    for (size_t i = gt; i < (size_t)NBLK64 * DFF; i += NT) {
        const int blk = (int)(i / DFF), f = (int)(i % DFF);
        float pm2, pm1;
        if (blk >= MP / 64) { const int bs = blk - MP / 64; pm2 = sc[((size_t)bs * 2 + 0) * DFF + f]; pm1 = sc[((size_t)bs * 2 + 1) * DFF + f]; }
        else if ((blk & 63) == 0) { pm2 = 0.f; pm1 = 0.f; }
        else { pm2 = tail[((size_t)(blk - 1) * 2 + 0) * DFF + f]; pm1 = tail[((size_t)(blk - 1) * 2 + 1) * DFF + f]; }
        const float w0 = cw[f], w1 = cw[DFF + f];
        const float* hp = head + (size_t)blk * 4 * DFF + f;
        const float c0 = hp[0] + w0 * pm2 + w1 * pm1, g0 = hp[DFF], c1 = hp[2 * DFF] + w0 * pm1, g1 = hp[3 * DFF];
        ACT[(size_t)blk * 64 * DFF + f] = f2bf(gelu_t(c0) * g0);
        ACT[((size_t)blk * 64 + 1) * DFF + f] = f2bf(gelu_t(c1) * g1);
        const float t0 = tail[((size_t)blk * 2 + 0) * DFF + f], t1 = tail[((size_t)blk * 2 + 1) * DFF + f];
        if (blk >= MP / 64) { float* o = a->out + OUT_CS + ((size_t)l * 32 + (blk - MP / 64)) * 2 * DFF + f; o[0] = t0; o[DFF] = t1; }
        else if ((blk & 63) == 63) { float* o = a->out + OUT_CP + ((size_t)l * 16 + (blk >> 6)) * 2 * DFF + f; o[0] = t0; o[DFF] = t1; }
    }
}

__device__ __forceinline__ void final_phase(KArgs a, int tid) {
    const float* ssq = (const float*)(a->ws + WS_SSQ) + (size_t)4 * MT; const float* g = a->in[25];
    const int lane = tid & 63; const int gw = blockIdx.x * NWAVES + (tid >> 6), NGW = gridDim.x * NWAVES;
    for (int m = gw; m < MT; m += NGW) {
        const float r = rs_from(ssq[m], 1.0f / 1024.0f); f32x4* row = (f32x4*)(a->out + (size_t)m * 1024);
#pragma unroll
        for (int j = 0; j < 4; ++j) { const f32x4 gg = *((const f32x4*)g + lane + 64 * j); f32x4 v = row[lane + 64 * j]; v = v * r * gg; row[lane + 64 * j] = v; }
    }
}

__device__ __forceinline__ void launder(int& t) { asm volatile("" : "+v"(t)); }
__global__ void __launch_bounds__(NTHR, 2) fwd_kernel(Args a) {
    extern __shared__ __attribute__((aligned(16))) unsigned char lds_raw[];
    LAS unsigned char* lds = (LAS unsigned char*)lds_raw;
    int tid = threadIdx.x; const int G = gridDim.x;
    KArgs kp = (KArgs)__builtin_amdgcn_kernarg_segment_ptr();
#define PH_ARGS() KArgs q = kp; asm volatile("" : "+s"(q)); unsigned char* ws = q->ws; float* ssqb = (float*)(ws + WS_SSQ); bf16_t* HB = (bf16_t*)(ws + WS_HB); (void)ssqb; (void)HB;
    int ph = 0;
#define SEAM() do { if (a.coop && ph + 1 < a.ph_hi) { __threadfence(); cg::this_grid().sync(); } } while (0)
#define IN_PH() (launder(tid), ph >= a.ph_lo && ph < a.ph_hi)
#ifndef EN_MASK
#define EN_MASK 0xffff
#endif
#define EN(k) ((EN_MASK >> (k)) & 1)

    if (IN_PH()) { PH_ARGS(); if (EN(0)) p0_prologue(q, lds, tid); SEAM(); } ++ph;

#pragma unroll 1
    for (int l = 0; l < 4; ++l) {
        if (IN_PH()) { PH_ARGS();
            if (l < 2) { if (EN(1)) {
                pg8::Gemm g{HB, (const bf16_t*)(ws + WS_WINA) + (size_t)l * 1536 * 1024, MT, 1536, 1024}; pg8::StaticOrder S; S.init(MT, 1536, G, (int)blockIdx.x);
                EpiInA E{ssqb + (size_t)l * MT, (bf16_t*)(ws + WS_U), (bf16_t*)(ws + WS_VT), (bf16_t*)(ws + WS_QM), ssqb + (size_t)(9 + l) * MT, 0.08838834764831845f * LOG2E};
                pg8::gemm_phase<EpiInA, pg8::StaticOrder, true, true>(lds, g, S, E, tid); }
                if (EN(2) && l == 0) {
                    pg8::Gemm g2{(const bf16_t*)(ws + WS_MPB), (const bf16_t*)(ws + WS_WMEM), 4096, 4096, 1024}; pg8::StaticOrder S2; S2.init(4096, 4096, G, (int)blockIdx.x);
                    EpiMem E2{(const float*)(ws + WS_RMEM), q->out, (bf16_t*)(ws + WS_MEMK), (bf16_t*)(ws + WS_MEMVT)};
                    pg8::gemm_phase<EpiMem, pg8::StaticOrder, true, true>(lds, g2, S2, E2, tid);
                }
            } else if (EN(3)) {
                const int N = l == 2 ? 2048 : 1024;
                pg8::Gemm g{HB, (const bf16_t*)(ws + WS_WB) + (size_t)(l == 2 ? 0 : 2048) * 1024, MT, N, 1024}; pg8::StaticOrder S; S.init(MT, N, G, (int)blockIdx.x);
                EpiInB E{ssqb + (size_t)l * MT, (bf16_t*)(ws + WS_U), (bf16_t*)(ws + WS_QM), (bf16_t*)(ws + WS_PK), (bf16_t*)(ws + WS_PVT), (bf16_t*)(ws + WS_SK), (bf16_t*)(ws + WS_SVT), q->out,
                         0.125f * LOG2E, 0.08838834764831845f * LOG2E};
                pg8::gemm_phase<EpiInB, pg8::StaticOrder, true, true>(lds, g, S, E, tid);
            }
            SEAM();
        } ++ph;
        if (IN_PH()) { PH_ARGS(); if (EN(4)) mixer_phase(q, lds, tid, l); SEAM(); } ++ph;
        if (IN_PH()) { PH_ARGS(); if (EN(5)) {
            pg8::Gemm g{(const bf16_t*)(ws + WS_CAT), (const bf16_t*)(ws + WS_WOUT) + (size_t)l * 1024 * 1024, MT, 1024, 1024}; pg8::StaticOrder S; S.init(MT, 1024, G, (int)blockIdx.x);
            EpiRes E{l == 0 ? q->in[0] : q->out, l == 0 ? q->in[1] - (size_t)MP * 1024 : q->out, q->out, HB, ssqb + (size_t)(5 + l) * MT};
            pg8::gemm_phase<EpiRes, pg8::StaticOrder, true, true>(lds, g, S, E, tid); }
            SEAM();
        } ++ph;
        if (IN_PH()) { PH_ARGS(); if (EN(6)) {
            pg8::Gemm g{HB, (const bf16_t*)(ws + WS_WUP) + (size_t)l * 5632 * 1024, MT, 5632, 1024}; pg8::StaticOrder S; S.init(MT, 5632, G, (int)blockIdx.x);
            EpiUp E{ssqb + (size_t)(5 + l) * MT, q->in[22] + (size_t)l * 3 * DFF, q->in[23] + (size_t)l * DFF, (bf16_t*)(ws + WS_ACT), (float*)(ws + WS_TAIL), (float*)(ws + WS_HEAD)};
            pg8::gemm_phase<EpiUp, pg8::StaticOrder, true, true>(lds, g, S, E, tid); }
            SEAM();
        } ++ph;
        if (IN_PH()) { PH_ARGS(); if (EN(7)) fixup_phase(q, tid, l); SEAM(); } ++ph;
        if (IN_PH()) { PH_ARGS(); if (EN(8)) {
            pg8::Gemm g{(const bf16_t*)(ws + WS_ACT), (const bf16_t*)(ws + WS_WDOWN) + (size_t)l * 1024 * DFF, MT, 1024, DFF}; pg8::StaticOrder S; S.init(MT, 1024, G, (int)blockIdx.x);
            EpiRes E{q->out, q->out, q->out, HB, ssqb + (size_t)(l + 1) * MT};
            pg8::gemm_phase<EpiRes, pg8::StaticOrder, true, true>(lds, g, S, E, tid); }
            SEAM();
        } ++ph;
    }
    if (IN_PH()) { PH_ARGS(); if (EN(9)) final_phase(q, tid); } ++ph;
#undef SEAM
#undef IN_PH
}
constexpr int N_PHASES = 26;

#ifndef MK_MULTI
#define MK_MULTI 0
#endif

extern "C" void kernel_launch(void* const* d_in, const int* in_sizes, int n_in, void* d_out, int out_size, void* d_ws, size_t ws_size, hipStream_t stream) {
    static int grid = 0;
    if (grid == 0) {
        if (n_in != 26 || (size_t)out_size != OUT_END || ws_size < WS_END) { fprintf(stderr, "kernel_launch: unexpected sizes n_in %d out %d ws %zu (need %zu)\n", n_in, out_size, ws_size, (size_t)WS_END); grid = -1; return; }
        int dev = 0, cus = 0, per_cu = 0;
        if (hipGetDevice(&dev) != hipSuccess || hipDeviceGetAttribute(&cus, hipDeviceAttributeMultiprocessorCount, dev) != hipSuccess) { grid = -1; return; }
        if (hipFuncSetAttribute((const void*)fwd_kernel, hipFuncAttributeMaxDynamicSharedMemorySize, LDS_BYTES) != hipSuccess) { fprintf(stderr, "kernel_launch: hipFuncSetAttribute failed\n"); grid = -1; return; }
        if (hipOccupancyMaxActiveBlocksPerMultiprocessor(&per_cu, (const void*)fwd_kernel, NTHR, LDS_BYTES) != hipSuccess || per_cu < 1) { fprintf(stderr, "kernel_launch: occupancy query says %d\n", per_cu); per_cu = 1; }
        (void)hipGetLastError();
        grid = cus * 1;
    }
    if (grid < 0) return;
    Args a{};
    for (int i = 0; i < 26; ++i) a.in[i] = (const float*)d_in[i];
    a.out = (float*)d_out; a.ws = (unsigned char*)d_ws;
#if MK_MULTI
    for (int p = 0; p < N_PHASES; ++p) { a.ph_lo = p; a.ph_hi = p + 1; a.coop = 0; hipLaunchKernelGGL(fwd_kernel, dim3(grid), dim3(NTHR), LDS_BYTES, stream, a); }
#else
    a.ph_lo = 0; a.ph_hi = N_PHASES; a.coop = 1;
    void* args[] = {&a};
    hipError_t e = hipLaunchCooperativeKernel((const void*)fwd_kernel, dim3(grid), dim3(NTHR), args, LDS_BYTES, stream);
    if (e != hipSuccess) fprintf(stderr, "cooperative launch failed: %s (grid %d)\n", hipGetErrorString(e), grid);
#endif
}
```

```cpp
#include <hip/hip_runtime.h>
#include <hip/hip_cooperative_groups.h>
#include <cstdio>
#include <cstdint>
namespace cg = cooperative_groups;
namespace pg8 {
#define PG8_LAS __attribute__((address_space(3)))
typedef unsigned short bf16_t;
typedef short bf16x8 __attribute__((ext_vector_type(8)));
typedef float f32x4 __attribute__((ext_vector_type(4)));
typedef unsigned u32x4 __attribute__((ext_vector_type(4)));
constexpr int BM = 256, BK = 64, HALF = 128, HTB = HALF * BK * 2  , STAGE_BYTES = 8 * HTB, NXCD = 8, WGM = 8;

__host__ __device__ __forceinline__ int lds_byte(int r, int c) { const int st = (r >> 4) * 2 + (c >> 5), rr = r & 15, cc = c & 31, ob = rr * 64 + cc * 2; return st * 1024 + (ob ^ (((ob >> 9) & 1) << 5)); }
__host__ __device__ __forceinline__ void stage_rc(int b, int& R, int& C) { const int st = b / 1024, sb = b % 1024, swz = sb ^ (((sb >> 9) & 1) << 5); R = (st >> 1) * 16 + swz / 64; C = (st & 1) * 32 + (swz % 64) / 2; }
__host__ __device__ __forceinline__ int perm32(int rho) { const int n = rho >> 4, i = rho & 15; return 8 * (i >> 2) + 4 * n + (i & 3); }

struct Unit { int pm, pn; };
struct Gemm { const bf16_t* A; const bf16_t* Bt; int M, N, K; };

struct StaticOrder {
    int nM, nN, nwg, G, c, rep = 1;
    __host__ __device__ void init(int M, int N, int G_, int c_) { nM = M / BM; nN = N / BM; nwg = nM * nN; G = G_; c = c_; }
    __host__ __device__ bool next(int i, Unit& u) const {
        const long L = (long)i * G + c; if (L >= (long)nwg * rep) return false;
        int wgid = (int)(L % nwg); { const int q = nwg / NXCD, r = nwg % NXCD, xcd = wgid % NXCD, off = wgid / NXCD; wgid = (xcd < r ? xcd * (q + 1) : r * (q + 1) + (xcd - r) * q) + off; }
        const int nig = WGM * nN, gid = wgid / nig, fm = gid * WGM, gsz = (nM - fm) < WGM ? (nM - fm) : WGM;
        u.pm = fm + ((wgid % nig) % gsz); u.pn = (wgid % nig) / gsz; return true;
    }
    __device__ __forceinline__ void a_ready(const Unit&) const {}
    __device__ __forceinline__ void done(const Unit&) const {}
};

__device__ __forceinline__ unsigned cvt_pk_bf16(float lo, float hi) { unsigned r; asm volatile("v_cvt_pk_bf16_f32 %0, %1, %2" : "=v"(r) : "v"(lo), "v"(hi)); return r; }
template <class Epi, class Sched, bool ALIGN_EPI = false, bool SP2 = false>
__device__ __forceinline__ void gemm_phase(PG8_LAS unsigned char* lds, const Gemm g, const Sched& S, const Epi& E, const int tid) {
    const int wid = __builtin_amdgcn_readfirstlane(tid >> 6), lane = tid & 63, wr = wid >> 2, wc = wid & 3, fr = lane & 15, fq = lane >> 4;
    const int K = g.K, nt = K / BK;
    unsigned voffA[2], voffB[2];
#pragma unroll
    for (int i = 0; i < 2; ++i) { int R, C; stage_rc(tid * 16 + i * 8192, R, C); const int Rb = Epi::PERM ? ((R & ~31) + perm32(R & 31)) : R;
        voffA[i] = (unsigned)(R * K + C) * 2u; voffB[i] = (unsigned)(Rb * K + C) * 2u; }
    const size_t kstep = (size_t)(BK * 2);
    const size_t hstep = (size_t)HALF * K * 2;
    const size_t tstep = 2 * hstep;
    const unsigned ldsw = (unsigned)wid * 1024u;
    const int aoff = lds_byte(wr * 64 + fr, fq * 8), boff = lds_byte(wc * 32 + fr, fq * 8);
#define PG8_SA(b, h) (((b) * 2 + (h)) * HTB)
#define PG8_SB(b, h) ((4 + (b) * 2 + (h)) * HTB)
#define PG8_STAGE(bufoff, gbase, voff) do { _Pragma("unroll") for (int _i = 0; _i < 2; ++_i) \
        __builtin_amdgcn_global_load_lds((const unsigned*)((const char*)(gbase) + (voff)[_i]), (PG8_LAS unsigned*)(lds + (bufoff) + ldsw + _i * 8192), 16, 0, 0); } while (0)
#define PG8_LDA(dst, b, h) do { _Pragma("unroll") for (int m = 0; m < 4; ++m) _Pragma("unroll") for (int k = 0; k < 2; ++k) dst[m][k] = *(const PG8_LAS bf16x8*)(lds + PG8_SA(b, h) + aoff + m * 2048 + k * 1024); } while (0)
#define PG8_LDB(dst, b, h) do { _Pragma("unroll") for (int n = 0; n < 2; ++n) _Pragma("unroll") for (int k = 0; k < 2; ++k) dst[n][k] = *(const PG8_LAS bf16x8*)(lds + PG8_SB(b, h) + boff + n * 2048 + k * 1024); } while (0)
#define PG8_MMA(ai, bj, At, Bt) do { __builtin_amdgcn_s_setprio(1); _Pragma("unroll") for (int m = 0; m < 4; ++m) _Pragma("unroll") for (int n = 0; n < 2; ++n) _Pragma("unroll") for (int k = 0; k < 2; ++k) \
        acc[ai][bj][m][n] = __builtin_amdgcn_mfma_f32_16x16x32_bf16(Bt[n][k], At[m][k], acc[ai][bj][m][n], 0, 0, 0); __builtin_amdgcn_s_setprio(0); } while (0)
#define PG8_WAIT_V(n) asm volatile("s_waitcnt vmcnt(" #n ")" ::: "memory")
#define PG8_WAIT_L(n) asm volatile("s_waitcnt lgkmcnt(" #n ")" ::: "memory")
#define PG8_BAR __builtin_amdgcn_s_barrier()
#define PG8_SCHED __builtin_amdgcn_sched_barrier(0)
    Unit cur, nxt; int ui = 0;
    if (!S.next(0, cur)) return;
    f32x4 acc[2][2][4][2];
#pragma unroll
    for (int a = 0; a < 2; ++a)
#pragma unroll
        for (int b = 0; b < 2; ++b)
#pragma unroll
            for (int m = 0; m < 4; ++m)
#pragma unroll
                for (int n = 0; n < 2; ++n) acc[a][b][m][n] = (f32x4){0.f, 0.f, 0.f, 0.f};
    bf16x8 At[4][2], B0[2][2], B1[2][2];
    const char* cA = (const char*)g.A + (size_t)cur.pm * tstep; const char* cB = (const char*)g.Bt + (size_t)cur.pn * tstep;
    S.a_ready(cur);
    if constexpr (SP2) {
        PG8_STAGE(PG8_SB(0, 0), cB, voffB); PG8_STAGE(PG8_SB(0, 1), cB + hstep, voffB); PG8_STAGE(PG8_SA(0, 0), cA, voffA); PG8_STAGE(PG8_SA(0, 1), cA + hstep, voffA);
        if (wr == 1) PG8_BAR;
        PG8_WAIT_V(2); PG8_BAR;
        PG8_STAGE(PG8_SB(1, 0), cB + kstep, voffB); PG8_STAGE(PG8_SA(1, 0), cA + kstep, voffA); PG8_STAGE(PG8_SB(1, 1), cB + hstep + kstep, voffB);
        PG8_WAIT_V(6); PG8_BAR;
    } else {
        PG8_STAGE(PG8_SB(0, 0), cB, voffB); PG8_STAGE(PG8_SA(0, 0), cA, voffA); PG8_STAGE(PG8_SB(0, 1), cB + hstep, voffB); PG8_STAGE(PG8_SA(0, 1), cA + hstep, voffA);
        if (wr == 1) PG8_BAR;
        PG8_WAIT_V(4); PG8_BAR;
        PG8_STAGE(PG8_SB(1, 0), cB + kstep, voffB); PG8_STAGE(PG8_SA(1, 0), cA + kstep, voffA); PG8_STAGE(PG8_SB(1, 1), cB + hstep + kstep, voffB);
        PG8_WAIT_V(6); PG8_BAR;
    }
    for (;;) {
        const bool has_next = S.next(ui + 1, nxt);
        const char* nA = has_next ? (const char*)g.A + (size_t)nxt.pm * tstep : cA; const char* nB = has_next ? (const char*)g.Bt + (size_t)nxt.pn * tstep : cB;
        for (int t = 0; t < nt; t += 2) {
            const bool last = (t == nt - 2);
            const char* a1 = cA + (size_t)(t + 1) * kstep;
            const char* a2 = last ? nA : cA + (size_t)(t + 2) * kstep; const char* b2 = last ? nB : cB + (size_t)(t + 2) * kstep;
            const char* a3 = a2 + kstep; const char* b3 = b2 + kstep;
            if (last && has_next) S.a_ready(nxt);
            if constexpr (SP2) {
            PG8_LDB(B0, 0, 0); PG8_LDB(B1, 0, 1); PG8_SCHED; PG8_LDA(At, 0, 0); PG8_STAGE(PG8_SA(1, 1), a1 + hstep, voffA);
            PG8_WAIT_V(8); PG8_WAIT_L(0); PG8_BAR; PG8_MMA(0, 0, At, B0); PG8_MMA(0, 1, At, B1); PG8_BAR; PG8_SCHED;
            PG8_LDA(At, 0, 1); PG8_STAGE(PG8_SB(0, 0), b2, voffB); PG8_STAGE(PG8_SB(0, 1), b2 + hstep, voffB); PG8_STAGE(PG8_SA(0, 0), a2, voffA);
            PG8_WAIT_V(8); PG8_WAIT_L(0); PG8_BAR; PG8_MMA(1, 0, At, B0); PG8_MMA(1, 1, At, B1); PG8_BAR; PG8_SCHED;
            PG8_LDB(B0, 1, 0); PG8_LDB(B1, 1, 1); PG8_SCHED; PG8_LDA(At, 1, 0); PG8_STAGE(PG8_SA(0, 1), a2 + hstep, voffA);
            PG8_WAIT_V(8); PG8_WAIT_L(0); PG8_BAR; PG8_MMA(0, 0, At, B0); PG8_MMA(0, 1, At, B1); PG8_BAR; PG8_SCHED;
            PG8_LDA(At, 1, 1); PG8_STAGE(PG8_SB(1, 0), b3, voffB); PG8_STAGE(PG8_SB(1, 1), b3 + hstep, voffB); PG8_STAGE(PG8_SA(1, 0), a3, voffA);
            PG8_WAIT_V(8); PG8_WAIT_L(0); PG8_BAR; PG8_MMA(1, 0, At, B0); PG8_MMA(1, 1, At, B1); PG8_BAR; PG8_SCHED;
            } else {
            PG8_LDB(B0, 0, 0); PG8_SCHED; PG8_LDA(At, 0, 0); PG8_STAGE(PG8_SA(1, 1), a1 + hstep, voffA);
            PG8_WAIT_L(8); PG8_BAR; PG8_WAIT_L(0); PG8_MMA(0, 0, At, B0); PG8_BAR; PG8_SCHED;
            PG8_LDB(B1, 0, 1); PG8_STAGE(PG8_SB(0, 0), b2, voffB);
            PG8_BAR; PG8_WAIT_L(0); PG8_MMA(0, 1, At, B1); PG8_BAR;
            PG8_LDA(At, 0, 1); PG8_STAGE(PG8_SA(0, 0), a2, voffA);
            PG8_BAR; PG8_WAIT_L(0); PG8_MMA(1, 0, At, B0); PG8_BAR; PG8_SCHED;
            PG8_STAGE(PG8_SB(0, 1), b2 + hstep, voffB);
            PG8_WAIT_V(6); PG8_BAR; PG8_MMA(1, 1, At, B1); PG8_BAR;
            PG8_LDB(B0, 1, 0); PG8_SCHED; PG8_LDA(At, 1, 0); PG8_STAGE(PG8_SA(0, 1), a2 + hstep, voffA);
            PG8_WAIT_L(8); PG8_BAR; PG8_WAIT_L(0); PG8_MMA(0, 0, At, B0); PG8_BAR; PG8_SCHED;
            PG8_LDB(B1, 1, 1); PG8_STAGE(PG8_SB(1, 0), b3, voffB);
            PG8_BAR; PG8_WAIT_L(0); PG8_MMA(0, 1, At, B1); PG8_BAR;
            PG8_LDA(At, 1, 1); PG8_STAGE(PG8_SA(1, 0), a3, voffA);
            PG8_BAR; PG8_WAIT_L(0); PG8_MMA(1, 0, At, B0); PG8_BAR; PG8_SCHED;
            PG8_STAGE(PG8_SB(1, 1), b3 + hstep, voffB);
            PG8_WAIT_V(6); PG8_BAR; PG8_MMA(1, 1, At, B1); PG8_BAR;
            }
        }
        if constexpr (ALIGN_EPI) { if (wr == 0) PG8_BAR; }
        if constexpr (!Epi::AFTER_DRAIN) { E(acc, cur, wr, wc, fr, fq); S.done(cur); }
        if (!has_next) break;
#pragma unroll
        for (int a = 0; a < 2; ++a)
#pragma unroll
            for (int b = 0; b < 2; ++b)
#pragma unroll
                for (int m = 0; m < 4; ++m)
#pragma unroll
                    for (int n = 0; n < 2; ++n) acc[a][b][m][n] = (f32x4){0.f, 0.f, 0.f, 0.f};
        cur = nxt; cA = nA; cB = nB; ++ui;
        if constexpr (ALIGN_EPI) { if (wr == 1) PG8_BAR; }
    }
    PG8_WAIT_V(0);
    if constexpr (!ALIGN_EPI) { if (wr == 0) PG8_BAR; }
    PG8_BAR;
    if constexpr (Epi::AFTER_DRAIN) { E.fused(acc, cur, wr, wc, fr, fq, lds, wid, lane); S.done(cur); }
#undef PG8_SA
#undef PG8_SB
#undef PG8_STAGE
#undef PG8_LDA
#undef PG8_LDB
#undef PG8_MMA
#undef PG8_WAIT_V
#undef PG8_WAIT_L
#undef PG8_BAR
#undef PG8_SCHED
}
}

#define LAS __attribute__((address_space(3)))
typedef unsigned short bf16_t;
typedef short bf16x8 __attribute__((ext_vector_type(8)));
typedef float f32x4 __attribute__((ext_vector_type(4)));
typedef float f32x16 __attribute__((ext_vector_type(16)));
typedef unsigned u32x4 __attribute__((ext_vector_type(4)));
typedef unsigned u32x2 __attribute__((ext_vector_type(2)));
using pg8::cvt_pk_bf16;

constexpr int NWAVES = 8, NTHR = 512;
constexpr int DM = 1024, DFF = 2816, SEQ = 4096, NB = 16, NBS = 32, DSEQ = 64;
constexpr int MP = NB * SEQ, MS = NBS * DSEQ, MT = MP + MS;
constexpr int NBLK64 = MT / 64;
constexpr float EPS = 1e-6f, LOG2E = 1.4426950408889634f;
constexpr int LDS_BYTES = 147456;

constexpr size_t OUT_Y = 0;
constexpr size_t OUT_MK = (size_t)MT * DM;
constexpr size_t OUT_MV = OUT_MK + (size_t)4 * 16 * 256 * 512;
constexpr size_t OUT_BK = OUT_MV + (size_t)4 * 16 * 256 * 512;
constexpr size_t OUT_BV = OUT_BK + (size_t)16 * 512 * 512;
constexpr size_t OUT_CP = OUT_BV + (size_t)16 * 512 * 512;
constexpr size_t OUT_AV = OUT_CP + (size_t)4 * 16 * 2 * DFF;
constexpr size_t OUT_SK = OUT_AV + (size_t)2 * 32 * 64 * 512;
constexpr size_t OUT_SV = OUT_SK + (size_t)32 * 64 * 512;
constexpr size_t OUT_CS = OUT_SV + (size_t)32 * 64 * 512;
constexpr size_t OUT_END = OUT_CS + (size_t)4 * 32 * 2 * DFF;

constexpr size_t al256(size_t x) { return (x + 255) & ~(size_t)255; }
constexpr size_t WS_BAR = 0, BAR_BYTES = 16384;
constexpr size_t WS_SSQ = BAR_BYTES;
constexpr size_t WS_RMEM = al256(WS_SSQ + (size_t)11 * MT * 4);
constexpr size_t WS_WINA = al256(WS_RMEM + 4096 * 4);
constexpr size_t WS_WB = WS_WINA + (size_t)2 * 1536 * 1024 * 2;
constexpr size_t WS_WMEM = WS_WB + (size_t)3072 * 1024 * 2;
constexpr size_t WS_WOUT = WS_WMEM + (size_t)4096 * 1024 * 2;
constexpr size_t WS_WUP = WS_WOUT + (size_t)4096 * 1024 * 2;
constexpr size_t WS_WDOWN = WS_WUP + (size_t)4 * 5632 * 1024 * 2;
constexpr size_t WS_WSB = WS_WDOWN + (size_t)4 * 1024 * 2816 * 2;
constexpr size_t WS_MPB = WS_WSB + (size_t)2 * 8 * 128 * 128 * 2;
constexpr size_t WS_HB = WS_MPB + (size_t)4096 * 1024 * 2;
constexpr size_t WS_MEMK = WS_HB + (size_t)MT * 1024 * 2;
constexpr size_t WS_MEMVT = WS_MEMK + (size_t)4 * 48 * 256 * 512 * 2;
constexpr size_t WS_PK = WS_MEMVT + (size_t)4 * 48 * 256 * 512 * 2;
constexpr size_t WS_PVT = WS_PK + (size_t)MP * 512 * 2;
constexpr size_t WS_SK = WS_PVT + (size_t)MP * 512 * 2;
constexpr size_t WS_SVT = WS_SK + (size_t)32 * 576 * 512 * 2;
constexpr size_t WS_TAIL = WS_SVT + (size_t)32 * 576 * 512 * 2;
constexpr size_t WS_HEAD = WS_TAIL + (size_t)NBLK64 * 2 * DFF * 4;
constexpr size_t WS_OVL = WS_HEAD + (size_t)NBLK64 * 4 * DFF * 4;
constexpr size_t WS_ACT = WS_OVL;
constexpr size_t WS_U = WS_OVL;
constexpr size_t WS_VT = WS_U + (size_t)MT * 512 * 2;
constexpr size_t WS_QM = WS_VT + (size_t)MT * 512 * 2;
constexpr size_t WS_CAT = WS_QM + (size_t)MT * 512 * 2;
constexpr size_t WS_END = WS_OVL + (size_t)MT * DFF * 2;
static_assert(WS_CAT + (size_t)MT * 1024 * 2 <= WS_END, "overlay");
static_assert(WS_END <= (size_t)1073741824, "workspace budget");

__device__ __forceinline__ float bf2f(unsigned short b) { return __builtin_bit_cast(float, (unsigned)b << 16); }
__device__ __forceinline__ unsigned short f2bf(float f) { unsigned u = __builtin_bit_cast(unsigned, f); return (unsigned short)((u + 0x7fffu + ((u >> 16) & 1u)) >> 16); }
__device__ __forceinline__ float gelu_t(float x) {
    const float t = x * (1.0f + 0.044715f * x * x);
    const float e = __builtin_amdgcn_exp2f(-2.302208198f * t);
    return x * __builtin_amdgcn_rcpf(1.0f + e);
}
__device__ __forceinline__ float rs_from(float ssq, float invn) { return rsqrtf(ssq * invn + EPS); }
__device__ __forceinline__ u32x4 pack8(const f32x4& a, const f32x4& b) { u32x4 w; w.x = cvt_pk_bf16(a[0], a[1]); w.y = cvt_pk_bf16(a[2], a[3]); w.z = cvt_pk_bf16(b[0], b[1]); w.w = cvt_pk_bf16(b[2], b[3]); return w; }
__device__ __forceinline__ float wave_sum(float v) {
#pragma unroll
    for (int o = 1; o < 64; o <<= 1) v += __shfl_xor(v, o);
    return v;
}
#define MFMA32(a, b, c) __builtin_amdgcn_mfma_f32_32x32x16_bf16((a), (b), (c), 0, 0, 0)
__device__ __forceinline__ int crow(int r, int hi) { return (r & 3) + 8 * (r >> 2) + 4 * hi; }

typedef f32x4 AccT[2][2][4][2];

struct EpiInA {
    static constexpr bool PERM = true, AFTER_DRAIN = false;
    const float* ssq; bf16_t* U; bf16_t* VT; bf16_t* QM; float* ssqv; float qscale;
    __device__ __forceinline__ void operator()(const AccT& acc, const pg8::Unit& u, int wr, int wc, int fr, int fq) const {
        const int row0 = u.pm * 256 + wr * 64 + fr; const int ty = u.pn >> 1; const int cb = (u.pn & 1) * 256 + wc * 32 + 8 * fq;
#pragma unroll
        for (int ai = 0; ai < 2; ++ai)
#pragma unroll
            for (int m = 0; m < 4; ++m) {
                const int row = row0 + ai * 128 + m * 16; const float r = rs_from(ssq[row], 1.0f / 1024.0f);
                if (ty == 0) {
#pragma unroll
                    for (int bj = 0; bj < 2; ++bj) { f32x4 a = acc[ai][bj][m][0] * r, b = acc[ai][bj][m][1] * r;
#pragma unroll
                        for (int e = 0; e < 4; ++e) { a[e] = gelu_t(a[e]); b[e] = gelu_t(b[e]); }
                        *(u32x4*)(U + (size_t)row * 512 + cb + bj * 128) = pack8(a, b); }
                } else if (ty == 2) {
                    const float s = r * qscale;
#pragma unroll
                    for (int bj = 0; bj < 2; ++bj) { f32x4 a = acc[ai][bj][m][0] * s, b = acc[ai][bj][m][1] * s;
                        *(u32x4*)(QM + (size_t)row * 512 + cb + bj * 128) = pack8(a, b); }
                } else {
                    float ss = 0.f; bf16_t* vt = VT + (size_t)(row >> 7) * 512 * 128 + (row & 127);
#pragma unroll
                    for (int bj = 0; bj < 2; ++bj)
#pragma unroll
                        for (int n = 0; n < 2; ++n)
#pragma unroll
                            for (int e = 0; e < 4; ++e) { const unsigned short hb = f2bf(gelu_t(acc[ai][bj][m][n][e] * r)); const float vr = bf2f(hb); ss += vr * vr;
                                vt[(size_t)(cb + bj * 128 + 4 * n + e) * 128] = hb; }
                    ss += __shfl_xor(ss, 16); ss += __shfl_xor(ss, 32);
                    if (fq == 0) atomicAdd(ssqv + row, ss);
                }
            }
    }
};

struct EpiInB {
    static constexpr bool PERM = true, AFTER_DRAIN = false;
    const float* ssq; bf16_t* Q; bf16_t* QM; bf16_t* PK; bf16_t* PVT; bf16_t* SK; bf16_t* SVT; float* out; float qscale, mscale;
    __device__ __forceinline__ void operator()(const AccT& acc, const pg8::Unit& u, int wr, int wc, int fr, int fq) const {
        const int row0 = u.pm * 256 + wr * 64 + fr; const int ty = u.pn >> 1; const int cb = (u.pn & 1) * 256 + wc * 32 + 8 * fq;
        const bool samp = u.pm >= 256;
#pragma unroll
        for (int ai = 0; ai < 2; ++ai)
#pragma unroll
            for (int m = 0; m < 4; ++m) {
                const int row = row0 + ai * 128 + m * 16; const float r = rs_from(ssq[row], 1.0f / 1024.0f);
                if (ty < 2) {
                    const float s = r * (ty == 0 ? qscale : mscale); bf16_t* dst = (ty == 0 ? Q : QM) + (size_t)row * 512 + cb;
#pragma unroll
                    for (int bj = 0; bj < 2; ++bj) { f32x4 a = acc[ai][bj][m][0] * s, b = acc[ai][bj][m][1] * s; *(u32x4*)(dst + bj * 128) = pack8(a, b); }
                } else if (ty == 2) {
                    bf16_t* dst; float* fo = nullptr;
                    if (!samp) { dst = PK + (size_t)row * 512 + cb; const int t = row & 4095; if (t >= 3584) fo = out + OUT_BK + ((size_t)(row >> 12) * 512 + (t - 3584)) * 512 + cb; }
                    else { const int rs = row - MP, bs = rs >> 6, t = rs & 63; dst = SK + ((size_t)bs * 576 + 512 + t) * 512 + cb; fo = out + OUT_SK + (size_t)rs * 512 + cb; }
#pragma unroll
                    for (int bj = 0; bj < 2; ++bj) { f32x4 a = acc[ai][bj][m][0] * r, b = acc[ai][bj][m][1] * r; *(u32x4*)(dst + bj * 128) = pack8(a, b);
                        if (fo) { *(f32x4*)(fo + bj * 128) = a; *(f32x4*)(fo + bj * 128 + 4) = b; } }
                } else {
                    bf16_t* dst; size_t cst; float* fo = nullptr;
                    if (!samp) { const int b = row >> 12, t = row & 4095; dst = PVT + (size_t)b * 512 * 4096 + t; cst = 4096; if (t >= 3584) fo = out + OUT_BV + ((size_t)b * 512 + (t - 3584)) * 512 + cb; }
                    else { const int rs = row - MP, bs = rs >> 6, t = rs & 63; dst = SVT + (size_t)bs * 512 * 576 + 512 + t; cst = 576; fo = out + OUT_SV + (size_t)rs * 512 + cb; }
#pragma unroll
                    for (int bj = 0; bj < 2; ++bj) { f32x4 a = acc[ai][bj][m][0] * r, b = acc[ai][bj][m][1] * r;
#pragma unroll
                        for (int e = 0; e < 4; ++e) { dst[(size_t)(cb + bj * 128 + e) * cst] = f2bf(a[e]); dst[(size_t)(cb + bj * 128 + 4 + e) * cst] = f2bf(b[e]); }
                        if (fo) { *(f32x4*)(fo + bj * 128) = a; *(f32x4*)(fo + bj * 128 + 4) = b; } }
                }
            }
    }
};

struct EpiRes {
    static constexpr bool PERM = true, AFTER_DRAIN = false;
    const float* res_p; const float* res_s; float* hout; bf16_t* hb; float* ssq_next;
    __device__ __forceinline__ void operator()(const AccT& acc, const pg8::Unit& u, int wr, int wc, int fr, int fq) const {
        const int row0 = u.pm * 256 + wr * 64 + fr; const int cb = u.pn * 256 + wc * 32 + 8 * fq;
        const float* rin = (u.pm < 256) ? res_p : res_s;
#pragma unroll
        for (int ai = 0; ai < 2; ++ai)
#pragma unroll
            for (int m = 0; m < 4; ++m) {
                const int row = row0 + ai * 128 + m * 16; float ss = 0.f;
#pragma unroll
                for (int bj = 0; bj < 2; ++bj) { const size_t o = (size_t)row * 1024 + cb + bj * 128;
                    f32x4 a = *(const f32x4*)(rin + o) + acc[ai][bj][m][0], b = *(const f32x4*)(rin + o + 4) + acc[ai][bj][m][1];
                    *(f32x4*)(hout + o) = a; *(f32x4*)(hout + o + 4) = b; *(u32x4*)(hb + o) = pack8(a, b);
                    ss += (a[0] * a[0] + a[1] * a[1]) + (a[2] * a[2] + a[3] * a[3]) + (b[0] * b[0] + b[1] * b[1]) + (b[2] * b[2] + b[3] * b[3]); }
                ss += __shfl_xor(ss, 16); ss += __shfl_xor(ss, 32);
                if (fq == 0) atomicAdd(ssq_next + row, ss);
            }
    }
};

struct EpiUp {
    static constexpr bool PERM = true, AFTER_DRAIN = false;
    const float* ssq; const float* cw; const float* cbias; bf16_t* ACT; float* tail; float* head;
    __device__ __forceinline__ void operator()(const AccT& acc, const pg8::Unit& u, int wr, int wc, int fr, int fq) const {
        const int f0 = u.pn * 128 + wc * 32 + 8 * fq; const int lane = fq * 16 + fr;
        const int s1 = (lane & 48) | ((fr - 1) & 15), s2 = (lane & 48) | ((fr - 2) & 15);
        f32x4 w0[2], w1[2], w2[2], bb[2];
#pragma unroll
        for (int n = 0; n < 2; ++n) { w0[n] = *(const f32x4*)(cw + f0 + 4 * n); w1[n] = *(const f32x4*)(cw + DFF + f0 + 4 * n); w2[n] = *(const f32x4*)(cw + 2 * DFF + f0 + 4 * n); bb[n] = *(const f32x4*)(cbias + f0 + 4 * n); }
#pragma unroll
        for (int ai = 0; ai < 2; ++ai) {
            const int blk = u.pm * 4 + ai * 2 + wr; const int rowb = blk * 64;
            f32x4 p1[2], p2[2];
#pragma unroll
            for (int n = 0; n < 2; ++n) { p1[n] = (f32x4){0.f, 0.f, 0.f, 0.f}; p2[n] = p1[n]; }
#pragma unroll
            for (int m = 0; m < 4; ++m) {
                const int row = rowb + 16 * m + fr; const float r = rs_from(ssq[row], 1.0f / 1024.0f);
                f32x4 a[2], g[2], o[2], pp[2];
#pragma unroll
                for (int n = 0; n < 2; ++n) { a[n] = acc[ai][0][m][n] * r; g[n] = acc[ai][1][m][n] * r;
                    f32x4 c1, c2;
#pragma unroll
                    for (int e = 0; e < 4; ++e) { c1[e] = __shfl(a[n][e], s1); c2[e] = __shfl(a[n][e], s2); }
                    f32x4 a1, a2;
#pragma unroll
                    for (int e = 0; e < 4; ++e) { a1[e] = fr >= 1 ? c1[e] : p1[n][e]; a2[e] = fr >= 2 ? c2[e] : p2[n][e]; }
                    p1[n] = c1; p2[n] = c2;
                    if (m == 0) {
#pragma unroll
                        for (int e = 0; e < 4; ++e) { if (fr == 0) { a1[e] = 0.f; a2[e] = 0.f; } else if (fr == 1) a2[e] = 0.f; }
                    }
                    pp[n] = bb[n] + w0[n] * a2 + w1[n] * a1 + w2[n] * a[n];
#pragma unroll
                    for (int e = 0; e < 4; ++e) o[n][e] = gelu_t(pp[n][e]) * g[n][e];
                }
                if (m == 0 && fr < 2) {
                    float* hp = head + ((size_t)(blk * 2 + fr) * 2) * DFF + f0;
                    *(f32x4*)(hp) = pp[0]; *(f32x4*)(hp + 4) = pp[1]; *(f32x4*)(hp + DFF) = g[0]; *(f32x4*)(hp + DFF + 4) = g[1];
                } else {
                    *(u32x4*)(ACT + (size_t)row * DFF + f0) = pack8(o[0], o[1]);
                }
                if (m == 3 && fr >= 14) { float* tp = tail + (size_t)(blk * 2 + (fr - 14)) * DFF + f0; *(f32x4*)(tp) = a[0]; *(f32x4*)(tp + 4) = a[1]; }
            }
        }
    }
};

struct EpiMem {
    static constexpr bool PERM = true, AFTER_DRAIN = false;
    const float* rmem; float* out; bf16_t* MEMK; bf16_t* MEMVT;
    __device__ __forceinline__ void operator()(const AccT& acc, const pg8::Unit& u, int wr, int wc, int fr, int fq) const {
        const int row0 = u.pm * 256 + wr * 64 + fr; const int l = u.pn >> 2, kv = (u.pn >> 1) & 1; const int cb = (u.pn & 1) * 256 + wc * 32 + 8 * fq;
#pragma unroll
        for (int ai = 0; ai < 2; ++ai)
#pragma unroll
            for (int m = 0; m < 4; ++m) {
                const int row = row0 + ai * 128 + m * 16; const float r = rmem[row]; const int b = row >> 8, n = row & 255;
                float* fo = out + (kv ? OUT_MV : OUT_MK) + ((size_t)l * 4096 + row) * 512 + cb;
#pragma unroll
                for (int bj = 0; bj < 2; ++bj) { f32x4 x = acc[ai][bj][m][0] * r, y = acc[ai][bj][m][1] * r;
                    *(f32x4*)(fo + bj * 128) = x; *(f32x4*)(fo + bj * 128 + 4) = y;
                    if (!kv) *(u32x4*)(MEMK + (((size_t)l * 48 + b) * 256 + n) * 512 + cb + bj * 128) = pack8(x, y);
                    else { bf16_t* d = MEMVT + (((size_t)l * 48 + b) * 512 + cb + bj * 128) * 256 + n;
#pragma unroll
                        for (int e = 0; e < 4; ++e) { d[(size_t)e * 256] = f2bf(x[e]); d[(size_t)(4 + e) * 256] = f2bf(y[e]); } } }
            }
    }
};

__device__ __forceinline__ void tr_item(const float* src, int lsrc, int k0, int n0, const float* g, bf16_t* dst, int ldd, LAS float* scr, int lane) {
#pragma unroll 8
    for (int i = 0; i < 32; ++i) { const int kk = 2 * i + (lane >> 5); float v = src[(size_t)(k0 + kk) * lsrc + n0 + (lane & 31)]; if (g) v *= g[k0 + kk]; scr[kk * 33 + (lane & 31)] = v; }
    asm volatile("s_waitcnt lgkmcnt(0)" ::: "memory");
    const int c = lane & 7;
#pragma unroll
    for (int j = 0; j < 4; ++j) { const int n = (lane >> 3) + 8 * j; const LAS float* s = scr + (8 * c) * 33 + n;
        u32x4 o; o.x = cvt_pk_bf16(s[0 * 33], s[1 * 33]); o.y = cvt_pk_bf16(s[2 * 33], s[3 * 33]); o.z = cvt_pk_bf16(s[4 * 33], s[5 * 33]); o.w = cvt_pk_bf16(s[6 * 33], s[7 * 33]);
        *(u32x4*)(dst + (size_t)n * ldd + k0 + 8 * c) = o; }
    asm volatile("s_waitcnt lgkmcnt(0)" ::: "memory");
}
__device__ __forceinline__ void tr_plain(const float* src, int K, int N, const float* g, bf16_t* dst, int ldd, int item, LAS float* scr, int lane) {
    const int nblk = N / 32, kb = item / nblk, nb = item % nblk;
    tr_item(src, N, kb * 64, nb * 32, g, dst + (size_t)(nb * 32) * ldd, ldd, scr, lane);
}

struct Args { const float* in[26]; float* out; unsigned char* ws; int ph_lo, ph_hi, coop, pad; };
typedef __attribute__((address_space(4))) const Args* KArgs;

__device__ __forceinline__ void p0_prologue(KArgs a, LAS unsigned char* lds, int tid) {
    const int lane = tid & 63, wave = tid >> 6; const int G = gridDim.x;
    LAS float* scr = (LAS float*)(lds + wave * 8704);
    unsigned char* ws = a->ws;
    const int gw = blockIdx.x * NWAVES + wave, NGW = G * NWAVES;
    constexpr int I_INA = 16 * 48, I_SQ = 16 * 32, I_UP = 16 * 176, I_DN = 44 * 32, I_MV = 4 * 16, I_BV = 8 * 16;
    constexpr int N_INA = 2 * I_INA, N_B = 3 * I_SQ, N_MEM = 4 * I_SQ, N_OUT = 4 * I_SQ, N_UP = 4 * I_UP, N_DN = 4 * I_DN, N_MV = 128 * I_MV, N_BV = 32 * I_BV;
    constexpr int NITEMS = N_INA + N_B + N_MEM + N_OUT + N_UP + N_DN + N_MV + N_BV;
    for (int it = gw; it < NITEMS; it += NGW) {
        int r = it;
        if (r < N_INA) { const int l = r / I_INA; r %= I_INA; tr_plain(a->in[9] + (size_t)l * 1024 * 1536, 1024, 1536, a->in[8] + l * 1024, (bf16_t*)(ws + WS_WINA) + (size_t)l * 1536 * 1024, 1024, r, scr, lane); continue; } r -= N_INA;
        if (r < N_B) { const int s = r / I_SQ; r %= I_SQ;
            const float* src = s == 1 ? a->in[14] : a->in[15] + (size_t)(s >> 1) * 1024 * 1024; const float* g = s == 1 ? a->in[13] : a->in[8] + (2 + (s >> 1)) * 1024;
            tr_plain(src, 1024, 1024, g, (bf16_t*)(ws + WS_WB) + (size_t)s * 1024 * 1024, 1024, r, scr, lane); continue; } r -= N_B;
        if (r < N_MEM) { const int l = r / I_SQ; r %= I_SQ; tr_plain(a->in[18] + (size_t)l * 1024 * 1024, 1024, 1024, a->in[17] + l * 1024, (bf16_t*)(ws + WS_WMEM) + (size_t)l * 1024 * 1024, 1024, r, scr, lane); continue; } r -= N_MEM;
        if (r < N_OUT) { const int l = r / I_SQ; r %= I_SQ; tr_plain(a->in[19] + (size_t)l * 1024 * 1024, 1024, 1024, nullptr, (bf16_t*)(ws + WS_WOUT) + (size_t)l * 1024 * 1024, 1024, r, scr, lane); continue; } r -= N_OUT;
        if (r < N_UP) { const int l = r / I_UP; r %= I_UP; const int kb = r / 176, nb = r % 176; const int s0 = nb * 32; const int bj = s0 / DFF, f = s0 % DFF; const int drow = (f >> 7) * 256 + bj * 128 + (f & 127);
            tr_item(a->in[21] + (size_t)l * 1024 * 5632, 5632, kb * 64, s0, a->in[20] + l * 1024, (bf16_t*)(ws + WS_WUP) + ((size_t)l * 5632 + drow) * 1024, 1024, scr, lane); continue; } r -= N_UP;
        if (r < N_DN) { const int l = r / I_DN; r %= I_DN; tr_plain(a->in[24] + (size_t)l * DFF * 1024, DFF, 1024, nullptr, (bf16_t*)(ws + WS_WDOWN) + (size_t)l * 1024 * DFF, DFF, r, scr, lane); continue; } r -= N_DN;
        if (r < N_MV) { const int mi = r / I_MV; r %= I_MV; const int l = mi >> 5, bs = mi & 31;
            tr_plain(a->in[4] + (size_t)mi * 256 * 512, 256, 512, nullptr, (bf16_t*)(ws + WS_MEMVT) + ((size_t)l * 48 + 16 + bs) * 512 * 256, 256, r, scr, lane); continue; } r -= N_MV;
        { const int bs = r / I_BV; r %= I_BV; tr_plain(a->in[6] + (size_t)bs * 512 * 512, 512, 512, nullptr, (bf16_t*)(ws + WS_SVT) + (size_t)bs * 512 * 576, 576, r, scr, lane); }
    }
    for (int m = gw; m < MT + 4096; m += NGW) {
        const bool ismem = m >= MT; const int rr = ismem ? m - MT : m;
        const float* xr = ismem ? a->in[2] + (size_t)rr * 1024 : (rr < MP ? a->in[0] + (size_t)rr * 1024 : a->in[1] + (size_t)(rr - MP) * 1024);
        bf16_t* orow = (bf16_t*)(ws + (ismem ? WS_MPB : WS_HB)) + (size_t)rr * 1024;
        f32x4 v[4]; float s = 0.f;
#pragma unroll
        for (int j = 0; j < 4; ++j) { v[j] = *((const f32x4*)xr + lane + 64 * j); s += (v[j][0] * v[j][0] + v[j][1] * v[j][1]) + (v[j][2] * v[j][2] + v[j][3] * v[j][3]); }
        s = wave_sum(s);
#pragma unroll
        for (int j = 0; j < 4; ++j) { u32x2 o; o.x = cvt_pk_bf16(v[j][0], v[j][1]); o.y = cvt_pk_bf16(v[j][2], v[j][3]); *((u32x2*)orow + lane + 64 * j) = o; }
        if (lane == 0) { if (ismem) ((float*)(ws + WS_RMEM))[rr] = rs_from(s, 1.0f / 1024.0f); else ((float*)(ws + WS_SSQ))[rr] = s; }
    }
    const size_t gt = (size_t)blockIdx.x * NTHR + tid, NT = (size_t)G * NTHR;
    { float* z = (float*)(ws + WS_SSQ) + MT; for (size_t i = gt; i < (size_t)10 * MT; i += NT) z[i] = 0.f; }
    { bf16_t* wsb = (bf16_t*)(ws + WS_WSB); const float* w = a->in[11];
      for (size_t i = gt; i < (size_t)2 * 8 * 128 * 128; i += NT) { const int jj = (int)(i & 127), ii = (int)((i >> 7) & 127); wsb[i] = jj <= ii ? f2bf(w[i]) : (unsigned short)0; } }
    {
      const f32x4* src = (const f32x4*)a->in[3]; bf16_t* dst = (bf16_t*)(ws + WS_MEMK);
      for (size_t i = gt; i < (size_t)4 * 32 * 256 * 512 / 4; i += NT) { const size_t e = i * 4; const size_t mi = e / (256 * 512), rem = e % (256 * 512); const size_t l = mi >> 5, bs = mi & 31;
          const f32x4 v = src[i]; u32x2 o; o.x = cvt_pk_bf16(v[0], v[1]); o.y = cvt_pk_bf16(v[2], v[3]); *(u32x2*)(dst + ((l * 48 + 16 + bs) * 256 * 512) + rem) = o; } }
    {
      const f32x4* src = (const f32x4*)a->in[5]; bf16_t* dst = (bf16_t*)(ws + WS_SK);
      for (size_t i = gt; i < (size_t)32 * 512 * 512 / 4; i += NT) { const size_t e = i * 4; const size_t bs = e / (512 * 512), rem = e % (512 * 512);
          const f32x4 v = src[i]; u32x2 o; o.x = cvt_pk_bf16(v[0], v[1]); o.y = cvt_pk_bf16(v[2], v[3]); *(u32x2*)(dst + bs * 576 * 512 + rem) = o; } }
}

__device__ __forceinline__ void gate_unit(LAS unsigned char* lds, int tid, int chunk, int joff, int nib, int row0,
                                          const bf16_t* wsb, const bf16_t* VT, const bf16_t* U, const float* ssqv, const float* gv, const float* bs, bf16_t* CAT, float* av_out) {
    const int g = tid >> 6, lane = tid & 63, l32 = lane & 31, half = lane >> 5;
    LAS float* rv = (LAS float*)lds;
    __syncthreads();
    if (tid < nib * 32) rv[tid] = rs_from(ssqv[row0 + tid], 1.0f / 512.0f);
    __syncthreads();
    const bf16_t* vt_g = VT + ((size_t)chunk * 512 + g * 64) * 128 + joff;
    const bf16_t* w_g = wsb + (size_t)g * 128 * 128;
#pragma unroll 1
    for (int db = 0; db < 2; ++db) {
        f32x16 acc[4];
#pragma unroll
        for (int i = 0; i < 4; ++i)
#pragma unroll
            for (int e = 0; e < 16; ++e) acc[i][e] = 0.f;
        const bf16_t* vt_d = vt_g + (size_t)(db * 32 + l32) * 128 + half * 8;
        const bf16_t* w_d = w_g + (size_t)l32 * 128 + half * 8;
#pragma unroll
        for (int ks = 0; ks < 8; ++ks) {
            if (ks < nib * 2) {
                const int j0 = ks * 16 + half * 8;
                const u32x4 raw = *(const u32x4*)(vt_d + ks * 16);
                u32x4 sc;
#pragma unroll
                for (int q = 0; q < 4; ++q) { const float lo = __builtin_bit_cast(float, raw[q] << 16) * rv[j0 + 2 * q], hi = __builtin_bit_cast(float, raw[q] & 0xffff0000u) * rv[j0 + 2 * q + 1]; sc[q] = cvt_pk_bf16(lo, hi); }
                const bf16x8 bfr = __builtin_bit_cast(bf16x8, sc);
#pragma unroll
                for (int ib = 0; ib < 4; ++ib) {
                    if (ib < nib && ks < (ib + 1) * 2) {
                        const bf16x8 af = *(const bf16x8*)(w_d + ib * 32 * 128 + ks * 16);
                        acc[ib] = MFMA32(af, bfr, acc[ib]);
                    }
                }
            }
        }
        const int c = g * 64 + db * 32 + l32; const float gvc = gv[c];
        const bf16_t* ub = U + ((size_t)row0 + 4 * half) * 512 + c; bf16_t* cbp = CAT + ((size_t)row0 + 4 * half) * 1024 + c; const float* bsp = bs + g * 128 + 4 * half;
#pragma unroll
        for (int ib = 0; ib < 4; ++ib) {
            if (ib < nib) {
#pragma unroll
                for (int e = 0; e < 16; ++e) { const int i = ib * 32 + (e & 3) + 8 * (e >> 2);
                    const float s = acc[ib][e] * gvc + bsp[i];
                    cbp[(size_t)i * 1024] = f2bf(bf2f(ub[(size_t)i * 512]) * s); }
            }
        }
    }
    if (av_out) {
        for (int e = tid; e < 64 * 512; e += NTHR) { const int t = e >> 9, c = e & 511; av_out[e] = bf2f(VT[((size_t)chunk * 512 + c) * 128 + joff + t]) * rv[t] * gv[c]; }
    }
}

template <int D, bool BAND>
__device__ __forceinline__ void attn_unit(LAS unsigned char* lds, int tid, const bf16_t* Qw, bool hasq, const bf16_t* Kb, int ldk, const bf16_t* Vtb, int ldv,
                                          int jstart, int nkb, int jlo, int jhi, bf16_t* Ow, LAS const float* btab, int relq) {
    constexpr int KROW = (D + 8) * 2, VROW = 144, KBYTES = 64 * KROW, VBYTES = D * VROW, BUF = KBYTES + VBYTES, NR = D / 64, KK = D / 16, DB = D / 32;
    const int lane = tid & 63, l32 = lane & 31, half = lane >> 5;
    bf16x8 qf[KK];
#pragma unroll
    for (int kk = 0; kk < KK; ++kk) qf[kk] = hasq ? *(const bf16x8*)(Qw + (size_t)l32 * 512 + kk * 16 + half * 8) : (bf16x8){0, 0, 0, 0, 0, 0, 0, 0};
    f32x16 O[DB];
#pragma unroll
    for (int d = 0; d < DB; ++d)
#pragma unroll
        for (int e = 0; e < 16; ++e) O[d][e] = 0.f;
    float mrun = -1e30f, lsum = 0.f;
    u32x4 kreg[NR], vreg[NR];
    auto gload = [&](int j) {
#pragma unroll
        for (int i = 0; i < NR; ++i) { const int id = tid + i * NTHR; const int kr = id / (D / 8), kc = id % (D / 8); kreg[i] = *(const u32x4*)(Kb + (long)(j * 64 + kr) * ldk + kc * 8);
            const int vr = id >> 3, vc = id & 7; vreg[i] = *(const u32x4*)(Vtb + (long)vr * ldv + j * 64 + vc * 8); }
    };
    auto lstore = [&](int buf) {
        LAS unsigned char* b = lds + buf * BUF;
#pragma unroll
        for (int i = 0; i < NR; ++i) { const int id = tid + i * NTHR; const int kr = id / (D / 8), kc = id % (D / 8); *(LAS u32x4*)(b + kr * KROW + kc * 16) = kreg[i];
            const int vr = id >> 3, vc = id & 7; *(LAS u32x4*)(b + KBYTES + vr * VROW + vc * 16) = vreg[i]; }
    };
    __syncthreads();
    gload(jstart); lstore(0);
    __syncthreads();
    for (int j = jstart; j < nkb; ++j) {
        const int cur = (j - jstart) & 1;
        if (j + 1 < nkb) gload(j + 1);
        if (hasq && j >= jlo && j <= jhi) {
            const LAS unsigned char* b = lds + cur * BUF;
            f32x16 S[2];
#pragma unroll
            for (int s = 0; s < 2; ++s) {
#pragma unroll
                for (int e = 0; e < 16; ++e) S[s][e] = 0.f;
#pragma unroll
                for (int kk = 0; kk < KK; ++kk) { const bf16x8 af = *(const LAS bf16x8*)(b + (s * 32 + l32) * KROW + (kk * 16 + half * 8) * 2); S[s] = MFMA32(af, qf[kk], S[s]); }
                if (BAND) {
#pragma unroll
                    for (int e = 0; e < 16; ++e) { const int kidx = j * 64 + s * 32 + crow(e, half); int rel = relq - kidx; rel = rel > 256 ? 256 : rel; S[s][e] += btab[rel + 63]; }
                }
            }
            float mx = S[0][0];
#pragma unroll
            for (int e = 1; e < 16; ++e) mx = fmaxf(mx, S[0][e]);
#pragma unroll
            for (int e = 0; e < 16; ++e) mx = fmaxf(mx, S[1][e]);
            mx = fmaxf(mx, __shfl_xor(mx, 32));
            const float mnew = fmaxf(mrun, mx); const float alpha = __builtin_amdgcn_exp2f(mrun - mnew); mrun = mnew;
            float ps = 0.f;
#pragma unroll
            for (int s = 0; s < 2; ++s)
#pragma unroll
                for (int e = 0; e < 16; ++e) { const float p = __builtin_amdgcn_exp2f(S[s][e] - mnew); S[s][e] = p; ps += p; }
            lsum = lsum * alpha + ps;
#pragma unroll
            for (int d = 0; d < DB; ++d)
#pragma unroll
                for (int e = 0; e < 16; ++e) O[d][e] *= alpha;
#pragma unroll
            for (int s = 0; s < 2; ++s)
#pragma unroll
                for (int t = 0; t < 2; ++t) {
                    u32x4 pk;
#pragma unroll
                    for (int q = 0; q < 4; ++q) pk[q] = cvt_pk_bf16(S[s][8 * t + 2 * q], S[s][8 * t + 2 * q + 1]);
                    const bf16x8 pb = __builtin_bit_cast(bf16x8, pk);
#pragma unroll
                    for (int d = 0; d < DB; ++d) {
                        const LAS unsigned char* vp = b + KBYTES + (d * 32 + l32) * VROW + (s * 32 + 16 * t + 4 * half) * 2;
                        const u32x2 v0 = *(const LAS u32x2*)vp, v1 = *(const LAS u32x2*)(vp + 16);
                        const u32x4 vv = {v0.x, v0.y, v1.x, v1.y};
                        O[d] = MFMA32(__builtin_bit_cast(bf16x8, vv), pb, O[d]);
                    }
                }
        }
        if (j + 1 < nkb) lstore(cur ^ 1);
        __syncthreads();
    }
    if (hasq) {
        const float l = lsum + __shfl_xor(lsum, 32); const float inv = 1.0f / l;
#pragma unroll
        for (int d = 0; d < DB; ++d)
#pragma unroll
            for (int gq = 0; gq < 4; ++gq) {
                u32x2 o; o.x = cvt_pk_bf16(O[d][4 * gq] * inv, O[d][4 * gq + 1] * inv); o.y = cvt_pk_bf16(O[d][4 * gq + 2] * inv, O[d][4 * gq + 3] * inv);
                *(u32x2*)(Ow + (size_t)l32 * 1024 + d * 32 + 8 * gq + 4 * half) = o;
            }
    }
}

__device__ __forceinline__ void mixer_phase(KArgs a, LAS unsigned char* lds, int tid_in, int l) {
    unsigned char* ws = a->ws; const int G = gridDim.x;
    bf16_t* CAT = (bf16_t*)(ws + WS_CAT);
    constexpr int N_MEMP = 16 * 16 * 4, N_MEMS = 32 * 4;
#ifndef NO_MEMATT
    {
        int tid = tid_in; asm volatile("" : "+v"(tid)); const int wave = tid >> 6;
        const bf16_t* QM = (const bf16_t*)(ws + WS_QM);
        for (int it = blockIdx.x; it < N_MEMP + N_MEMS; it += G) {
            int r = it; int bb, h, q0, nq;
            if (r < N_MEMP) { h = r & 3; const int qb = (r >> 2) & 15; bb = r >> 6; q0 = bb * SEQ + qb * 256; nq = 256; }
            else { r -= N_MEMP; h = r & 3; const int bs = r >> 2; bb = 16 + bs; q0 = MP + bs * 64; nq = 64; }
            const bool hasq = wave * 32 < nq; const int qrow = q0 + wave * 32;
            attn_unit<128, false>(lds, tid, QM + (size_t)qrow * 512 + h * 128, hasq, (const bf16_t*)(ws + WS_MEMK) + ((size_t)l * 48 + bb) * 256 * 512 + h * 128, 512,
                                  (const bf16_t*)(ws + WS_MEMVT) + (((size_t)l * 48 + bb) * 512 + h * 128) * 256, 256, 0, 4, 0, 3, CAT + (size_t)qrow * 1024 + 512 + h * 128, nullptr, 0);
        }
    }
#endif
    if (l < 2) {
#ifndef NO_GATE
        int tid = tid_in; asm volatile("" : "+v"(tid));
        for (int r = blockIdx.x; r < 512 + 32; r += G) {
            int chunk, joff, nib, row0; float* av = nullptr;
            if (r < 512) { chunk = r; joff = 0; nib = 4; row0 = r * 128; }
            else { const int bs = r - 512; chunk = 512 + (bs >> 1); joff = (bs & 1) * 64; nib = 2; row0 = MP + bs * 64; av = a->out + OUT_AV + ((size_t)l * 32 + bs) * 64 * 512; }
            gate_unit(lds, tid, chunk, joff, nib, row0, (const bf16_t*)(ws + WS_WSB) + (size_t)l * 8 * 128 * 128, (const bf16_t*)(ws + WS_VT), (const bf16_t*)(ws + WS_U),
                      (const float*)(ws + WS_SSQ) + (size_t)(9 + l) * MT, a->in[10] + l * 512, a->in[12] + l * 8 * 128, CAT, av);
        }
#endif
    } else {
#ifndef NO_BAND
        int tid = tid_in; asm volatile("" : "+v"(tid)); const int wave = tid >> 6;
        const int jl = l - 2; const bf16_t* Q = (const bf16_t*)(ws + WS_U);
        LAS float* btab = (LAS float*)(lds + 40960);
        for (int it = blockIdx.x; it < 16 * 8 * 16 + 32 * 8; it += G) {
            int r = it;
            int h, qrow, jstart, nkb, jlo, jhi, relq; const bf16_t* Kb; const bf16_t* Vtb; int ldv; bool hasq;
            if (r < 16 * 8 * 16) { h = r & 7; const int cg4 = (r >> 3) & 15; const int b = r >> 7; const int c0 = cg4 * 4;
                qrow = b * SEQ + c0 * 64 + wave * 32; hasq = true; nkb = 12; jstart = c0 >= 8 ? 0 : 8 - c0; jlo = wave >> 1; jhi = jlo + 8;
                Kb = (const bf16_t*)(ws + WS_PK) + ((long)b * SEQ + (long)(c0 - 8) * 64) * 512 + h * 64;
                Vtb = (const bf16_t*)(ws + WS_PVT) + ((long)b * 512 + h * 64) * 4096 + (long)(c0 - 8) * 64; ldv = 4096;
                relq = 512 + (wave >> 1) * 64 + (wave & 1) * 32 + (tid & 31); }
            else { r -= 16 * 8 * 16; h = r & 7; const int bs = r >> 3; qrow = MP + bs * 64 + wave * 32; hasq = wave < 2; nkb = 9; jstart = 0; jlo = 0; jhi = 8;
                Kb = (const bf16_t*)(ws + WS_SK) + (size_t)bs * 576 * 512 + h * 64; Vtb = (const bf16_t*)(ws + WS_SVT) + ((size_t)bs * 512 + h * 64) * 576; ldv = 576;
                relq = 512 + (wave & 1) * 32 + (tid & 31); }
            __syncthreads();
            if (tid < 320) btab[tid] = a->in[16][((size_t)jl * 8 + h) * 513 + 193 + tid] * LOG2E;
            attn_unit<64, true>(lds, tid, Q + (size_t)qrow * 512 + h * 64, hasq, Kb, 512, Vtb, ldv, jstart, nkb, jlo, jhi, CAT + (size_t)qrow * 1024 + h * 64, btab, relq);
        }
#endif
    }
}

__device__ __forceinline__ void fixup_phase(KArgs a, int tid, int l) {
    unsigned char* ws = a->ws; const float* tail = (const float*)(ws + WS_TAIL); const float* head = (const float*)(ws + WS_HEAD); bf16_t* ACT = (bf16_t*)(ws + WS_ACT);
    const float* cw = a->in[22] + (size_t)l * 3 * DFF; const float* sc = a->in[7] + (size_t)l * 32 * 2 * DFF;
    const size_t gt = (size_t)blockIdx.x * NTHR + tid, NT = (size_t)gridDim.x * NTHR;
    for (size_t i = gt; i < (size_t)NBLK64 * DFF; i += NT) {
        const int blk = (int)(i / DFF), f = (int)(i % DFF);
        float pm2, pm1;
        if (blk >= MP / 64) { const int bs = blk - MP / 64; pm2 = sc[((size_t)bs * 2 + 0) * DFF + f]; pm1 = sc[((size_t)bs * 2 + 1) * DFF + f]; }
        else if ((blk & 63) == 0) { pm2 = 0.f; pm1 = 0.f; }
        else { pm2 = tail[((size_t)(blk - 1) * 2 + 0) * DFF + f]; pm1 = tail[((size_t)(blk - 1) * 2 + 1) * DFF + f]; }
        const float w0 = cw[f], w1 = cw[DFF + f];
        const float* hp = head + (size_t)blk * 4 * DFF + f;
        const float c0 = hp[0] + w0 * pm2 + w1 * pm1, g0 = hp[DFF], c1 = hp[2 * DFF] + w0 * pm1, g1 = hp[3 * DFF];
        ACT[(size_t)blk * 64 * DFF + f] = f2bf(gelu_t(c0) * g0);
        ACT[((size_t)blk * 64 + 1) * DFF + f] = f2bf(gelu_t(c1) * g1);
        const float t0 = tail[((size_t)blk * 2 + 0) * DFF + f], t1 = tail[((size_t)blk * 2 + 1) * DFF + f];
        if (blk >= MP / 64) { float* o = a->out + OUT_CS + ((size_t)l * 32 + (blk - MP / 64)) * 2 * DFF + f; o[0] = t0; o[DFF] = t1; }
        else if ((blk & 63) == 63) { float* o = a->out + OUT_CP + ((size_t)l * 16 + (blk >> 6)) * 2 * DFF + f; o[0] = t0; o[DFF] = t1; }
    }
}

__device__ __forceinline__ void final_phase(KArgs a, int tid) {
    const float* ssq = (const float*)(a->ws + WS_SSQ) + (size_t)4 * MT; const float* g = a->in[25];
    const int lane = tid & 63; const int gw = blockIdx.x * NWAVES + (tid >> 6), NGW = gridDim.x * NWAVES;
    for (int m = gw; m < MT; m += NGW) {
        const float r = rs_from(ssq[m], 1.0f / 1024.0f); f32x4* row = (f32x4*)(a->out + (size_t)m * 1024);
#pragma unroll
        for (int j = 0; j < 4; ++j) { const f32x4 gg = *((const f32x4*)g + lane + 64 * j); f32x4 v = row[lane + 64 * j]; v = v * r * gg; row[lane + 64 * j] = v; }
    }
}

#define XB_TMO      128
#define XB_XCNT(j)  (256  + 64 * (j))
#define XB_XSUB(j)  (1280 + 64 * (j))
#define XB_XGEN(j)  (2304 + 64 * (j))
#define XB_TOP      3328
#define XB_TOPGEN   3392
#define XCD_BAR_WORDS 3456
#define XB_SPIN_CAP (1u << 18)

__device__ __forceinline__ unsigned xb_ld(unsigned* p)              { return __hip_atomic_load(p, __ATOMIC_RELAXED, __HIP_MEMORY_SCOPE_AGENT); }
__device__ __forceinline__ unsigned xb_add(unsigned* p, unsigned v) { return __hip_atomic_fetch_add(p, v, __ATOMIC_RELAXED, __HIP_MEMORY_SCOPE_AGENT); }
__device__ __forceinline__ unsigned xb_xcc_id() { return (unsigned)__builtin_amdgcn_s_getreg((3 << 11) | 20) & 0xFu; }
#define XB_SPIN(cond, bar) do { unsigned _sp = 0; while (cond) { __builtin_amdgcn_s_sleep(1); \
    if ((++_sp & 255u) == 0u) { if (xb_ld(&(bar)[XB_TMO])) break; if (_sp > XB_SPIN_CAP) { atomicAdd(&(bar)[XB_TMO], 1u); break; } } } } while (0)

struct XcdBarrier {
    unsigned* bar; unsigned x;
    volatile LAS unsigned* st;
};

__device__ __forceinline__ XcdBarrier xcd_barrier_post(unsigned* bar, volatile LAS unsigned* st) {
    XcdBarrier b; b.bar = bar; b.x = xb_xcc_id(); b.st = st;
    if (threadIdx.x == 0) (void)xb_add(&bar[XB_XCNT(b.x)], 1u);
    return b;
}
__device__ __forceinline__ void xcd_barrier_complete(unsigned* bar, unsigned x, unsigned& nloc, unsigned& nx) {
    const unsigned G = gridDim.x * gridDim.y * gridDim.z;
    unsigned sum, cnt, mine, sp = 0u;
    for (;;) {
        sum = 0u; cnt = 0u; mine = 0u;
#pragma unroll
        for (unsigned j = 0; j < 16; ++j) { const unsigned c = xb_ld(&bar[XB_XCNT(j)]); sum += c; cnt += (c > 0u) ? 1u : 0u; mine = (j == x) ? c : mine; }
        if (sum == G) break;
        __builtin_amdgcn_s_sleep(1);
        if ((++sp & 255u) == 0u) { if (xb_ld(&bar[XB_TMO])) break; if (sp > XB_SPIN_CAP) { atomicAdd(&bar[XB_TMO], 1u); break; } }
    }
    nloc = mine > 0u ? mine : 1u; nx = cnt > 0u ? cnt : 1u;
}

__device__ __forceinline__ void xcd_barrier(const XcdBarrier& b) {
    asm volatile("s_waitcnt vmcnt(0)" ::: "memory");
    __syncthreads();
    if (threadIdx.x == 0) {
        unsigned* bar = b.bar;
        __builtin_amdgcn_s_waitcnt(0);
        unsigned nloc = b.st[0], nx = b.st[1];
        if (nloc == 0u) { xcd_barrier_complete(bar, b.x, nloc, nx); b.st[0] = nloc; b.st[1] = nx; }
        const unsigned old = xb_add(&bar[XB_XSUB(b.x)], 1u);
        const unsigned gen = old / nloc;
        if (old + 1u == (gen + 1u) * nloc) {
            __builtin_amdgcn_fence(__ATOMIC_RELEASE, "agent");
            asm volatile("s_waitcnt vmcnt(0)" ::: "memory");
            const unsigned og = xb_add(&bar[XB_TOP], 1u);
            const unsigned tg = og / nx;
            if (og + 1u == (tg + 1u) * nx) xb_add(&bar[XB_TOPGEN], 1u);
            else XB_SPIN(xb_ld(&bar[XB_TOPGEN]) == tg, bar);
            __builtin_amdgcn_fence(__ATOMIC_ACQUIRE, "agent");
            xb_add(&bar[XB_XGEN(b.x)], 1u);
            asm volatile("s_waitcnt vmcnt(0)" ::: "memory");
        } else {
            XB_SPIN(xb_ld(&bar[XB_XGEN(b.x)]) == gen, bar);
            __builtin_amdgcn_fence(__ATOMIC_ACQUIRE, "agent");
            asm volatile("s_waitcnt vmcnt(0)" ::: "memory");
        }
    }
    __syncthreads();
}

#ifndef REP_P0
#define REP_P0 1
#endif
#ifndef REP_MIX
#define REP_MIX 1
#endif
#ifndef REP_UP
#define REP_UP 1
#endif
__device__ __forceinline__ void launder(int& t) { asm volatile("" : "+v"(t)); }
__global__ void __launch_bounds__(NTHR, 2) fwd_kernel(Args a) {
    extern __shared__ __attribute__((aligned(16))) unsigned char lds_raw[];
    LAS unsigned char* lds = (LAS unsigned char*)lds_raw;
    int tid = threadIdx.x; const int G = gridDim.x;
    KArgs kp = (KArgs)__builtin_amdgcn_kernarg_segment_ptr();
    volatile LAS unsigned* bst = (volatile LAS unsigned*)(lds + 131072 + 64);
    if (tid < 2) bst[tid] = 0u;
    __syncthreads();
    XcdBarrier bar; bar.bar = (unsigned*)(a.ws + WS_BAR); bar.x = 0; bar.st = bst;
    if (a.coop) bar = xcd_barrier_post((unsigned*)(a.ws + WS_BAR), bst);
#define PH_ARGS() KArgs q = kp; asm volatile("" : "+s"(q)); unsigned char* ws = q->ws; float* ssqb = (float*)(ws + WS_SSQ); bf16_t* HB = (bf16_t*)(ws + WS_HB); (void)ssqb; (void)HB;
    int ph = 0;
#ifndef REP_SYNC
#define REP_SYNC 1
#endif
#define SEAM() do { if (a.coop && ph + 1 < a.ph_hi) { for (int rs_ = 0; rs_ < REP_SYNC; ++rs_) { if (a.coop == 2) cg::this_grid().sync(); else xcd_barrier(bar); } } } while (0)
#define IN_PH() (launder(tid), ph >= a.ph_lo && ph < a.ph_hi)
#ifndef EN_MASK
#define EN_MASK 0xffff
#endif
#define EN(k) ((EN_MASK >> (k)) & 1)

    if (IN_PH()) { PH_ARGS(); for (int rep = 0; rep < REP_P0; ++rep) p0_prologue(q, lds, tid); SEAM(); } ++ph;

#pragma unroll 1
    for (int l = 0; l < 4; ++l) {
        if (IN_PH()) { PH_ARGS();
            if (l < 2) { if (EN(1)) {
                pg8::Gemm g{HB, (const bf16_t*)(ws + WS_WINA) + (size_t)l * 1536 * 1024, MT, 1536, 1024}; pg8::StaticOrder S; S.init(MT, 1536, G, (int)blockIdx.x);
                EpiInA E{ssqb + (size_t)l * MT, (bf16_t*)(ws + WS_U), (bf16_t*)(ws + WS_VT), (bf16_t*)(ws + WS_QM), ssqb + (size_t)(9 + l) * MT, 0.08838834764831845f * LOG2E};
                pg8::gemm_phase<EpiInA, pg8::StaticOrder, true, true>(lds, g, S, E, tid); }
                if (EN(2) && l == 0) {
                    pg8::Gemm g2{(const bf16_t*)(ws + WS_MPB), (const bf16_t*)(ws + WS_WMEM), 4096, 4096, 1024}; pg8::StaticOrder S2; S2.init(4096, 4096, G, (int)blockIdx.x);
                    EpiMem E2{(const float*)(ws + WS_RMEM), q->out, (bf16_t*)(ws + WS_MEMK), (bf16_t*)(ws + WS_MEMVT)};
                    pg8::gemm_phase<EpiMem, pg8::StaticOrder, true, true>(lds, g2, S2, E2, tid);
                }
            } else if (EN(3)) {
                const int N = l == 2 ? 2048 : 1024;
                pg8::Gemm g{HB, (const bf16_t*)(ws + WS_WB) + (size_t)(l == 2 ? 0 : 2048) * 1024, MT, N, 1024}; pg8::StaticOrder S; S.init(MT, N, G, (int)blockIdx.x);
                EpiInB E{ssqb + (size_t)l * MT, (bf16_t*)(ws + WS_U), (bf16_t*)(ws + WS_QM), (bf16_t*)(ws + WS_PK), (bf16_t*)(ws + WS_PVT), (bf16_t*)(ws + WS_SK), (bf16_t*)(ws + WS_SVT), q->out,
                         0.125f * LOG2E, 0.08838834764831845f * LOG2E};
                pg8::gemm_phase<EpiInB, pg8::StaticOrder, true, true>(lds, g, S, E, tid);
            }
            SEAM();
        } ++ph;
        if (IN_PH()) { PH_ARGS(); for (int rep = 0; rep < REP_MIX; ++rep) mixer_phase(q, lds, tid, l); SEAM(); } ++ph;
        if (IN_PH()) { PH_ARGS(); if (EN(5)) {
            pg8::Gemm g{(const bf16_t*)(ws + WS_CAT), (const bf16_t*)(ws + WS_WOUT) + (size_t)l * 1024 * 1024, MT, 1024, 1024}; pg8::StaticOrder S; S.init(MT, 1024, G, (int)blockIdx.x);
            EpiRes E{l == 0 ? q->in[0] : q->out, l == 0 ? q->in[1] - (size_t)MP * 1024 : q->out, q->out, HB, ssqb + (size_t)(5 + l) * MT};
            pg8::gemm_phase<EpiRes, pg8::StaticOrder, true, true>(lds, g, S, E, tid); }
            SEAM();
        } ++ph;
        if (IN_PH()) { PH_ARGS(); if (EN(6)) {
            pg8::Gemm g{HB, (const bf16_t*)(ws + WS_WUP) + (size_t)l * 5632 * 1024, MT, 5632, 1024}; pg8::StaticOrder S; S.init(MT, 5632, G, (int)blockIdx.x);
            EpiUp E{ssqb + (size_t)(5 + l) * MT, q->in[22] + (size_t)l * 3 * DFF, q->in[23] + (size_t)l * DFF, (bf16_t*)(ws + WS_ACT), (float*)(ws + WS_TAIL), (float*)(ws + WS_HEAD)};
            S.rep = REP_UP; pg8::gemm_phase<EpiUp, pg8::StaticOrder, true, true>(lds, g, S, E, tid); }
            SEAM();
        } ++ph;
        if (IN_PH()) { PH_ARGS(); if (EN(7)) fixup_phase(q, tid, l); SEAM(); } ++ph;
        if (IN_PH()) { PH_ARGS(); if (EN(8)) {
            pg8::Gemm g{(const bf16_t*)(ws + WS_ACT), (const bf16_t*)(ws + WS_WDOWN) + (size_t)l * 1024 * DFF, MT, 1024, DFF}; pg8::StaticOrder S; S.init(MT, 1024, G, (int)blockIdx.x);
            EpiRes E{q->out, q->out, q->out, HB, ssqb + (size_t)(l + 1) * MT};
            pg8::gemm_phase<EpiRes, pg8::StaticOrder, true, true>(lds, g, S, E, tid); }
            SEAM();
        } ++ph;
    }
    if (IN_PH()) { PH_ARGS(); if (EN(9)) final_phase(q, tid); } ++ph;
#undef SEAM
#undef IN_PH
}
constexpr int N_PHASES = 26;

#ifndef MK_MULTI
#define MK_MULTI 0
#endif

extern "C" void kernel_launch(void* const* d_in, const int* in_sizes, int n_in, void* d_out, int out_size, void* d_ws, size_t ws_size, hipStream_t stream) {
    static int grid = 0;
    if (grid == 0) {
        if (n_in != 26 || (size_t)out_size != OUT_END || ws_size < WS_END) { fprintf(stderr, "kernel_launch: unexpected sizes n_in %d out %d ws %zu (need %zu)\n", n_in, out_size, ws_size, (size_t)WS_END); grid = -1; return; }
        int dev = 0, cus = 0, per_cu = 0;
        if (hipGetDevice(&dev) != hipSuccess || hipDeviceGetAttribute(&cus, hipDeviceAttributeMultiprocessorCount, dev) != hipSuccess) { grid = -1; return; }
        if (hipFuncSetAttribute((const void*)fwd_kernel, hipFuncAttributeMaxDynamicSharedMemorySize, LDS_BYTES) != hipSuccess) { fprintf(stderr, "kernel_launch: hipFuncSetAttribute failed\n"); grid = -1; return; }
        if (hipOccupancyMaxActiveBlocksPerMultiprocessor(&per_cu, (const void*)fwd_kernel, NTHR, LDS_BYTES) != hipSuccess || per_cu < 1) { fprintf(stderr, "kernel_launch: occupancy query says %d\n", per_cu); per_cu = 1; }
        (void)hipGetLastError();
        grid = cus * 1;
    }
    if (grid < 0) return;
    Args a{};
    for (int i = 0; i < 26; ++i) a.in[i] = (const float*)d_in[i];
    a.out = (float*)d_out; a.ws = (unsigned char*)d_ws;
#if MK_MULTI
    for (int p = 0; p < N_PHASES; ++p) { a.ph_lo = p; a.ph_hi = p + 1; a.coop = 0; hipLaunchKernelGGL(fwd_kernel, dim3(grid), dim3(NTHR), LDS_BYTES, stream, a); }
#else
    a.ph_lo = 0; a.ph_hi = N_PHASES; a.coop = 1;
    if (hipMemsetAsync((char*)d_ws + WS_BAR, 0, BAR_BYTES, stream) != hipSuccess) { fprintf(stderr, "memset failed\n"); return; }
    void* args[] = {&a};
    hipError_t e = hipLaunchCooperativeKernel((const void*)fwd_kernel, dim3(grid), dim3(NTHR), args, LDS_BYTES, stream);
    if (e != hipSuccess) fprintf(stderr, "cooperative launch failed: %s (grid %d)\n", hipGetErrorString(e), grid);
#endif
}
```

```cpp
#include <hip/hip_runtime.h>
#include <hip/hip_cooperative_groups.h>
#include <cstdio>
#include <cstdint>
namespace cg = cooperative_groups;
namespace pg8 {
#define PG8_LAS __attribute__((address_space(3)))
typedef unsigned short bf16_t;
typedef short bf16x8 __attribute__((ext_vector_type(8)));
typedef float f32x4 __attribute__((ext_vector_type(4)));
typedef unsigned u32x4 __attribute__((ext_vector_type(4)));
constexpr int BM = 256, BK = 64, HALF = 128, HTB = HALF * BK * 2  , STAGE_BYTES = 8 * HTB, NXCD = 8, WGM = 8;

__host__ __device__ __forceinline__ int lds_byte(int r, int c) { const int st = (r >> 4) * 2 + (c >> 5), rr = r & 15, cc = c & 31, ob = rr * 64 + cc * 2; return st * 1024 + (ob ^ (((ob >> 9) & 1) << 5)); }
__host__ __device__ __forceinline__ void stage_rc(int b, int& R, int& C) { const int st = b / 1024, sb = b % 1024, swz = sb ^ (((sb >> 9) & 1) << 5); R = (st >> 1) * 16 + swz / 64; C = (st & 1) * 32 + (swz % 64) / 2; }
__host__ __device__ __forceinline__ int perm32(int rho) { const int n = rho >> 4, i = rho & 15; return 8 * (i >> 2) + 4 * n + (i & 3); }

struct Unit { int pm, pn, pass; };
struct Gemm { const bf16_t* A; const bf16_t* Bt; int M, N, K; };

struct StaticOrder {
    int nM, nN, nwg, G, c, rep = 1;
    __host__ __device__ void init(int M, int N, int G_, int c_) { nM = M / BM; nN = N / BM; nwg = nM * nN; G = G_; c = c_; }
    __host__ __device__ bool next(int i, Unit& u) const {
        const long L = (long)i * G + c; if (L >= (long)nwg * rep) return false;
        int wgid = (int)(L % nwg); u.pass = (int)(L / nwg); { const int q = nwg / NXCD, r = nwg % NXCD, xcd = wgid % NXCD, off = wgid / NXCD; wgid = (xcd < r ? xcd * (q + 1) : r * (q + 1) + (xcd - r) * q) + off; }
        const int nig = WGM * nN, gid = wgid / nig, fm = gid * WGM, gsz = (nM - fm) < WGM ? (nM - fm) : WGM;
        u.pm = fm + ((wgid % nig) % gsz); u.pn = (wgid % nig) / gsz; return true;
    }
    __device__ __forceinline__ void a_ready(const Unit&) const {}
    __device__ __forceinline__ void done(const Unit&) const {}
};

__device__ __forceinline__ unsigned cvt_pk_bf16(float lo, float hi) { unsigned r; asm volatile("v_cvt_pk_bf16_f32 %0, %1, %2" : "=v"(r) : "v"(lo), "v"(hi)); return r; }
template <class Epi, class Sched, bool ALIGN_EPI = false, bool SP2 = false>
__device__ __forceinline__ void gemm_phase(PG8_LAS unsigned char* lds, const Gemm g, const Sched& S, const Epi& E, const int tid) {
    const int wid = __builtin_amdgcn_readfirstlane(tid >> 6), lane = tid & 63, wr = wid >> 2, wc = wid & 3, fr = lane & 15, fq = lane >> 4;
    const int K = g.K, nt = K / BK;
    unsigned voffA[2], voffB[2];
#pragma unroll
    for (int i = 0; i < 2; ++i) { int R, C; stage_rc(tid * 16 + i * 8192, R, C); const int Rb = Epi::PERM ? ((R & ~31) + perm32(R & 31)) : R;
        voffA[i] = (unsigned)(R * K + C) * 2u; voffB[i] = (unsigned)(Rb * K + C) * 2u; }
    const size_t kstep = (size_t)(BK * 2);
    const size_t hstep = (size_t)HALF * K * 2;
    const size_t tstep = 2 * hstep;
    const unsigned ldsw = (unsigned)wid * 1024u;
    const int aoff = lds_byte(wr * 64 + fr, fq * 8), boff = lds_byte(wc * 32 + fr, fq * 8);
#define PG8_SA(b, h) (((b) * 2 + (h)) * HTB)
#define PG8_SB(b, h) ((4 + (b) * 2 + (h)) * HTB)
#define PG8_STAGE(bufoff, gbase, voff) do { _Pragma("unroll") for (int _i = 0; _i < 2; ++_i) \
        __builtin_amdgcn_global_load_lds((const unsigned*)((const char*)(gbase) + (voff)[_i]), (PG8_LAS unsigned*)(lds + (bufoff) + ldsw + _i * 8192), 16, 0, 0); } while (0)
#define PG8_LDA(dst, b, h) do { _Pragma("unroll") for (int m = 0; m < 4; ++m) _Pragma("unroll") for (int k = 0; k < 2; ++k) dst[m][k] = *(const PG8_LAS bf16x8*)(lds + PG8_SA(b, h) + aoff + m * 2048 + k * 1024); } while (0)
#define PG8_LDB(dst, b, h) do { _Pragma("unroll") for (int n = 0; n < 2; ++n) _Pragma("unroll") for (int k = 0; k < 2; ++k) dst[n][k] = *(const PG8_LAS bf16x8*)(lds + PG8_SB(b, h) + boff + n * 2048 + k * 1024); } while (0)
#define PG8_MMA(ai, bj, At, Bt) do { __builtin_amdgcn_s_setprio(1); _Pragma("unroll") for (int m = 0; m < 4; ++m) _Pragma("unroll") for (int n = 0; n < 2; ++n) _Pragma("unroll") for (int k = 0; k < 2; ++k) \
        acc[ai][bj][m][n] = __builtin_amdgcn_mfma_f32_16x16x32_bf16(Bt[n][k], At[m][k], acc[ai][bj][m][n], 0, 0, 0); __builtin_amdgcn_s_setprio(0); } while (0)
#define PG8_WAIT_V(n) asm volatile("s_waitcnt vmcnt(" #n ")" ::: "memory")
#define PG8_WAIT_L(n) asm volatile("s_waitcnt lgkmcnt(" #n ")" ::: "memory")
#define PG8_BAR __builtin_amdgcn_s_barrier()
#define PG8_SCHED __builtin_amdgcn_sched_barrier(0)
    Unit cur, nxt; int ui = 0;
    if (!S.next(0, cur)) return;
    f32x4 acc[2][2][4][2];
#pragma unroll
    for (int a = 0; a < 2; ++a)
#pragma unroll
        for (int b = 0; b < 2; ++b)
#pragma unroll
            for (int m = 0; m < 4; ++m)
#pragma unroll
                for (int n = 0; n < 2; ++n) acc[a][b][m][n] = (f32x4){0.f, 0.f, 0.f, 0.f};
    bf16x8 At[4][2], B0[2][2], B1[2][2];
    const char* cA = (const char*)g.A + (size_t)cur.pm * tstep; const char* cB = (const char*)g.Bt + (size_t)cur.pn * tstep;
    S.a_ready(cur);
    if constexpr (SP2) {
        PG8_STAGE(PG8_SB(0, 0), cB, voffB); PG8_STAGE(PG8_SB(0, 1), cB + hstep, voffB); PG8_STAGE(PG8_SA(0, 0), cA, voffA); PG8_STAGE(PG8_SA(0, 1), cA + hstep, voffA);
        if (wr == 1) PG8_BAR;
        PG8_WAIT_V(2); PG8_BAR;
        PG8_STAGE(PG8_SB(1, 0), cB + kstep, voffB); PG8_STAGE(PG8_SA(1, 0), cA + kstep, voffA); PG8_STAGE(PG8_SB(1, 1), cB + hstep + kstep, voffB);
        PG8_WAIT_V(6); PG8_BAR;
    } else {
        PG8_STAGE(PG8_SB(0, 0), cB, voffB); PG8_STAGE(PG8_SA(0, 0), cA, voffA); PG8_STAGE(PG8_SB(0, 1), cB + hstep, voffB); PG8_STAGE(PG8_SA(0, 1), cA + hstep, voffA);
        if (wr == 1) PG8_BAR;
        PG8_WAIT_V(4); PG8_BAR;
        PG8_STAGE(PG8_SB(1, 0), cB + kstep, voffB); PG8_STAGE(PG8_SA(1, 0), cA + kstep, voffA); PG8_STAGE(PG8_SB(1, 1), cB + hstep + kstep, voffB);
        PG8_WAIT_V(6); PG8_BAR;
    }
    for (;;) {
        const bool has_next = S.next(ui + 1, nxt);
        const char* nA = has_next ? (const char*)g.A + (size_t)nxt.pm * tstep : cA; const char* nB = has_next ? (const char*)g.Bt + (size_t)nxt.pn * tstep : cB;
        for (int t = 0; t < nt; t += 2) {
            const bool last = (t == nt - 2);
            const char* a1 = cA + (size_t)(t + 1) * kstep;
            const char* a2 = last ? nA : cA + (size_t)(t + 2) * kstep; const char* b2 = last ? nB : cB + (size_t)(t + 2) * kstep;
            const char* a3 = a2 + kstep; const char* b3 = b2 + kstep;
            if (last && has_next) S.a_ready(nxt);
            if constexpr (SP2) {
            PG8_LDB(B0, 0, 0); PG8_LDB(B1, 0, 1); PG8_SCHED; PG8_LDA(At, 0, 0); PG8_STAGE(PG8_SA(1, 1), a1 + hstep, voffA);
            PG8_WAIT_V(8); PG8_WAIT_L(0); PG8_BAR; PG8_MMA(0, 0, At, B0); PG8_MMA(0, 1, At, B1); PG8_BAR; PG8_SCHED;
            PG8_LDA(At, 0, 1); PG8_STAGE(PG8_SB(0, 0), b2, voffB); PG8_STAGE(PG8_SB(0, 1), b2 + hstep, voffB); PG8_STAGE(PG8_SA(0, 0), a2, voffA);
            PG8_WAIT_V(8); PG8_WAIT_L(0); PG8_BAR; PG8_MMA(1, 0, At, B0); PG8_MMA(1, 1, At, B1); PG8_BAR; PG8_SCHED;
            PG8_LDB(B0, 1, 0); PG8_LDB(B1, 1, 1); PG8_SCHED; PG8_LDA(At, 1, 0); PG8_STAGE(PG8_SA(0, 1), a2 + hstep, voffA);
            PG8_WAIT_V(8); PG8_WAIT_L(0); PG8_BAR; PG8_MMA(0, 0, At, B0); PG8_MMA(0, 1, At, B1); PG8_BAR; PG8_SCHED;
            PG8_LDA(At, 1, 1); PG8_STAGE(PG8_SB(1, 0), b3, voffB); PG8_STAGE(PG8_SB(1, 1), b3 + hstep, voffB); PG8_STAGE(PG8_SA(1, 0), a3, voffA);
            PG8_WAIT_V(8); PG8_WAIT_L(0); PG8_BAR; PG8_MMA(1, 0, At, B0); PG8_MMA(1, 1, At, B1); PG8_BAR; PG8_SCHED;
            } else {
            PG8_LDB(B0, 0, 0); PG8_SCHED; PG8_LDA(At, 0, 0); PG8_STAGE(PG8_SA(1, 1), a1 + hstep, voffA);
            PG8_WAIT_L(8); PG8_BAR; PG8_WAIT_L(0); PG8_MMA(0, 0, At, B0); PG8_BAR; PG8_SCHED;
            PG8_LDB(B1, 0, 1); PG8_STAGE(PG8_SB(0, 0), b2, voffB);
            PG8_BAR; PG8_WAIT_L(0); PG8_MMA(0, 1, At, B1); PG8_BAR;
            PG8_LDA(At, 0, 1); PG8_STAGE(PG8_SA(0, 0), a2, voffA);
            PG8_BAR; PG8_WAIT_L(0); PG8_MMA(1, 0, At, B0); PG8_BAR; PG8_SCHED;
            PG8_STAGE(PG8_SB(0, 1), b2 + hstep, voffB);
            PG8_WAIT_V(6); PG8_BAR; PG8_MMA(1, 1, At, B1); PG8_BAR;
            PG8_LDB(B0, 1, 0); PG8_SCHED; PG8_LDA(At, 1, 0); PG8_STAGE(PG8_SA(0, 1), a2 + hstep, voffA);
            PG8_WAIT_L(8); PG8_BAR; PG8_WAIT_L(0); PG8_MMA(0, 0, At, B0); PG8_BAR; PG8_SCHED;
            PG8_LDB(B1, 1, 1); PG8_STAGE(PG8_SB(1, 0), b3, voffB);
            PG8_BAR; PG8_WAIT_L(0); PG8_MMA(0, 1, At, B1); PG8_BAR;
            PG8_LDA(At, 1, 1); PG8_STAGE(PG8_SA(1, 0), a3, voffA);
            PG8_BAR; PG8_WAIT_L(0); PG8_MMA(1, 0, At, B0); PG8_BAR; PG8_SCHED;
            PG8_STAGE(PG8_SB(1, 1), b3 + hstep, voffB);
            PG8_WAIT_V(6); PG8_BAR; PG8_MMA(1, 1, At, B1); PG8_BAR;
            }
        }
        if constexpr (ALIGN_EPI) { if (wr == 0) PG8_BAR; }
        if constexpr (!Epi::AFTER_DRAIN) { if (cur.pass == S.rep - 1) E(acc, cur, wr, wc, fr, fq); S.done(cur); }
        if (!has_next) break;
#pragma unroll
        for (int a = 0; a < 2; ++a)
#pragma unroll
            for (int b = 0; b < 2; ++b)
#pragma unroll
                for (int m = 0; m < 4; ++m)
#pragma unroll
                    for (int n = 0; n < 2; ++n) acc[a][b][m][n] = (f32x4){0.f, 0.f, 0.f, 0.f};
        cur = nxt; cA = nA; cB = nB; ++ui;
        if constexpr (ALIGN_EPI) { if (wr == 1) PG8_BAR; }
    }
    PG8_WAIT_V(0);
    if constexpr (!ALIGN_EPI) { if (wr == 0) PG8_BAR; }
    PG8_BAR;
    if constexpr (Epi::AFTER_DRAIN) { E.fused(acc, cur, wr, wc, fr, fq, lds, wid, lane); S.done(cur); }
#undef PG8_SA
#undef PG8_SB
#undef PG8_STAGE
#undef PG8_LDA
#undef PG8_LDB
#undef PG8_MMA
#undef PG8_WAIT_V
#undef PG8_WAIT_L
#undef PG8_BAR
#undef PG8_SCHED
}
}

#define LAS __attribute__((address_space(3)))
typedef unsigned short bf16_t;
typedef short bf16x8 __attribute__((ext_vector_type(8)));
typedef float f32x4 __attribute__((ext_vector_type(4)));
typedef float f32x16 __attribute__((ext_vector_type(16)));
typedef unsigned u32x4 __attribute__((ext_vector_type(4)));
typedef unsigned u32x2 __attribute__((ext_vector_type(2)));
using pg8::cvt_pk_bf16;

constexpr int NWAVES = 8, NTHR = 512;
constexpr int DM = 1024, DFF = 2816, SEQ = 4096, NB = 16, NBS = 32, DSEQ = 64;
constexpr int MP = NB * SEQ, MS = NBS * DSEQ, MT = MP + MS;
constexpr int NBLK64 = MT / 64;
constexpr float EPS = 1e-6f, LOG2E = 1.4426950408889634f;
constexpr int LDS_BYTES = 147456;

constexpr size_t OUT_Y = 0;
constexpr size_t OUT_MK = (size_t)MT * DM;
constexpr size_t OUT_MV = OUT_MK + (size_t)4 * 16 * 256 * 512;
constexpr size_t OUT_BK = OUT_MV + (size_t)4 * 16 * 256 * 512;
constexpr size_t OUT_BV = OUT_BK + (size_t)16 * 512 * 512;
constexpr size_t OUT_CP = OUT_BV + (size_t)16 * 512 * 512;
constexpr size_t OUT_AV = OUT_CP + (size_t)4 * 16 * 2 * DFF;
constexpr size_t OUT_SK = OUT_AV + (size_t)2 * 32 * 64 * 512;
constexpr size_t OUT_SV = OUT_SK + (size_t)32 * 64 * 512;
constexpr size_t OUT_CS = OUT_SV + (size_t)32 * 64 * 512;
constexpr size_t OUT_END = OUT_CS + (size_t)4 * 32 * 2 * DFF;

constexpr size_t al256(size_t x) { return (x + 255) & ~(size_t)255; }
constexpr size_t WS_BAR = 0, BAR_BYTES = 16384;
constexpr size_t WS_SSQ = BAR_BYTES;
constexpr size_t WS_RMEM = al256(WS_SSQ + (size_t)11 * MT * 8);
constexpr size_t WS_WINA = al256(WS_RMEM + 4096 * 4);
constexpr size_t WS_WB = WS_WINA + (size_t)2 * 1536 * 1024 * 2;
constexpr size_t WS_WMEM = WS_WB + (size_t)3072 * 1024 * 2;
constexpr size_t WS_WOUT = WS_WMEM + (size_t)4096 * 1024 * 2;
constexpr size_t WS_WUP = WS_WOUT + (size_t)4096 * 1024 * 2;
constexpr size_t WS_WDOWN = WS_WUP + (size_t)4 * 5632 * 1024 * 2;
constexpr size_t WS_WSB = WS_WDOWN + (size_t)4 * 1024 * 2816 * 2;
constexpr size_t WS_MPB = WS_WSB + (size_t)2 * 8 * 128 * 128 * 2;
constexpr size_t WS_HB = WS_MPB + (size_t)4096 * 1024 * 2;
constexpr size_t WS_MEMK = WS_HB + (size_t)MT * 1024 * 2;
constexpr size_t WS_MEMVT = WS_MEMK + (size_t)4 * 48 * 256 * 512 * 2;
constexpr size_t WS_PK = WS_MEMVT + (size_t)4 * 48 * 256 * 512 * 2;
constexpr size_t WS_PVT = WS_PK + (size_t)MP * 512 * 2;
constexpr size_t WS_SK = WS_PVT + (size_t)MP * 512 * 2;
constexpr size_t WS_SVT = WS_SK + (size_t)32 * 576 * 512 * 2;
constexpr size_t WS_TAIL = WS_SVT + (size_t)32 * 576 * 512 * 2;
constexpr size_t WS_HEAD = WS_TAIL + (size_t)NBLK64 * 2 * DFF * 4;
constexpr size_t WS_OVL = WS_HEAD + (size_t)NBLK64 * 4 * DFF * 4;
constexpr size_t WS_ACT = WS_OVL;
constexpr size_t WS_U = WS_OVL;
constexpr size_t WS_VT = WS_U + (size_t)MT * 512 * 2;
constexpr size_t WS_QM = WS_VT + (size_t)MT * 512 * 2;
constexpr size_t WS_CAT = WS_QM + (size_t)MT * 512 * 2;
constexpr size_t WS_END = WS_OVL + (size_t)MT * DFF * 2;
static_assert(WS_CAT + (size_t)MT * 1024 * 2 <= WS_END, "overlay");
static_assert(WS_END <= (size_t)1073741824, "workspace budget");

__device__ __forceinline__ float bf2f(unsigned short b) { return __builtin_bit_cast(float, (unsigned)b << 16); }
__device__ __forceinline__ unsigned short f2bf(float f) { unsigned u = __builtin_bit_cast(unsigned, f); return (unsigned short)((u + 0x7fffu + ((u >> 16) & 1u)) >> 16); }
__device__ __forceinline__ float gelu_t(float x) {
    const float t = x * (1.0f + 0.044715f * x * x);
    const float e = __builtin_amdgcn_exp2f(-2.302208198f * t);
    return x * __builtin_amdgcn_rcpf(1.0f + e);
}
typedef unsigned long long ssq_t;
__device__ __forceinline__ float rs_from(float ssq, float invn) { return rsqrtf(ssq * invn + EPS); }
__device__ __forceinline__ float rs_fromu(ssq_t v, float invn) { return rsqrtf((float)v * (invn * (1.0f / 1048576.0f)) + EPS); }
__device__ __forceinline__ ssq_t to_fix(float ss) { return (ssq_t)(ss * 1048576.0f); }
__device__ __forceinline__ u32x4 pack8(const f32x4& a, const f32x4& b) { u32x4 w; w.x = cvt_pk_bf16(a[0], a[1]); w.y = cvt_pk_bf16(a[2], a[3]); w.z = cvt_pk_bf16(b[0], b[1]); w.w = cvt_pk_bf16(b[2], b[3]); return w; }
__device__ __forceinline__ float wave_sum(float v) {
#pragma unroll
    for (int o = 1; o < 64; o <<= 1) v += __shfl_xor(v, o);
    return v;
}
#define MFMA32(a, b, c) __builtin_amdgcn_mfma_f32_32x32x16_bf16((a), (b), (c), 0, 0, 0)
__device__ __forceinline__ int crow(int r, int hi) { return (r & 3) + 8 * (r >> 2) + 4 * hi; }

typedef f32x4 AccT[2][2][4][2];

struct EpiInA {
    static constexpr bool PERM = true, AFTER_DRAIN = false;
    const ssq_t* ssq; bf16_t* U; bf16_t* VT; bf16_t* QM; ssq_t* ssqv; float qscale;
    __device__ __forceinline__ void operator()(const AccT& acc, const pg8::Unit& u, int wr, int wc, int fr, int fq) const {
        const int row0 = u.pm * 256 + wr * 64 + fr; const int ty = u.pn >> 1; const int cb = (u.pn & 1) * 256 + wc * 32 + 8 * fq;
#pragma unroll
        for (int ai = 0; ai < 2; ++ai)
#pragma unroll
            for (int m = 0; m < 4; ++m) {
                const int row = row0 + ai * 128 + m * 16; const float r = rs_fromu(ssq[row], 1.0f / 1024.0f);
                if (ty == 0) {
#pragma unroll
                    for (int bj = 0; bj < 2; ++bj) { f32x4 a = acc[ai][bj][m][0] * r, b = acc[ai][bj][m][1] * r;
#pragma unroll
                        for (int e = 0; e < 4; ++e) { a[e] = gelu_t(a[e]); b[e] = gelu_t(b[e]); }
                        *(u32x4*)(U + (size_t)row * 512 + cb + bj * 128) = pack8(a, b); }
                } else if (ty == 2) {
                    const float s = r * qscale;
#pragma unroll
                    for (int bj = 0; bj < 2; ++bj) { f32x4 a = acc[ai][bj][m][0] * s, b = acc[ai][bj][m][1] * s;
                        *(u32x4*)(QM + (size_t)row * 512 + cb + bj * 128) = pack8(a, b); }
                } else {
                    float ss = 0.f; bf16_t* vt = VT + (size_t)(row >> 7) * 512 * 128 + (row & 127);
#pragma unroll
                    for (int bj = 0; bj < 2; ++bj)
#pragma unroll
                        for (int n = 0; n < 2; ++n)
#pragma unroll
                            for (int e = 0; e < 4; ++e) { const unsigned short hb = f2bf(gelu_t(acc[ai][bj][m][n][e] * r)); const float vr = bf2f(hb); ss += vr * vr;
                                vt[(size_t)(cb + bj * 128 + 4 * n + e) * 128] = hb; }
                    ss += __shfl_xor(ss, 16); ss += __shfl_xor(ss, 32);
                    if (fq == 0) atomicAdd(ssqv + row, to_fix(ss));
                }
            }
    }
};

struct EpiInB {
    static constexpr bool PERM = true, AFTER_DRAIN = false;
    const ssq_t* ssq; bf16_t* Q; bf16_t* QM; bf16_t* PK; bf16_t* PVT; bf16_t* SK; bf16_t* SVT; float* out; float qscale, mscale;
    __device__ __forceinline__ void operator()(const AccT& acc, const pg8::Unit& u, int wr, int wc, int fr, int fq) const {
        const int row0 = u.pm * 256 + wr * 64 + fr; const int ty = u.pn >> 1; const int cb = (u.pn & 1) * 256 + wc * 32 + 8 * fq;
        const bool samp = u.pm >= 256;
#pragma unroll
        for (int ai = 0; ai < 2; ++ai)
#pragma unroll
            for (int m = 0; m < 4; ++m) {
                const int row = row0 + ai * 128 + m * 16; const float r = rs_fromu(ssq[row], 1.0f / 1024.0f);
                if (ty < 2) {
                    const float s = r * (ty == 0 ? qscale : mscale); bf16_t* dst = (ty == 0 ? Q : QM) + (size_t)row * 512 + cb;
#pragma unroll
                    for (int bj = 0; bj < 2; ++bj) { f32x4 a = acc[ai][bj][m][0] * s, b = acc[ai][bj][m][1] * s; *(u32x4*)(dst + bj * 128) = pack8(a, b); }
                } else if (ty == 2) {
                    bf16_t* dst; float* fo = nullptr;
                    if (!samp) { dst = PK + (size_t)row * 512 + cb; const int t = row & 4095; if (t >= 3584) fo = out + OUT_BK + ((size_t)(row >> 12) * 512 + (t - 3584)) * 512 + cb; }
                    else { const int rs = row - MP, bs = rs >> 6, t = rs & 63; dst = SK + ((size_t)bs * 576 + 512 + t) * 512 + cb; fo = out + OUT_SK + (size_t)rs * 512 + cb; }
#pragma unroll
                    for (int bj = 0; bj < 2; ++bj) { f32x4 a = acc[ai][bj][m][0] * r, b = acc[ai][bj][m][1] * r; *(u32x4*)(dst + bj * 128) = pack8(a, b);
                        if (fo) { *(f32x4*)(fo + bj * 128) = a; *(f32x4*)(fo + bj * 128 + 4) = b; } }
                } else {
                    bf16_t* dst; size_t cst; float* fo = nullptr;
                    if (!samp) { const int b = row >> 12, t = row & 4095; dst = PVT + (size_t)b * 512 * 4096 + t; cst = 4096; if (t >= 3584) fo = out + OUT_BV + ((size_t)b * 512 + (t - 3584)) * 512 + cb; }
                    else { const int rs = row - MP, bs = rs >> 6, t = rs & 63; dst = SVT + (size_t)bs * 512 * 576 + 512 + t; cst = 576; fo = out + OUT_SV + (size_t)rs * 512 + cb; }
#pragma unroll
                    for (int bj = 0; bj < 2; ++bj) { f32x4 a = acc[ai][bj][m][0] * r, b = acc[ai][bj][m][1] * r;
#pragma unroll
                        for (int e = 0; e < 4; ++e) { dst[(size_t)(cb + bj * 128 + e) * cst] = f2bf(a[e]); dst[(size_t)(cb + bj * 128 + 4 + e) * cst] = f2bf(b[e]); }
                        if (fo) { *(f32x4*)(fo + bj * 128) = a; *(f32x4*)(fo + bj * 128 + 4) = b; } }
                }
            }
    }
};

struct EpiRes {
    static constexpr bool PERM = true, AFTER_DRAIN = false;
    bf16_t* hb; ssq_t* ssq_next;
    __device__ __forceinline__ void operator()(const AccT& acc, const pg8::Unit& u, int wr, int wc, int fr, int fq) const {
        const int row0 = u.pm * 256 + wr * 64 + fr; const int cb = u.pn * 256 + wc * 32 + 8 * fq;
#pragma unroll
        for (int ai = 0; ai < 2; ++ai)
#pragma unroll
            for (int m = 0; m < 4; ++m) {
                const int row = row0 + ai * 128 + m * 16; float ss = 0.f;
#pragma unroll
                for (int bj = 0; bj < 2; ++bj) { bf16_t* p = hb + (size_t)row * 1024 + cb + bj * 128; const u32x4 rw = *(const u32x4*)p;
                    f32x4 a, b;
                    a[0] = __builtin_bit_cast(float, rw.x << 16); a[1] = __builtin_bit_cast(float, rw.x & 0xffff0000u); a[2] = __builtin_bit_cast(float, rw.y << 16); a[3] = __builtin_bit_cast(float, rw.y & 0xffff0000u);
                    b[0] = __builtin_bit_cast(float, rw.z << 16); b[1] = __builtin_bit_cast(float, rw.z & 0xffff0000u); b[2] = __builtin_bit_cast(float, rw.w << 16); b[3] = __builtin_bit_cast(float, rw.w & 0xffff0000u);
                    a = a + acc[ai][bj][m][0]; b = b + acc[ai][bj][m][1];
                    *(u32x4*)p = pack8(a, b);
                    ss += (a[0] * a[0] + a[1] * a[1]) + (a[2] * a[2] + a[3] * a[3]) + (b[0] * b[0] + b[1] * b[1]) + (b[2] * b[2] + b[3] * b[3]); }
                ss += __shfl_xor(ss, 16); ss += __shfl_xor(ss, 32);
                if (fq == 0) atomicAdd(ssq_next + row, to_fix(ss));
            }
    }
};

struct EpiUp {
    static constexpr bool PERM = true, AFTER_DRAIN = false;
    const ssq_t* ssq; const float* cw; const float* cbias; bf16_t* ACT; float* tail; float* head;
    __device__ __forceinline__ void operator()(const AccT& acc, const pg8::Unit& u, int wr, int wc, int fr, int fq) const {
        const int f0 = u.pn * 128 + wc * 32 + 8 * fq; const int lane = fq * 16 + fr;
        const int s1 = (lane & 48) | ((fr - 1) & 15), s2 = (lane & 48) | ((fr - 2) & 15);
        f32x4 w0[2], w1[2], w2[2], bb[2];
#pragma unroll
        for (int n = 0; n < 2; ++n) { w0[n] = *(const f32x4*)(cw + f0 + 4 * n); w1[n] = *(const f32x4*)(cw + DFF + f0 + 4 * n); w2[n] = *(const f32x4*)(cw + 2 * DFF + f0 + 4 * n); bb[n] = *(const f32x4*)(cbias + f0 + 4 * n); }
#pragma unroll
        for (int ai = 0; ai < 2; ++ai) {
            const int blk = u.pm * 4 + ai * 2 + wr; const int rowb = blk * 64;
            f32x4 p1[2], p2[2];
#pragma unroll
            for (int n = 0; n < 2; ++n) { p1[n] = (f32x4){0.f, 0.f, 0.f, 0.f}; p2[n] = p1[n]; }
#pragma unroll
            for (int m = 0; m < 4; ++m) {
                const int row = rowb + 16 * m + fr; const float r = rs_fromu(ssq[row], 1.0f / 1024.0f);
                f32x4 a[2], g[2], o[2], pp[2];
#pragma unroll
                for (int n = 0; n < 2; ++n) { a[n] = acc[ai][0][m][n] * r; g[n] = acc[ai][1][m][n] * r;
                    f32x4 c1, c2;
#pragma unroll
                    for (int e = 0; e < 4; ++e) { c1[e] = __shfl(a[n][e], s1); c2[e] = __shfl(a[n][e], s2); }
                    f32x4 a1, a2;
#pragma unroll
                    for (int e = 0; e < 4; ++e) { a1[e] = fr >= 1 ? c1[e] : p1[n][e]; a2[e] = fr >= 2 ? c2[e] : p2[n][e]; }
                    p1[n] = c1; p2[n] = c2;
                    if (m == 0) {
#pragma unroll
                        for (int e = 0; e < 4; ++e) { if (fr == 0) { a1[e] = 0.f; a2[e] = 0.f; } else if (fr == 1) a2[e] = 0.f; }
                    }
                    pp[n] = bb[n] + w0[n] * a2 + w1[n] * a1 + w2[n] * a[n];
#pragma unroll
                    for (int e = 0; e < 4; ++e) o[n][e] = gelu_t(pp[n][e]) * g[n][e];
                }
                if (m == 0 && fr < 2) {
                    float* hp = head + ((size_t)(blk * 2 + fr) * 2) * DFF + f0;
                    *(f32x4*)(hp) = pp[0]; *(f32x4*)(hp + 4) = pp[1]; *(f32x4*)(hp + DFF) = g[0]; *(f32x4*)(hp + DFF + 4) = g[1];
                } else {
                    *(u32x4*)(ACT + (size_t)row * DFF + f0) = pack8(o[0], o[1]);
                }
                if (m == 3 && fr >= 14) { float* tp = tail + (size_t)(blk * 2 + (fr - 14)) * DFF + f0; *(f32x4*)(tp) = a[0]; *(f32x4*)(tp + 4) = a[1]; }
            }
        }
    }
};

struct EpiMem {
    static constexpr bool PERM = true, AFTER_DRAIN = false;
    const float* rmem; float* out; bf16_t* MEMK; bf16_t* MEMVT;
    __device__ __forceinline__ void operator()(const AccT& acc, const pg8::Unit& u, int wr, int wc, int fr, int fq) const {
        const int row0 = u.pm * 256 + wr * 64 + fr; const int l = u.pn >> 2, kv = (u.pn >> 1) & 1; const int cb = (u.pn & 1) * 256 + wc * 32 + 8 * fq;
#pragma unroll
        for (int ai = 0; ai < 2; ++ai)
#pragma unroll
            for (int m = 0; m < 4; ++m) {
                const int row = row0 + ai * 128 + m * 16; const float r = rmem[row]; const int b = row >> 8, n = row & 255;
                float* fo = out + (kv ? OUT_MV : OUT_MK) + ((size_t)l * 4096 + row) * 512 + cb;
#pragma unroll
                for (int bj = 0; bj < 2; ++bj) { f32x4 x = acc[ai][bj][m][0] * r, y = acc[ai][bj][m][1] * r;
                    *(f32x4*)(fo + bj * 128) = x; *(f32x4*)(fo + bj * 128 + 4) = y;
                    if (!kv) *(u32x4*)(MEMK + (((size_t)l * 48 + b) * 256 + n) * 512 + cb + bj * 128) = pack8(x, y);
                    else { bf16_t* d = MEMVT + (((size_t)l * 48 + b) * 512 + cb + bj * 128) * 256 + n;
#pragma unroll
                        for (int e = 0; e < 4; ++e) { d[(size_t)e * 256] = f2bf(x[e]); d[(size_t)(4 + e) * 256] = f2bf(y[e]); } } }
            }
    }
};

__device__ __forceinline__ void tr_item(const float* src, int lsrc, int k0, int n0, const float* g, bf16_t* dst, int ldd, LAS float* scr, int lane) {
#pragma unroll 8
    for (int i = 0; i < 32; ++i) { const int kk = 2 * i + (lane >> 5); float v = src[(size_t)(k0 + kk) * lsrc + n0 + (lane & 31)]; if (g) v *= g[k0 + kk]; scr[kk * 33 + (lane & 31)] = v; }
    asm volatile("s_waitcnt lgkmcnt(0)" ::: "memory");
    const int c = lane & 7;
#pragma unroll
    for (int j = 0; j < 4; ++j) { const int n = (lane >> 3) + 8 * j; const LAS float* s = scr + (8 * c) * 33 + n;
        u32x4 o; o.x = cvt_pk_bf16(s[0 * 33], s[1 * 33]); o.y = cvt_pk_bf16(s[2 * 33], s[3 * 33]); o.z = cvt_pk_bf16(s[4 * 33], s[5 * 33]); o.w = cvt_pk_bf16(s[6 * 33], s[7 * 33]);
        *(u32x4*)(dst + (size_t)n * ldd + k0 + 8 * c) = o; }
    asm volatile("s_waitcnt lgkmcnt(0)" ::: "memory");
}
__device__ __forceinline__ void tr_plain(const float* src, int K, int N, const float* g, bf16_t* dst, int ldd, int item, LAS float* scr, int lane) {
    const int nblk = N / 32, kb = item / nblk, nb = item % nblk;
    tr_item(src, N, kb * 64, nb * 32, g, dst + (size_t)(nb * 32) * ldd, ldd, scr, lane);
}

struct Args { const float* in[26]; float* out; unsigned char* ws; int ph_lo, ph_hi, coop, pad; };
typedef __attribute__((address_space(4))) const Args* KArgs;

__device__ __forceinline__ void p0_prologue(KArgs a, LAS unsigned char* lds, int tid) {
    const int lane = tid & 63, wave = tid >> 6; const int G = gridDim.x;
    LAS float* scr = (LAS float*)(lds + wave * 8704);
    unsigned char* ws = a->ws;
    const int gw = blockIdx.x * NWAVES + wave, NGW = G * NWAVES;
    constexpr int I_INA = 16 * 48, I_SQ = 16 * 32, I_UP = 16 * 176, I_DN = 44 * 32, I_MV = 4 * 16, I_BV = 8 * 16;
    constexpr int N_INA = 2 * I_INA, N_B = 3 * I_SQ, N_MEM = 4 * I_SQ, N_OUT = 4 * I_SQ, N_UP = 4 * I_UP, N_DN = 4 * I_DN, N_MV = 128 * I_MV, N_BV = 32 * I_BV;
    constexpr int NITEMS = N_INA + N_B + N_MEM + N_OUT + N_UP + N_DN + N_MV + N_BV;
    for (int it = gw; it < NITEMS; it += NGW) {
        int r = it;
        if (r < N_INA) { const int l = r / I_INA; r %= I_INA; tr_plain(a->in[9] + (size_t)l * 1024 * 1536, 1024, 1536, a->in[8] + l * 1024, (bf16_t*)(ws + WS_WINA) + (size_t)l * 1536 * 1024, 1024, r, scr, lane); continue; } r -= N_INA;
        if (r < N_B) { const int s = r / I_SQ; r %= I_SQ;
            const float* src = s == 1 ? a->in[14] : a->in[15] + (size_t)(s >> 1) * 1024 * 1024; const float* g = s == 1 ? a->in[13] : a->in[8] + (2 + (s >> 1)) * 1024;
            tr_plain(src, 1024, 1024, g, (bf16_t*)(ws + WS_WB) + (size_t)s * 1024 * 1024, 1024, r, scr, lane); continue; } r -= N_B;
        if (r < N_MEM) { const int l = r / I_SQ; r %= I_SQ; tr_plain(a->in[18] + (size_t)l * 1024 * 1024, 1024, 1024, a->in[17] + l * 1024, (bf16_t*)(ws + WS_WMEM) + (size_t)l * 1024 * 1024, 1024, r, scr, lane); continue; } r -= N_MEM;
        if (r < N_OUT) { const int l = r / I_SQ; r %= I_SQ; tr_plain(a->in[19] + (size_t)l * 1024 * 1024, 1024, 1024, nullptr, (bf16_t*)(ws + WS_WOUT) + (size_t)l * 1024 * 1024, 1024, r, scr, lane); continue; } r -= N_OUT;
        if (r < N_UP) { const int l = r / I_UP; r %= I_UP; const int kb = r / 176, nb = r % 176; const int s0 = nb * 32; const int bj = s0 / DFF, f = s0 % DFF; const int drow = (f >> 7) * 256 + bj * 128 + (f & 127);
            tr_item(a->in[21] + (size_t)l * 1024 * 5632, 5632, kb * 64, s0, a->in[20] + l * 1024, (bf16_t*)(ws + WS_WUP) + ((size_t)l * 5632 + drow) * 1024, 1024, scr, lane); continue; } r -= N_UP;
        if (r < N_DN) { const int l = r / I_DN; r %= I_DN; tr_plain(a->in[24] + (size_t)l * DFF * 1024, DFF, 1024, nullptr, (bf16_t*)(ws + WS_WDOWN) + (size_t)l * 1024 * DFF, DFF, r, scr, lane); continue; } r -= N_DN;
        if (r < N_MV) { const int mi = r / I_MV; r %= I_MV; const int l = mi >> 5, bs = mi & 31;
            tr_plain(a->in[4] + (size_t)mi * 256 * 512, 256, 512, nullptr, (bf16_t*)(ws + WS_MEMVT) + ((size_t)l * 48 + 16 + bs) * 512 * 256, 256, r, scr, lane); continue; } r -= N_MV;
        { const int bs = r / I_BV; r %= I_BV; tr_plain(a->in[6] + (size_t)bs * 512 * 512, 512, 512, nullptr, (bf16_t*)(ws + WS_SVT) + (size_t)bs * 512 * 576, 576, r, scr, lane); }
    }
    for (int m = gw; m < MT + 4096; m += NGW) {
        const bool ismem = m >= MT; const int rr = ismem ? m - MT : m;
        const float* xr = ismem ? a->in[2] + (size_t)rr * 1024 : (rr < MP ? a->in[0] + (size_t)rr * 1024 : a->in[1] + (size_t)(rr - MP) * 1024);
        bf16_t* orow = (bf16_t*)(ws + (ismem ? WS_MPB : WS_HB)) + (size_t)rr * 1024;
        f32x4 v[4]; float s = 0.f;
#pragma unroll
        for (int j = 0; j < 4; ++j) { v[j] = *((const f32x4*)xr + lane + 64 * j); s += (v[j][0] * v[j][0] + v[j][1] * v[j][1]) + (v[j][2] * v[j][2] + v[j][3] * v[j][3]); }
        s = wave_sum(s);
#pragma unroll
        for (int j = 0; j < 4; ++j) { u32x2 o; o.x = cvt_pk_bf16(v[j][0], v[j][1]); o.y = cvt_pk_bf16(v[j][2], v[j][3]); *((u32x2*)orow + lane + 64 * j) = o; }
        if (lane == 0) { if (ismem) ((float*)(ws + WS_RMEM))[rr] = rs_from(s, 1.0f / 1024.0f); else ((ssq_t*)(ws + WS_SSQ))[rr] = to_fix(s); }
    }
    const size_t gt = (size_t)blockIdx.x * NTHR + tid, NT = (size_t)G * NTHR;
    { ssq_t* z = (ssq_t*)(ws + WS_SSQ) + MT; for (size_t i = gt; i < (size_t)10 * MT; i += NT) z[i] = 0ull; }
    { bf16_t* wsb = (bf16_t*)(ws + WS_WSB); const float* w = a->in[11];
      for (size_t i = gt; i < (size_t)2 * 8 * 128 * 128; i += NT) { const int jj = (int)(i & 127), ii = (int)((i >> 7) & 127); wsb[i] = jj <= ii ? f2bf(w[i]) : (unsigned short)0; } }
    {
      const f32x4* src = (const f32x4*)a->in[3]; bf16_t* dst = (bf16_t*)(ws + WS_MEMK);
      for (size_t i = gt; i < (size_t)4 * 32 * 256 * 512 / 4; i += NT) { const size_t e = i * 4; const size_t mi = e / (256 * 512), rem = e % (256 * 512); const size_t l = mi >> 5, bs = mi & 31;
          const f32x4 v = src[i]; u32x2 o; o.x = cvt_pk_bf16(v[0], v[1]); o.y = cvt_pk_bf16(v[2], v[3]); *(u32x2*)(dst + ((l * 48 + 16 + bs) * 256 * 512) + rem) = o; } }
    {
      const f32x4* src = (const f32x4*)a->in[5]; bf16_t* dst = (bf16_t*)(ws + WS_SK);
      for (size_t i = gt; i < (size_t)32 * 512 * 512 / 4; i += NT) { const size_t e = i * 4; const size_t bs = e / (512 * 512), rem = e % (512 * 512);
          const f32x4 v = src[i]; u32x2 o; o.x = cvt_pk_bf16(v[0], v[1]); o.y = cvt_pk_bf16(v[2], v[3]); *(u32x2*)(dst + bs * 576 * 512 + rem) = o; } }
}

__device__ __forceinline__ void gate_unit(LAS unsigned char* lds, int tid, int chunk, int joff, int nib, int row0,
                                          const bf16_t* wsb, const bf16_t* VT, const bf16_t* U, const ssq_t* ssqv, const float* gv, const float* bs, bf16_t* CAT, float* av_out) {
    const int g = tid >> 6, lane = tid & 63, l32 = lane & 31, half = lane >> 5;
    LAS float* rv = (LAS float*)lds;
    __syncthreads();
    if (tid < nib * 32) rv[tid] = rs_fromu(ssqv[row0 + tid], 1.0f / 512.0f);
    __syncthreads();
    const bf16_t* vt_g = VT + ((size_t)chunk * 512 + g * 64) * 128 + joff;
    const bf16_t* w_g = wsb + (size_t)g * 128 * 128;
#pragma unroll 1
    for (int db = 0; db < 2; ++db) {
        f32x16 acc[4];
#pragma unroll
        for (int i = 0; i < 4; ++i)
#pragma unroll
            for (int e = 0; e < 16; ++e) acc[i][e] = 0.f;
        const bf16_t* vt_d = vt_g + (size_t)(db * 32 + l32) * 128 + half * 8;
        const bf16_t* w_d = w_g + (size_t)l32 * 128 + half * 8;
#pragma unroll
        for (int ks = 0; ks < 8; ++ks) {
            if (ks < nib * 2) {
                const int j0 = ks * 16 + half * 8;
                const u32x4 raw = *(const u32x4*)(vt_d + ks * 16);
                u32x4 sc;
#pragma unroll
                for (int q = 0; q < 4; ++q) { const float lo = __builtin_bit_cast(float, raw[q] << 16) * rv[j0 + 2 * q], hi = __builtin_bit_cast(float, raw[q] & 0xffff0000u) * rv[j0 + 2 * q + 1]; sc[q] = cvt_pk_bf16(lo, hi); }
                const bf16x8 bfr = __builtin_bit_cast(bf16x8, sc);
#pragma unroll
                for (int ib = 0; ib < 4; ++ib) {
                    if (ib < nib && ks < (ib + 1) * 2) {
                        const bf16x8 af = *(const bf16x8*)(w_d + ib * 32 * 128 + ks * 16);
                        acc[ib] = MFMA32(af, bfr, acc[ib]);
                    }
                }
            }
        }
        const int c = g * 64 + db * 32 + l32; const float gvc = gv[c];
        const bf16_t* ub = U + ((size_t)row0 + 4 * half) * 512 + c; bf16_t* cbp = CAT + ((size_t)row0 + 4 * half) * 1024 + c; const float* bsp = bs + g * 128 + 4 * half;
#pragma unroll
        for (int ib = 0; ib < 4; ++ib) {
            if (ib < nib) {
#pragma unroll
                for (int e = 0; e < 16; ++e) { const int i = ib * 32 + (e & 3) + 8 * (e >> 2);
                    const float s = acc[ib][e] * gvc + bsp[i];
                    cbp[(size_t)i * 1024] = f2bf(bf2f(ub[(size_t)i * 512]) * s); }
            }
        }
    }
    if (av_out) {
        for (int e = tid; e < 64 * 512; e += NTHR) { const int t = e >> 9, c = e & 511; av_out[e] = bf2f(VT[((size_t)chunk * 512 + c) * 128 + joff + t]) * rv[t] * gv[c]; }
    }
}

template <int D, bool BAND>
__device__ __forceinline__ void attn_unit(LAS unsigned char* lds, int tid, const bf16_t* Qw, bool hasq, const bf16_t* Kb, int ldk, const bf16_t* Vtb, int ldv,
                                          int jstart, int nkb, int jlo, int jhi, bf16_t* Ow, LAS const float* btab, int relq) {
    constexpr int KROW = (D + 8) * 2, VROW = 144, KBYTES = 64 * KROW, VBYTES = D * VROW, BUF = KBYTES + VBYTES, NR = D / 64, KK = D / 16, DB = D / 32;
    const int lane = tid & 63, l32 = lane & 31, half = lane >> 5;
    bf16x8 qf[KK];
#pragma unroll
    for (int kk = 0; kk < KK; ++kk) qf[kk] = hasq ? *(const bf16x8*)(Qw + (size_t)l32 * 512 + kk * 16 + half * 8) : (bf16x8){0, 0, 0, 0, 0, 0, 0, 0};
    f32x16 O[DB];
#pragma unroll
    for (int d = 0; d < DB; ++d)
#pragma unroll
        for (int e = 0; e < 16; ++e) O[d][e] = 0.f;
    float mrun = -1e30f, lsum = 0.f;
    u32x4 kreg[NR], vreg[NR];
    auto gload = [&](int j) {
#pragma unroll
        for (int i = 0; i < NR; ++i) { const int id = tid + i * NTHR; const int kr = id / (D / 8), kc = id % (D / 8); kreg[i] = *(const u32x4*)(Kb + (long)(j * 64 + kr) * ldk + kc * 8);
            const int vr = id >> 3, vc = id & 7; vreg[i] = *(const u32x4*)(Vtb + (long)vr * ldv + j * 64 + vc * 8); }
    };
    auto lstore = [&](int buf) {
        LAS unsigned char* b = lds + buf * BUF;
#pragma unroll
        for (int i = 0; i < NR; ++i) { const int id = tid + i * NTHR; const int kr = id / (D / 8), kc = id % (D / 8); *(LAS u32x4*)(b + kr * KROW + kc * 16) = kreg[i];
            const int vr = id >> 3, vc = id & 7; *(LAS u32x4*)(b + KBYTES + vr * VROW + vc * 16) = vreg[i]; }
    };
    __syncthreads();
    gload(jstart); lstore(0);
    __syncthreads();
    for (int j = jstart; j < nkb; ++j) {
        const int cur = (j - jstart) & 1;
        if (j + 1 < nkb) gload(j + 1);
        if (hasq && j >= jlo && j <= jhi) {
            const LAS unsigned char* b = lds + cur * BUF;
            f32x16 S[2];
#pragma unroll
            for (int s = 0; s < 2; ++s) {
#pragma unroll
                for (int e = 0; e < 16; ++e) S[s][e] = 0.f;
#pragma unroll
                for (int kk = 0; kk < KK; ++kk) { const bf16x8 af = *(const LAS bf16x8*)(b + (s * 32 + l32) * KROW + (kk * 16 + half * 8) * 2); S[s] = MFMA32(af, qf[kk], S[s]); }
                if (BAND) {
#pragma unroll
                    for (int e = 0; e < 16; ++e) { const int kidx = j * 64 + s * 32 + crow(e, half); int rel = relq - kidx; rel = rel > 256 ? 256 : rel; S[s][e] += btab[rel + 63]; }
                }
            }
            float mx = S[0][0];
#pragma unroll
            for (int e = 1; e < 16; ++e) mx = fmaxf(mx, S[0][e]);
#pragma unroll
            for (int e = 0; e < 16; ++e) mx = fmaxf(mx, S[1][e]);
            mx = fmaxf(mx, __shfl_xor(mx, 32));
            const float mnew = fmaxf(mrun, mx); const float alpha = __builtin_amdgcn_exp2f(mrun - mnew); mrun = mnew;
            float ps = 0.f;
#pragma unroll
            for (int s = 0; s < 2; ++s)
#pragma unroll
                for (int e = 0; e < 16; ++e) { const float p = __builtin_amdgcn_exp2f(S[s][e] - mnew); S[s][e] = p; ps += p; }
            lsum = lsum * alpha + ps;
#pragma unroll
            for (int d = 0; d < DB; ++d)
#pragma unroll
                for (int e = 0; e < 16; ++e) O[d][e] *= alpha;
#pragma unroll
            for (int s = 0; s < 2; ++s)
#pragma unroll
                for (int t = 0; t < 2; ++t) {
                    u32x4 pk;
#pragma unroll
                    for (int q = 0; q < 4; ++q) pk[q] = cvt_pk_bf16(S[s][8 * t + 2 * q], S[s][8 * t + 2 * q + 1]);
                    const bf16x8 pb = __builtin_bit_cast(bf16x8, pk);
#pragma unroll
                    for (int d = 0; d < DB; ++d) {
                        const LAS unsigned char* vp = b + KBYTES + (d * 32 + l32) * VROW + (s * 32 + 16 * t + 4 * half) * 2;
                        const u32x2 v0 = *(const LAS u32x2*)vp, v1 = *(const LAS u32x2*)(vp + 16);
                        const u32x4 vv = {v0.x, v0.y, v1.x, v1.y};
                        O[d] = MFMA32(__builtin_bit_cast(bf16x8, vv), pb, O[d]);
                    }
                }
        }
        if (j + 1 < nkb) lstore(cur ^ 1);
        __syncthreads();
    }
    if (hasq) {
        const float l = lsum + __shfl_xor(lsum, 32); const float inv = 1.0f / l;
#pragma unroll
        for (int d = 0; d < DB; ++d)
#pragma unroll
            for (int gq = 0; gq < 4; ++gq) {
                u32x2 o; o.x = cvt_pk_bf16(O[d][4 * gq] * inv, O[d][4 * gq + 1] * inv); o.y = cvt_pk_bf16(O[d][4 * gq + 2] * inv, O[d][4 * gq + 3] * inv);
                *(u32x2*)(Ow + (size_t)l32 * 1024 + d * 32 + 8 * gq + 4 * half) = o;
            }
    }
}

__device__ __forceinline__ void mixer_phase(KArgs a, LAS unsigned char* lds, int tid_in, int l) {
    unsigned char* ws = a->ws; const int G = gridDim.x;
    bf16_t* CAT = (bf16_t*)(ws + WS_CAT);
    constexpr int N_MEMP = 16 * 16 * 4, N_MEMS = 32 * 4;
#ifndef NO_MEMATT
    {
        int tid = tid_in; asm volatile("" : "+v"(tid)); const int wave = tid >> 6;
        const bf16_t* QM = (const bf16_t*)(ws + WS_QM);
        for (int it = blockIdx.x; it < N_MEMP + N_MEMS; it += G) {
            int r = it; int bb, h, q0, nq;
            if (r < N_MEMP) { h = r & 3; const int qb = (r >> 2) & 15; bb = r >> 6; q0 = bb * SEQ + qb * 256; nq = 256; }
            else { r -= N_MEMP; h = r & 3; const int bs = r >> 2; bb = 16 + bs; q0 = MP + bs * 64; nq = 64; }
            const bool hasq = wave * 32 < nq; const int qrow = q0 + wave * 32;
            attn_unit<128, false>(lds, tid, QM + (size_t)qrow * 512 + h * 128, hasq, (const bf16_t*)(ws + WS_MEMK) + ((size_t)l * 48 + bb) * 256 * 512 + h * 128, 512,
                                  (const bf16_t*)(ws + WS_MEMVT) + (((size_t)l * 48 + bb) * 512 + h * 128) * 256, 256, 0, 4, 0, 3, CAT + (size_t)qrow * 1024 + 512 + h * 128, nullptr, 0);
        }
    }
#endif
    if (l < 2) {
#ifndef NO_GATE
        int tid = tid_in; asm volatile("" : "+v"(tid));
        for (int r = blockIdx.x; r < 512 + 32; r += G) {
            int chunk, joff, nib, row0; float* av = nullptr;
            if (r < 512) { chunk = r; joff = 0; nib = 4; row0 = r * 128; }
            else { const int bs = r - 512; chunk = 512 + (bs >> 1); joff = (bs & 1) * 64; nib = 2; row0 = MP + bs * 64; av = a->out + OUT_AV + ((size_t)l * 32 + bs) * 64 * 512; }
            gate_unit(lds, tid, chunk, joff, nib, row0, (const bf16_t*)(ws + WS_WSB) + (size_t)l * 8 * 128 * 128, (const bf16_t*)(ws + WS_VT), (const bf16_t*)(ws + WS_U),
                      (const ssq_t*)(ws + WS_SSQ) + (size_t)(9 + l) * MT, a->in[10] + l * 512, a->in[12] + l * 8 * 128, CAT, av);
        }
#endif
    } else {
#ifndef NO_BAND
        int tid = tid_in; asm volatile("" : "+v"(tid)); const int wave = tid >> 6;
        const int jl = l - 2; const bf16_t* Q = (const bf16_t*)(ws + WS_U);
        LAS float* btab = (LAS float*)(lds + 40960);
        for (int it = blockIdx.x; it < 16 * 8 * 16 + 32 * 8; it += G) {
            int r = it;
            int h, qrow, jstart, nkb, jlo, jhi, relq; const bf16_t* Kb; const bf16_t* Vtb; int ldv; bool hasq;
            if (r < 16 * 8 * 16) { h = r & 7; const int cg4 = (r >> 3) & 15; const int b = r >> 7; const int c0 = cg4 * 4;
                qrow = b * SEQ + c0 * 64 + wave * 32; hasq = true; nkb = 12; jstart = c0 >= 8 ? 0 : 8 - c0; jlo = wave >> 1; jhi = jlo + 8;
                Kb = (const bf16_t*)(ws + WS_PK) + ((long)b * SEQ + (long)(c0 - 8) * 64) * 512 + h * 64;
                Vtb = (const bf16_t*)(ws + WS_PVT) + ((long)b * 512 + h * 64) * 4096 + (long)(c0 - 8) * 64; ldv = 4096;
                relq = 512 + (wave >> 1) * 64 + (wave & 1) * 32 + (tid & 31); }
            else { r -= 16 * 8 * 16; h = r & 7; const int bs = r >> 3; qrow = MP + bs * 64 + wave * 32; hasq = wave < 2; nkb = 9; jstart = 0; jlo = 0; jhi = 8;
                Kb = (const bf16_t*)(ws + WS_SK) + (size_t)bs * 576 * 512 + h * 64; Vtb = (const bf16_t*)(ws + WS_SVT) + ((size_t)bs * 512 + h * 64) * 576; ldv = 576;
                relq = 512 + (wave & 1) * 32 + (tid & 31); }
            __syncthreads();
            if (tid < 320) btab[tid] = a->in[16][((size_t)jl * 8 + h) * 513 + 193 + tid] * LOG2E;
            attn_unit<64, true>(lds, tid, Q + (size_t)qrow * 512 + h * 64, hasq, Kb, 512, Vtb, ldv, jstart, nkb, jlo, jhi, CAT + (size_t)qrow * 1024 + h * 64, btab, relq);
        }
#endif
    }
}

__device__ __forceinline__ void fixup_phase(KArgs a, int tid, int l) {
    unsigned char* ws = a->ws; const float* tail = (const float*)(ws + WS_TAIL); const float* head = (const float*)(ws + WS_HEAD); bf16_t* ACT = (bf16_t*)(ws + WS_ACT);
    const float* cw = a->in[22] + (size_t)l * 3 * DFF; const float* sc = a->in[7] + (size_t)l * 32 * 2 * DFF;
    const size_t gt = (size_t)blockIdx.x * NTHR + tid, NT = (size_t)gridDim.x * NTHR;
    for (size_t i = gt; i < (size_t)NBLK64 * DFF; i += NT) {
        const int blk = (int)(i / DFF), f = (int)(i % DFF);
        float pm2, pm1;
        if (blk >= MP / 64) { const int bs = blk - MP / 64; pm2 = sc[((size_t)bs * 2 + 0) * DFF + f]; pm1 = sc[((size_t)bs * 2 + 1) * DFF + f]; }
        else if ((blk & 63) == 0) { pm2 = 0.f; pm1 = 0.f; }
        else { pm2 = tail[((size_t)(blk - 1) * 2 + 0) * DFF + f]; pm1 = tail[((size_t)(blk - 1) * 2 + 1) * DFF + f]; }
        const float w0 = cw[f], w1 = cw[DFF + f];
        const float* hp = head + (size_t)blk * 4 * DFF + f;
        const float c0 = hp[0] + w0 * pm2 + w1 * pm1, g0 = hp[DFF], c1 = hp[2 * DFF] + w0 * pm1, g1 = hp[3 * DFF];
        ACT[(size_t)blk * 64 * DFF + f] = f2bf(gelu_t(c0) * g0);
        ACT[((size_t)blk * 64 + 1) * DFF + f] = f2bf(gelu_t(c1) * g1);
        const float t0 = tail[((size_t)blk * 2 + 0) * DFF + f], t1 = tail[((size_t)blk * 2 + 1) * DFF + f];
        if (blk >= MP / 64) { float* o = a->out + OUT_CS + ((size_t)l * 32 + (blk - MP / 64)) * 2 * DFF + f; o[0] = t0; o[DFF] = t1; }
        else if ((blk & 63) == 63) { float* o = a->out + OUT_CP + ((size_t)l * 16 + (blk >> 6)) * 2 * DFF + f; o[0] = t0; o[DFF] = t1; }
    }
}

__device__ __forceinline__ void final_phase(KArgs a, int tid) {
    const ssq_t* ssq = (const ssq_t*)(a->ws + WS_SSQ) + (size_t)4 * MT; const float* g = a->in[25]; const bf16_t* hb = (const bf16_t*)(a->ws + WS_HB);
    const int lane = tid & 63; const int gw = blockIdx.x * NWAVES + (tid >> 6), NGW = gridDim.x * NWAVES;
    for (int m = gw; m < MT; m += NGW) {
        const float r = rs_fromu(ssq[m], 1.0f / 1024.0f); f32x4* row = (f32x4*)(a->out + (size_t)m * 1024); const u32x2* hr = (const u32x2*)(hb + (size_t)m * 1024);
#pragma unroll
        for (int j = 0; j < 4; ++j) { const f32x4 gg = *((const f32x4*)g + lane + 64 * j); const u32x2 w = hr[lane + 64 * j]; f32x4 v;
            v[0] = __builtin_bit_cast(float, w.x << 16); v[1] = __builtin_bit_cast(float, w.x & 0xffff0000u); v[2] = __builtin_bit_cast(float, w.y << 16); v[3] = __builtin_bit_cast(float, w.y & 0xffff0000u);
            row[lane + 64 * j] = v * r * gg; }
    }
}


#define XB_TMO      128
#define XB_XCNT(j)  (256  + 64 * (j))
#define XB_XSUB(j)  (1280 + 64 * (j))
#define XB_XGEN(j)  (2304 + 64 * (j))
#define XB_TOP      3328
#define XB_TOPGEN   3392
#define XCD_BAR_WORDS 3456
#define XB_SPIN_CAP (1u << 18)

__device__ __forceinline__ unsigned xb_ld(unsigned* p)              { return __hip_atomic_load(p, __ATOMIC_RELAXED, __HIP_MEMORY_SCOPE_AGENT); }
__device__ __forceinline__ unsigned xb_add(unsigned* p, unsigned v) { return __hip_atomic_fetch_add(p, v, __ATOMIC_RELAXED, __HIP_MEMORY_SCOPE_AGENT); }
__device__ __forceinline__ unsigned xb_xcc_id() { return (unsigned)__builtin_amdgcn_s_getreg((3 << 11) | 20) & 0xFu; }
#define XB_SPIN(cond, bar) do { unsigned _sp = 0; while (cond) { __builtin_amdgcn_s_sleep(1); \
    if ((++_sp & 255u) == 0u) { if (xb_ld(&(bar)[XB_TMO])) break; if (_sp > XB_SPIN_CAP) { atomicAdd(&(bar)[XB_TMO], 1u); break; } } } } while (0)

struct XcdBarrier {
    unsigned* bar; unsigned x;
    volatile LAS unsigned* st;
};

__device__ __forceinline__ XcdBarrier xcd_barrier_post(unsigned* bar, volatile LAS unsigned* st) {
    XcdBarrier b; b.bar = bar; b.x = xb_xcc_id(); b.st = st;
    if (threadIdx.x == 0) (void)xb_add(&bar[XB_XCNT(b.x)], 1u);
    return b;
}
__device__ __forceinline__ void xcd_barrier_complete(unsigned* bar, unsigned x, unsigned& nloc, unsigned& nx) {
    const unsigned G = gridDim.x * gridDim.y * gridDim.z;
    unsigned sum, cnt, mine, sp = 0u;
    for (;;) {
        sum = 0u; cnt = 0u; mine = 0u;
#pragma unroll
        for (unsigned j = 0; j < 16; ++j) { const unsigned c = xb_ld(&bar[XB_XCNT(j)]); sum += c; cnt += (c > 0u) ? 1u : 0u; mine = (j == x) ? c : mine; }
        if (sum == G) break;
        __builtin_amdgcn_s_sleep(1);
        if ((++sp & 255u) == 0u) { if (xb_ld(&bar[XB_TMO])) break; if (sp > XB_SPIN_CAP) { atomicAdd(&bar[XB_TMO], 1u); break; } }
    }
    nloc = mine > 0u ? mine : 1u; nx = cnt > 0u ? cnt : 1u;
}

__device__ __forceinline__ void xcd_barrier(const XcdBarrier& b) {
    asm volatile("s_waitcnt vmcnt(0)" ::: "memory");
    __syncthreads();
    if (threadIdx.x == 0) {
        unsigned* bar = b.bar;
        __builtin_amdgcn_s_waitcnt(0);
        unsigned nloc = b.st[0], nx = b.st[1];
        if (nloc == 0u) { xcd_barrier_complete(bar, b.x, nloc, nx); b.st[0] = nloc; b.st[1] = nx; }
        const unsigned old = xb_add(&bar[XB_XSUB(b.x)], 1u);
        const unsigned gen = old / nloc;
        if (old + 1u == (gen + 1u) * nloc) {
            __builtin_amdgcn_fence(__ATOMIC_RELEASE, "agent");
            asm volatile("s_waitcnt vmcnt(0)" ::: "memory");
            const unsigned og = xb_add(&bar[XB_TOP], 1u);
            const unsigned tg = og / nx;
            if (og + 1u == (tg + 1u) * nx) xb_add(&bar[XB_TOPGEN], 1u);
            else XB_SPIN(xb_ld(&bar[XB_TOPGEN]) == tg, bar);
            __builtin_amdgcn_fence(__ATOMIC_ACQUIRE, "agent");
            xb_add(&bar[XB_XGEN(b.x)], 1u);
            asm volatile("s_waitcnt vmcnt(0)" ::: "memory");
        } else {
            XB_SPIN(xb_ld(&bar[XB_XGEN(b.x)]) == gen, bar);
            __builtin_amdgcn_fence(__ATOMIC_ACQUIRE, "agent");
            asm volatile("s_waitcnt vmcnt(0)" ::: "memory");
        }
    }
    __syncthreads();
}

#ifndef REP_P0
#define REP_P0 1
#endif
#ifndef REP_MIX
#define REP_MIX 1
#endif
#ifndef REP_UP
#define REP_UP 1
#endif
#ifndef REP_G
#define REP_G 1
#endif
__device__ __forceinline__ void launder(int& t) { asm volatile("" : "+v"(t)); }
__global__ void __launch_bounds__(NTHR, 2) fwd_kernel(Args a) {
    extern __shared__ __attribute__((aligned(16))) unsigned char lds_raw[];
    LAS unsigned char* lds = (LAS unsigned char*)lds_raw;
    int tid = threadIdx.x; const int G = gridDim.x;
    KArgs kp = (KArgs)__builtin_amdgcn_kernarg_segment_ptr();
    volatile LAS unsigned* bst = (volatile LAS unsigned*)(lds + 131072 + 64);
    if (tid < 2) bst[tid] = 0u;
    __syncthreads();
    XcdBarrier bar; bar.bar = (unsigned*)(a.ws + WS_BAR); bar.x = 0; bar.st = bst;
    if (a.coop) bar = xcd_barrier_post((unsigned*)(a.ws + WS_BAR), bst);
#define PH_ARGS() KArgs q = kp; asm volatile("" : "+s"(q)); unsigned char* ws = q->ws; ssq_t* ssqb = (ssq_t*)(ws + WS_SSQ); bf16_t* HB = (bf16_t*)(ws + WS_HB); (void)ssqb; (void)HB;
    int ph = 0;
#ifndef REP_SYNC
#define REP_SYNC 1
#endif
#define SEAM() do { if (a.coop && ph + 1 < a.ph_hi) { for (int rs_ = 0; rs_ < REP_SYNC; ++rs_) { if (a.coop == 2) cg::this_grid().sync(); else xcd_barrier(bar); } } } while (0)
#define IN_PH() (launder(tid), ph >= a.ph_lo && ph < a.ph_hi)
#ifndef EN_MASK
#define EN_MASK 0xffff
#endif
#define EN(k) ((EN_MASK >> (k)) & 1)

    if (IN_PH()) { PH_ARGS(); for (int rep = 0; rep < REP_P0; ++rep) p0_prologue(q, lds, tid); SEAM(); } ++ph;

#pragma unroll 1
    for (int l = 0; l < 4; ++l) {
        if (IN_PH()) { PH_ARGS();
            if (l < 2) { if (EN(1)) {
                pg8::Gemm g{HB, (const bf16_t*)(ws + WS_WINA) + (size_t)l * 1536 * 1024, MT, 1536, 1024}; pg8::StaticOrder S; S.init(MT, 1536, G, (int)blockIdx.x);
                EpiInA E{ssqb + (size_t)l * MT, (bf16_t*)(ws + WS_U), (bf16_t*)(ws + WS_VT), (bf16_t*)(ws + WS_QM), ssqb + (size_t)(9 + l) * MT, 0.08838834764831845f * LOG2E};
                S.rep = REP_G; pg8::gemm_phase<EpiInA, pg8::StaticOrder, true, true>(lds, g, S, E, tid); }
                if (EN(2) && l == 0) {
                    pg8::Gemm g2{(const bf16_t*)(ws + WS_MPB), (const bf16_t*)(ws + WS_WMEM), 4096, 4096, 1024}; pg8::StaticOrder S2; S2.init(4096, 4096, G, (int)blockIdx.x);
                    EpiMem E2{(const float*)(ws + WS_RMEM), q->out, (bf16_t*)(ws + WS_MEMK), (bf16_t*)(ws + WS_MEMVT)};
                    pg8::gemm_phase<EpiMem, pg8::StaticOrder, true, true>(lds, g2, S2, E2, tid);
                }
            } else if (EN(3)) {
                const int N = l == 2 ? 2048 : 1024;
                pg8::Gemm g{HB, (const bf16_t*)(ws + WS_WB) + (size_t)(l == 2 ? 0 : 2048) * 1024, MT, N, 1024}; pg8::StaticOrder S; S.init(MT, N, G, (int)blockIdx.x);
                EpiInB E{ssqb + (size_t)l * MT, (bf16_t*)(ws + WS_U), (bf16_t*)(ws + WS_QM), (bf16_t*)(ws + WS_PK), (bf16_t*)(ws + WS_PVT), (bf16_t*)(ws + WS_SK), (bf16_t*)(ws + WS_SVT), q->out,
                         0.125f * LOG2E, 0.08838834764831845f * LOG2E};
                S.rep = REP_G; pg8::gemm_phase<EpiInB, pg8::StaticOrder, true, true>(lds, g, S, E, tid);
            }
            SEAM();
        } ++ph;
        if (IN_PH()) { PH_ARGS(); for (int rep = 0; rep < REP_MIX; ++rep) mixer_phase(q, lds, tid, l); SEAM(); } ++ph;
        if (IN_PH()) { PH_ARGS(); if (EN(5)) {
            pg8::Gemm g{(const bf16_t*)(ws + WS_CAT), (const bf16_t*)(ws + WS_WOUT) + (size_t)l * 1024 * 1024, MT, 1024, 1024}; pg8::StaticOrder S; S.init(MT, 1024, G, (int)blockIdx.x);
            EpiRes E{HB, ssqb + (size_t)(5 + l) * MT};
            S.rep = REP_G; pg8::gemm_phase<EpiRes, pg8::StaticOrder, true, true>(lds, g, S, E, tid); }
            SEAM();
        } ++ph;
        if (IN_PH()) { PH_ARGS(); if (EN(6)) {
            pg8::Gemm g{HB, (const bf16_t*)(ws + WS_WUP) + (size_t)l * 5632 * 1024, MT, 5632, 1024}; pg8::StaticOrder S; S.init(MT, 5632, G, (int)blockIdx.x);
            EpiUp E{ssqb + (size_t)(5 + l) * MT, q->in[22] + (size_t)l * 3 * DFF, q->in[23] + (size_t)l * DFF, (bf16_t*)(ws + WS_ACT), (float*)(ws + WS_TAIL), (float*)(ws + WS_HEAD)};
            S.rep = REP_UP; pg8::gemm_phase<EpiUp, pg8::StaticOrder, true, true>(lds, g, S, E, tid); }
            SEAM();
        } ++ph;
        if (IN_PH()) { PH_ARGS(); if (EN(7)) fixup_phase(q, tid, l); SEAM(); } ++ph;
        if (IN_PH()) { PH_ARGS(); if (EN(8)) {
            pg8::Gemm g{(const bf16_t*)(ws + WS_ACT), (const bf16_t*)(ws + WS_WDOWN) + (size_t)l * 1024 * DFF, MT, 1024, DFF}; pg8::StaticOrder S; S.init(MT, 1024, G, (int)blockIdx.x);
            EpiRes E{HB, ssqb + (size_t)(l + 1) * MT};
            S.rep = REP_G; pg8::gemm_phase<EpiRes, pg8::StaticOrder, true, true>(lds, g, S, E, tid); }
            SEAM();
        } ++ph;
    }
    if (IN_PH()) { PH_ARGS(); if (EN(9)) final_phase(q, tid); } ++ph;
#undef SEAM
#undef IN_PH
}
constexpr int N_PHASES = 26;

#ifndef MK_MULTI
#define MK_MULTI 0
#endif

extern "C" void kernel_launch(void* const* d_in, const int* in_sizes, int n_in, void* d_out, int out_size, void* d_ws, size_t ws_size, hipStream_t stream) {
    static int grid = 0;
    if (grid == 0) {
        if (n_in != 26 || (size_t)out_size != OUT_END || ws_size < WS_END) { fprintf(stderr, "kernel_launch: unexpected sizes n_in %d out %d ws %zu (need %zu)\n", n_in, out_size, ws_size, (size_t)WS_END); grid = -1; return; }
        int dev = 0, cus = 0, per_cu = 0;
        if (hipGetDevice(&dev) != hipSuccess || hipDeviceGetAttribute(&cus, hipDeviceAttributeMultiprocessorCount, dev) != hipSuccess) { grid = -1; return; }
        if (hipFuncSetAttribute((const void*)fwd_kernel, hipFuncAttributeMaxDynamicSharedMemorySize, LDS_BYTES) != hipSuccess) { fprintf(stderr, "kernel_launch: hipFuncSetAttribute failed\n"); grid = -1; return; }
        if (hipOccupancyMaxActiveBlocksPerMultiprocessor(&per_cu, (const void*)fwd_kernel, NTHR, LDS_BYTES) != hipSuccess || per_cu < 1) { fprintf(stderr, "kernel_launch: occupancy query says %d\n", per_cu); per_cu = 1; }
        (void)hipGetLastError();
        grid = cus * 1;
    }
    if (grid < 0) return;
    Args a{};
    for (int i = 0; i < 26; ++i) a.in[i] = (const float*)d_in[i];
    a.out = (float*)d_out; a.ws = (unsigned char*)d_ws;
#if MK_MULTI
    for (int p = 0; p < N_PHASES; ++p) { a.ph_lo = p; a.ph_hi = p + 1; a.coop = 0; hipLaunchKernelGGL(fwd_kernel, dim3(grid), dim3(NTHR), LDS_BYTES, stream, a); }
#else
    a.ph_lo = 0; a.ph_hi = N_PHASES; a.coop = 1;
    if (hipMemsetAsync((char*)d_ws + WS_BAR, 0, BAR_BYTES, stream) != hipSuccess) { fprintf(stderr, "memset failed\n"); return; }
    void* args[] = {&a};
    hipError_t e = hipLaunchCooperativeKernel((const void*)fwd_kernel, dim3(grid), dim3(NTHR), args, LDS_BYTES, stream);
    if (e != hipSuccess) fprintf(stderr, "cooperative launch failed: %s (grid %d)\n", hipGetErrorString(e), grid);
#endif
}
```

```cpp
#include <hip/hip_runtime.h>
#include <hip/hip_cooperative_groups.h>
#include <cstdio>
#include <cstdint>
namespace cg = cooperative_groups;
namespace pg8 {
#define PG8_LAS __attribute__((address_space(3)))
typedef unsigned short bf16_t;
typedef short bf16x8 __attribute__((ext_vector_type(8)));
typedef float f32x4 __attribute__((ext_vector_type(4)));
typedef unsigned u32x4 __attribute__((ext_vector_type(4)));
constexpr int BM = 256, BK = 64, HALF = 128, HTB = HALF * BK * 2  , STAGE_BYTES = 8 * HTB, NXCD = 8, WGM = 8;

__host__ __device__ __forceinline__ int lds_byte(int r, int c) { const int st = (r >> 4) * 2 + (c >> 5), rr = r & 15, cc = c & 31, ob = rr * 64 + cc * 2; return st * 1024 + (ob ^ (((ob >> 9) & 1) << 5)); }
__host__ __device__ __forceinline__ void stage_rc(int b, int& R, int& C) { const int st = b / 1024, sb = b % 1024, swz = sb ^ (((sb >> 9) & 1) << 5); R = (st >> 1) * 16 + swz / 64; C = (st & 1) * 32 + (swz % 64) / 2; }
__host__ __device__ __forceinline__ int perm32(int rho) { const int n = rho >> 4, i = rho & 15; return 8 * (i >> 2) + 4 * n + (i & 3); }

struct Unit { int pm, pn, pass; };
struct Gemm { const bf16_t* A; const bf16_t* Bt; int M, N, K; };

struct StaticOrder {
    int nM, nN, nwg, G, c, rep = 1;
    __host__ __device__ void init(int M, int N, int G_, int c_) { nM = M / BM; nN = N / BM; nwg = nM * nN; G = G_; c = c_; }
    __host__ __device__ bool next(int i, Unit& u) const {
        const long L = (long)i * G + c; if (L >= (long)nwg * rep) return false;
        int wgid = (int)(L % nwg); u.pass = (int)(L / nwg); { const int q = nwg / NXCD, r = nwg % NXCD, xcd = wgid % NXCD, off = wgid / NXCD; wgid = (xcd < r ? xcd * (q + 1) : r * (q + 1) + (xcd - r) * q) + off; }
        const int nig = WGM * nN, gid = wgid / nig, fm = gid * WGM, gsz = (nM - fm) < WGM ? (nM - fm) : WGM;
        u.pm = fm + ((wgid % nig) % gsz); u.pn = (wgid % nig) / gsz; return true;
    }
    __device__ __forceinline__ void a_ready(const Unit&) const {}
    __device__ __forceinline__ void done(const Unit&) const {}
};

__device__ __forceinline__ unsigned cvt_pk_bf16(float lo, float hi) { unsigned r; asm volatile("v_cvt_pk_bf16_f32 %0, %1, %2" : "=v"(r) : "v"(lo), "v"(hi)); return r; }
template <class Epi, class Sched, bool ALIGN_EPI = false, bool SP2 = false>
__device__ __forceinline__ void gemm_phase(PG8_LAS unsigned char* lds, const Gemm g, const Sched& S, const Epi& E, const int tid) {
    const int wid = __builtin_amdgcn_readfirstlane(tid >> 6), lane = tid & 63, wr = wid >> 2, wc = wid & 3, fr = lane & 15, fq = lane >> 4;
    const int K = g.K, nt = K / BK;
    unsigned voffA[2], voffB[2];
#pragma unroll
    for (int i = 0; i < 2; ++i) { int R, C; stage_rc(tid * 16 + i * 8192, R, C); const int Rb = Epi::PERM ? ((R & ~31) + perm32(R & 31)) : R;
        voffA[i] = (unsigned)(R * K + C) * 2u; voffB[i] = (unsigned)(Rb * K + C) * 2u; }
    const size_t kstep = (size_t)(BK * 2);
    const size_t hstep = (size_t)HALF * K * 2;
    const size_t tstep = 2 * hstep;
    const unsigned ldsw = (unsigned)wid * 1024u;
    const int aoff = lds_byte(wr * 64 + fr, fq * 8), boff = lds_byte(wc * 32 + fr, fq * 8);
#define PG8_SA(b, h) (((b) * 2 + (h)) * HTB)
#define PG8_SB(b, h) ((4 + (b) * 2 + (h)) * HTB)
#define PG8_STAGE(bufoff, gbase, voff) do { _Pragma("unroll") for (int _i = 0; _i < 2; ++_i) \
        __builtin_amdgcn_global_load_lds((const unsigned*)((const char*)(gbase) + (voff)[_i]), (PG8_LAS unsigned*)(lds + (bufoff) + ldsw + _i * 8192), 16, 0, 0); } while (0)
#define PG8_LDA(dst, b, h) do { _Pragma("unroll") for (int m = 0; m < 4; ++m) _Pragma("unroll") for (int k = 0; k < 2; ++k) dst[m][k] = *(const PG8_LAS bf16x8*)(lds + PG8_SA(b, h) + aoff + m * 2048 + k * 1024); } while (0)
#define PG8_LDB(dst, b, h) do { _Pragma("unroll") for (int n = 0; n < 2; ++n) _Pragma("unroll") for (int k = 0; k < 2; ++k) dst[n][k] = *(const PG8_LAS bf16x8*)(lds + PG8_SB(b, h) + boff + n * 2048 + k * 1024); } while (0)
#define PG8_MMA(ai, bj, At, Bt) do { __builtin_amdgcn_s_setprio(1); _Pragma("unroll") for (int m = 0; m < 4; ++m) _Pragma("unroll") for (int n = 0; n < 2; ++n) _Pragma("unroll") for (int k = 0; k < 2; ++k) \
        acc[ai][bj][m][n] = __builtin_amdgcn_mfma_f32_16x16x32_bf16(Bt[n][k], At[m][k], acc[ai][bj][m][n], 0, 0, 0); __builtin_amdgcn_s_setprio(0); } while (0)
#define PG8_WAIT_V(n) asm volatile("s_waitcnt vmcnt(" #n ")" ::: "memory")
#define PG8_WAIT_L(n) asm volatile("s_waitcnt lgkmcnt(" #n ")" ::: "memory")
#define PG8_BAR __builtin_amdgcn_s_barrier()
#define PG8_SCHED __builtin_amdgcn_sched_barrier(0)
    Unit cur, nxt; int ui = 0;
    if (!S.next(0, cur)) return;
    f32x4 acc[2][2][4][2];
#pragma unroll
    for (int a = 0; a < 2; ++a)
#pragma unroll
        for (int b = 0; b < 2; ++b)
#pragma unroll
            for (int m = 0; m < 4; ++m)
#pragma unroll
                for (int n = 0; n < 2; ++n) acc[a][b][m][n] = (f32x4){0.f, 0.f, 0.f, 0.f};
    bf16x8 At[4][2], B0[2][2], B1[2][2];
    const char* cA = (const char*)g.A + (size_t)cur.pm * tstep; const char* cB = (const char*)g.Bt + (size_t)cur.pn * tstep;
    S.a_ready(cur);
    if constexpr (SP2) {
        PG8_STAGE(PG8_SB(0, 0), cB, voffB); PG8_STAGE(PG8_SB(0, 1), cB + hstep, voffB); PG8_STAGE(PG8_SA(0, 0), cA, voffA); PG8_STAGE(PG8_SA(0, 1), cA + hstep, voffA);
        if (wr == 1) PG8_BAR;
        PG8_WAIT_V(2); PG8_BAR;
        PG8_STAGE(PG8_SB(1, 0), cB + kstep, voffB); PG8_STAGE(PG8_SA(1, 0), cA + kstep, voffA); PG8_STAGE(PG8_SB(1, 1), cB + hstep + kstep, voffB);
        PG8_WAIT_V(6); PG8_BAR;
    } else {
        PG8_STAGE(PG8_SB(0, 0), cB, voffB); PG8_STAGE(PG8_SA(0, 0), cA, voffA); PG8_STAGE(PG8_SB(0, 1), cB + hstep, voffB); PG8_STAGE(PG8_SA(0, 1), cA + hstep, voffA);
        if (wr == 1) PG8_BAR;
        PG8_WAIT_V(4); PG8_BAR;
        PG8_STAGE(PG8_SB(1, 0), cB + kstep, voffB); PG8_STAGE(PG8_SA(1, 0), cA + kstep, voffA); PG8_STAGE(PG8_SB(1, 1), cB + hstep + kstep, voffB);
        PG8_WAIT_V(6); PG8_BAR;
    }
    for (;;) {
        const bool has_next = S.next(ui + 1, nxt);
        const char* nA = has_next ? (const char*)g.A + (size_t)nxt.pm * tstep : cA; const char* nB = has_next ? (const char*)g.Bt + (size_t)nxt.pn * tstep : cB;
        for (int t = 0; t < nt; t += 2) {
            const bool last = (t == nt - 2);
            const char* a1 = cA + (size_t)(t + 1) * kstep;
            const char* a2 = last ? nA : cA + (size_t)(t + 2) * kstep; const char* b2 = last ? nB : cB + (size_t)(t + 2) * kstep;
            const char* a3 = a2 + kstep; const char* b3 = b2 + kstep;
            if (last && has_next) S.a_ready(nxt);
            if constexpr (SP2) {
            PG8_LDB(B0, 0, 0); PG8_LDB(B1, 0, 1); PG8_SCHED; PG8_LDA(At, 0, 0); PG8_STAGE(PG8_SA(1, 1), a1 + hstep, voffA);
            PG8_WAIT_V(8); PG8_WAIT_L(0); PG8_BAR; PG8_MMA(0, 0, At, B0); PG8_MMA(0, 1, At, B1); PG8_BAR; PG8_SCHED;
            PG8_LDA(At, 0, 1); PG8_STAGE(PG8_SB(0, 0), b2, voffB); PG8_STAGE(PG8_SB(0, 1), b2 + hstep, voffB); PG8_STAGE(PG8_SA(0, 0), a2, voffA);
            PG8_WAIT_V(8); PG8_WAIT_L(0); PG8_BAR; PG8_MMA(1, 0, At, B0); PG8_MMA(1, 1, At, B1); PG8_BAR; PG8_SCHED;
            PG8_LDB(B0, 1, 0); PG8_LDB(B1, 1, 1); PG8_SCHED; PG8_LDA(At, 1, 0); PG8_STAGE(PG8_SA(0, 1), a2 + hstep, voffA);
            PG8_WAIT_V(8); PG8_WAIT_L(0); PG8_BAR; PG8_MMA(0, 0, At, B0); PG8_MMA(0, 1, At, B1); PG8_BAR; PG8_SCHED;
            PG8_LDA(At, 1, 1); PG8_STAGE(PG8_SB(1, 0), b3, voffB); PG8_STAGE(PG8_SB(1, 1), b3 + hstep, voffB); PG8_STAGE(PG8_SA(1, 0), a3, voffA);
            PG8_WAIT_V(8); PG8_WAIT_L(0); PG8_BAR; PG8_MMA(1, 0, At, B0); PG8_MMA(1, 1, At, B1); PG8_BAR; PG8_SCHED;
            } else {
            PG8_LDB(B0, 0, 0); PG8_SCHED; PG8_LDA(At, 0, 0); PG8_STAGE(PG8_SA(1, 1), a1 + hstep, voffA);
            PG8_WAIT_L(8); PG8_BAR; PG8_WAIT_L(0); PG8_MMA(0, 0, At, B0); PG8_BAR; PG8_SCHED;
            PG8_LDB(B1, 0, 1); PG8_STAGE(PG8_SB(0, 0), b2, voffB);
            PG8_BAR; PG8_WAIT_L(0); PG8_MMA(0, 1, At, B1); PG8_BAR;
            PG8_LDA(At, 0, 1); PG8_STAGE(PG8_SA(0, 0), a2, voffA);
            PG8_BAR; PG8_WAIT_L(0); PG8_MMA(1, 0, At, B0); PG8_BAR; PG8_SCHED;
            PG8_STAGE(PG8_SB(0, 1), b2 + hstep, voffB);
            PG8_WAIT_V(6); PG8_BAR; PG8_MMA(1, 1, At, B1); PG8_BAR;
            PG8_LDB(B0, 1, 0); PG8_SCHED; PG8_LDA(At, 1, 0); PG8_STAGE(PG8_SA(0, 1), a2 + hstep, voffA);
            PG8_WAIT_L(8); PG8_BAR; PG8_WAIT_L(0); PG8_MMA(0, 0, At, B0); PG8_BAR; PG8_SCHED;
            PG8_LDB(B1, 1, 1); PG8_STAGE(PG8_SB(1, 0), b3, voffB);
            PG8_BAR; PG8_WAIT_L(0); PG8_MMA(0, 1, At, B1); PG8_BAR;
            PG8_LDA(At, 1, 1); PG8_STAGE(PG8_SA(1, 0), a3, voffA);
            PG8_BAR; PG8_WAIT_L(0); PG8_MMA(1, 0, At, B0); PG8_BAR; PG8_SCHED;
            PG8_STAGE(PG8_SB(1, 1), b3 + hstep, voffB);
            PG8_WAIT_V(6); PG8_BAR; PG8_MMA(1, 1, At, B1); PG8_BAR;
            }
        }
        if constexpr (ALIGN_EPI) { if (wr == 0) PG8_BAR; }
        if constexpr (!Epi::AFTER_DRAIN) { if (cur.pass == S.rep - 1) E(acc, cur, wr, wc, fr, fq); S.done(cur); }
        if (!has_next) break;
#pragma unroll
        for (int a = 0; a < 2; ++a)
#pragma unroll
            for (int b = 0; b < 2; ++b)
#pragma unroll
                for (int m = 0; m < 4; ++m)
#pragma unroll
                    for (int n = 0; n < 2; ++n) acc[a][b][m][n] = (f32x4){0.f, 0.f, 0.f, 0.f};
        cur = nxt; cA = nA; cB = nB; ++ui;
        if constexpr (ALIGN_EPI) { if (wr == 1) PG8_BAR; }
    }
    PG8_WAIT_V(0);
    if constexpr (!ALIGN_EPI) { if (wr == 0) PG8_BAR; }
    PG8_BAR;
    if constexpr (Epi::AFTER_DRAIN) { E.fused(acc, cur, wr, wc, fr, fq, lds, wid, lane); S.done(cur); }
#undef PG8_SA
#undef PG8_SB
#undef PG8_STAGE
#undef PG8_LDA
#undef PG8_LDB
#undef PG8_MMA
#undef PG8_WAIT_V
#undef PG8_WAIT_L
#undef PG8_BAR
#undef PG8_SCHED
}
}

#define LAS __attribute__((address_space(3)))
typedef unsigned short bf16_t;
typedef short bf16x8 __attribute__((ext_vector_type(8)));
typedef float f32x4 __attribute__((ext_vector_type(4)));
typedef float f32x16 __attribute__((ext_vector_type(16)));
typedef unsigned u32x4 __attribute__((ext_vector_type(4)));
typedef unsigned u32x2 __attribute__((ext_vector_type(2)));
using pg8::cvt_pk_bf16;

constexpr int NWAVES = 8, NTHR = 512;
constexpr int DM = 1024, DFF = 2816, SEQ = 4096, NB = 16, NBS = 32, DSEQ = 64;
constexpr int MP = NB * SEQ, MS = NBS * DSEQ, MT = MP + MS;
constexpr int NBLK64 = MT / 64;
constexpr float EPS = 1e-6f, LOG2E = 1.4426950408889634f;
constexpr int LDS_BYTES = 147456;

constexpr size_t OUT_Y = 0;
constexpr size_t OUT_MK = (size_t)MT * DM;
constexpr size_t OUT_MV = OUT_MK + (size_t)4 * 16 * 256 * 512;
constexpr size_t OUT_BK = OUT_MV + (size_t)4 * 16 * 256 * 512;
constexpr size_t OUT_BV = OUT_BK + (size_t)16 * 512 * 512;
constexpr size_t OUT_CP = OUT_BV + (size_t)16 * 512 * 512;
constexpr size_t OUT_AV = OUT_CP + (size_t)4 * 16 * 2 * DFF;
constexpr size_t OUT_SK = OUT_AV + (size_t)2 * 32 * 64 * 512;
constexpr size_t OUT_SV = OUT_SK + (size_t)32 * 64 * 512;
constexpr size_t OUT_CS = OUT_SV + (size_t)32 * 64 * 512;
constexpr size_t OUT_END = OUT_CS + (size_t)4 * 32 * 2 * DFF;

constexpr size_t al256(size_t x) { return (x + 255) & ~(size_t)255; }
constexpr size_t WS_BAR = 0, BAR_BYTES = 16384;
constexpr size_t WS_SSQ = BAR_BYTES;
constexpr size_t WS_RMEM = al256(WS_SSQ + (size_t)11 * MT * 8);
constexpr size_t WS_WINA = al256(WS_RMEM + 4096 * 4);
constexpr size_t WS_WB = WS_WINA + (size_t)2 * 1536 * 1024 * 2;
constexpr size_t WS_WMEM = WS_WB + (size_t)3072 * 1024 * 2;
constexpr size_t WS_WOUT = WS_WMEM + (size_t)4096 * 1024 * 2;
constexpr size_t WS_WUP = WS_WOUT + (size_t)4096 * 1024 * 2;
constexpr size_t WS_WDOWN = WS_WUP + (size_t)4 * 5632 * 1024 * 2;
constexpr size_t WS_WSB = WS_WDOWN + (size_t)4 * 1024 * 2816 * 2;
constexpr size_t WS_MPB = WS_WSB + (size_t)2 * 8 * 128 * 128 * 2;
constexpr size_t WS_HB = WS_MPB + (size_t)4096 * 1024 * 2;
constexpr size_t WS_MEMK = WS_HB + (size_t)MT * 1024 * 2;
constexpr size_t WS_MEMVT = WS_MEMK + (size_t)4 * 48 * 256 * 512 * 2;
constexpr size_t WS_PK = WS_MEMVT + (size_t)4 * 48 * 256 * 512 * 2;
constexpr size_t WS_PVT = WS_PK + (size_t)MP * 512 * 2;
constexpr size_t WS_SK = WS_PVT + (size_t)MP * 512 * 2;
constexpr size_t WS_SVT = WS_SK + (size_t)32 * 576 * 512 * 2;
constexpr size_t WS_TAIL = WS_SVT + (size_t)32 * 576 * 512 * 2;
constexpr size_t WS_HEAD = WS_TAIL + (size_t)NBLK64 * 2 * DFF * 4;
constexpr size_t WS_OVL = WS_HEAD + (size_t)NBLK64 * 4 * DFF * 4;
constexpr size_t WS_ACT = WS_OVL;
constexpr size_t WS_U = WS_OVL;
constexpr size_t WS_VT = WS_U + (size_t)MT * 512 * 2;
constexpr size_t WS_QM = WS_VT + (size_t)MT * 512 * 2;
constexpr size_t WS_CAT = WS_QM + (size_t)MT * 512 * 2;
constexpr size_t WS_END = WS_OVL + (size_t)MT * DFF * 2;
static_assert(WS_CAT + (size_t)MT * 1024 * 2 <= WS_END, "overlay");
static_assert(WS_END <= (size_t)1073741824, "workspace budget");

__device__ __forceinline__ float bf2f(unsigned short b) { return __builtin_bit_cast(float, (unsigned)b << 16); }
__device__ __forceinline__ unsigned short f2bf(float f) { unsigned u = __builtin_bit_cast(unsigned, f); return (unsigned short)((u + 0x7fffu + ((u >> 16) & 1u)) >> 16); }
__device__ __forceinline__ float gelu_t(float x) {
    const float t = x * (1.0f + 0.044715f * x * x);
    const float e = __builtin_amdgcn_exp2f(-2.302208198f * t);
    return x * __builtin_amdgcn_rcpf(1.0f + e);
}
typedef unsigned long long ssq_t;
__device__ __forceinline__ float rs_from(float ssq, float invn) { return rsqrtf(ssq * invn + EPS); }
__device__ __forceinline__ float rs_fromu(ssq_t v, float invn) { return rsqrtf((float)v * (invn * (1.0f / 1048576.0f)) + EPS); }
__device__ __forceinline__ ssq_t to_fix(float ss) { return (ssq_t)(ss * 1048576.0f); }
__device__ __forceinline__ u32x4 pack8(const f32x4& a, const f32x4& b) { u32x4 w; w.x = cvt_pk_bf16(a[0], a[1]); w.y = cvt_pk_bf16(a[2], a[3]); w.z = cvt_pk_bf16(b[0], b[1]); w.w = cvt_pk_bf16(b[2], b[3]); return w; }
__device__ __forceinline__ float wave_sum(float v) {
#pragma unroll
    for (int o = 1; o < 64; o <<= 1) v += __shfl_xor(v, o);
    return v;
}
#define MFMA32(a, b, c) __builtin_amdgcn_mfma_f32_32x32x16_bf16((a), (b), (c), 0, 0, 0)
__device__ __forceinline__ int crow(int r, int hi) { return (r & 3) + 8 * (r >> 2) + 4 * hi; }

typedef f32x4 AccT[2][2][4][2];

struct EpiInA {
    static constexpr bool PERM = true, AFTER_DRAIN = false;
    const ssq_t* ssq; bf16_t* U; bf16_t* VT; bf16_t* QM; ssq_t* ssqv; float qscale;
    __device__ __forceinline__ void operator()(const AccT& acc, const pg8::Unit& u, int wr, int wc, int fr, int fq) const {
        const int row0 = u.pm * 256 + wr * 64 + fr; const int ty = u.pn >> 1; const int cb = (u.pn & 1) * 256 + wc * 32 + 8 * fq;
#pragma unroll
        for (int ai = 0; ai < 2; ++ai)
#pragma unroll
            for (int m = 0; m < 4; ++m) {
                const int row = row0 + ai * 128 + m * 16; const float r = rs_fromu(ssq[row], 1.0f / 1024.0f);
                if (ty == 0) {
#pragma unroll
                    for (int bj = 0; bj < 2; ++bj) { f32x4 a = acc[ai][bj][m][0] * r, b = acc[ai][bj][m][1] * r;
#pragma unroll
                        for (int e = 0; e < 4; ++e) { a[e] = gelu_t(a[e]); b[e] = gelu_t(b[e]); }
                        *(u32x4*)(U + (size_t)row * 512 + cb + bj * 128) = pack8(a, b); }
                } else if (ty == 2) {
                    const float s = r * qscale;
#pragma unroll
                    for (int bj = 0; bj < 2; ++bj) { f32x4 a = acc[ai][bj][m][0] * s, b = acc[ai][bj][m][1] * s;
                        *(u32x4*)(QM + (size_t)row * 512 + cb + bj * 128) = pack8(a, b); }
                } else {
                    float ss = 0.f; bf16_t* vt = VT + (size_t)(row >> 7) * 512 * 128 + (row & 127);
#pragma unroll
                    for (int bj = 0; bj < 2; ++bj)
#pragma unroll
                        for (int n = 0; n < 2; ++n)
#pragma unroll
                            for (int e = 0; e < 4; ++e) { const unsigned short hb = f2bf(gelu_t(acc[ai][bj][m][n][e] * r)); const float vr = bf2f(hb); ss += vr * vr;
                                vt[(size_t)(cb + bj * 128 + 4 * n + e) * 128] = hb; }
                    ss += __shfl_xor(ss, 16); ss += __shfl_xor(ss, 32);
                    if (fq == 0) atomicAdd(ssqv + row, to_fix(ss));
                }
            }
    }
};

struct EpiInB {
    static constexpr bool PERM = true, AFTER_DRAIN = false;
    const ssq_t* ssq; bf16_t* Q; bf16_t* QM; bf16_t* PK; bf16_t* PVT; bf16_t* SK; bf16_t* SVT; float* out; float qscale, mscale;
    __device__ __forceinline__ void operator()(const AccT& acc, const pg8::Unit& u, int wr, int wc, int fr, int fq) const {
        const int row0 = u.pm * 256 + wr * 64 + fr; const int ty = u.pn >> 1; const int cb = (u.pn & 1) * 256 + wc * 32 + 8 * fq;
        const bool samp = u.pm >= 256;
#pragma unroll
        for (int ai = 0; ai < 2; ++ai)
#pragma unroll
            for (int m = 0; m < 4; ++m) {
                const int row = row0 + ai * 128 + m * 16; const float r = rs_fromu(ssq[row], 1.0f / 1024.0f);
                if (ty < 2) {
                    const float s = r * (ty == 0 ? qscale : mscale); bf16_t* dst = (ty == 0 ? Q : QM) + (size_t)row * 512 + cb;
#pragma unroll
                    for (int bj = 0; bj < 2; ++bj) { f32x4 a = acc[ai][bj][m][0] * s, b = acc[ai][bj][m][1] * s; *(u32x4*)(dst + bj * 128) = pack8(a, b); }
                } else if (ty == 2) {
                    bf16_t* dst; float* fo = nullptr;
                    if (!samp) { dst = PK + (size_t)row * 512 + cb; const int t = row & 4095; if (t >= 3584) fo = out + OUT_BK + ((size_t)(row >> 12) * 512 + (t - 3584)) * 512 + cb; }
                    else { const int rs = row - MP, bs = rs >> 6, t = rs & 63; dst = SK + ((size_t)bs * 576 + 512 + t) * 512 + cb; fo = out + OUT_SK + (size_t)rs * 512 + cb; }
#pragma unroll
                    for (int bj = 0; bj < 2; ++bj) { f32x4 a = acc[ai][bj][m][0] * r, b = acc[ai][bj][m][1] * r; *(u32x4*)(dst + bj * 128) = pack8(a, b);
                        if (fo) { *(f32x4*)(fo + bj * 128) = a; *(f32x4*)(fo + bj * 128 + 4) = b; } }
                } else {
                    bf16_t* dst; size_t cst; float* fo = nullptr;
                    if (!samp) { const int b = row >> 12, t = row & 4095; dst = PVT + (size_t)b * 512 * 4096 + t; cst = 4096; if (t >= 3584) fo = out + OUT_BV + ((size_t)b * 512 + (t - 3584)) * 512 + cb; }
                    else { const int rs = row - MP, bs = rs >> 6, t = rs & 63; dst = SVT + (size_t)bs * 512 * 576 + 512 + t; cst = 576; fo = out + OUT_SV + (size_t)rs * 512 + cb; }
#pragma unroll
                    for (int bj = 0; bj < 2; ++bj) { f32x4 a = acc[ai][bj][m][0] * r, b = acc[ai][bj][m][1] * r;
#pragma unroll
                        for (int e = 0; e < 4; ++e) { dst[(size_t)(cb + bj * 128 + e) * cst] = f2bf(a[e]); dst[(size_t)(cb + bj * 128 + 4 + e) * cst] = f2bf(b[e]); }
                        if (fo) { *(f32x4*)(fo + bj * 128) = a; *(f32x4*)(fo + bj * 128 + 4) = b; } }
                }
            }
    }
};

struct EpiRes {
    static constexpr bool PERM = true, AFTER_DRAIN = false;
    bf16_t* hb; ssq_t* ssq_next;
    __device__ __forceinline__ void operator()(const AccT& acc, const pg8::Unit& u, int wr, int wc, int fr, int fq) const {
        const int row0 = u.pm * 256 + wr * 64 + fr; const int cb = u.pn * 256 + wc * 32 + 8 * fq;
#pragma unroll
        for (int ai = 0; ai < 2; ++ai)
#pragma unroll
            for (int m = 0; m < 4; ++m) {
                const int row = row0 + ai * 128 + m * 16; float ss = 0.f;
#pragma unroll
                for (int bj = 0; bj < 2; ++bj) { bf16_t* p = hb + (size_t)row * 1024 + cb + bj * 128; const u32x4 rw = *(const u32x4*)p;
                    f32x4 a, b;
                    a[0] = __builtin_bit_cast(float, rw.x << 16); a[1] = __builtin_bit_cast(float, rw.x & 0xffff0000u); a[2] = __builtin_bit_cast(float, rw.y << 16); a[3] = __builtin_bit_cast(float, rw.y & 0xffff0000u);
                    b[0] = __builtin_bit_cast(float, rw.z << 16); b[1] = __builtin_bit_cast(float, rw.z & 0xffff0000u); b[2] = __builtin_bit_cast(float, rw.w << 16); b[3] = __builtin_bit_cast(float, rw.w & 0xffff0000u);
                    a = a + acc[ai][bj][m][0]; b = b + acc[ai][bj][m][1];
                    *(u32x4*)p = pack8(a, b);
                    ss += (a[0] * a[0] + a[1] * a[1]) + (a[2] * a[2] + a[3] * a[3]) + (b[0] * b[0] + b[1] * b[1]) + (b[2] * b[2] + b[3] * b[3]); }
                ss += __shfl_xor(ss, 16); ss += __shfl_xor(ss, 32);
                if (fq == 0) atomicAdd(ssq_next + row, to_fix(ss));
            }
    }
};

struct EpiUp {
    static constexpr bool PERM = true, AFTER_DRAIN = false;
    const ssq_t* ssq; const float* cw; const float* cbias; bf16_t* ACT; float* tail; float* head;
    __device__ __forceinline__ void operator()(const AccT& acc, const pg8::Unit& u, int wr, int wc, int fr, int fq) const {
        const int f0 = u.pn * 128 + wc * 32 + 8 * fq; const int lane = fq * 16 + fr;
        const int s1 = (lane & 48) | ((fr - 1) & 15), s2 = (lane & 48) | ((fr - 2) & 15);
        f32x4 w0[2], w1[2], w2[2], bb[2];
#pragma unroll
        for (int n = 0; n < 2; ++n) { w0[n] = *(const f32x4*)(cw + f0 + 4 * n); w1[n] = *(const f32x4*)(cw + DFF + f0 + 4 * n); w2[n] = *(const f32x4*)(cw + 2 * DFF + f0 + 4 * n); bb[n] = *(const f32x4*)(cbias + f0 + 4 * n); }
#pragma unroll
        for (int ai = 0; ai < 2; ++ai) {
            const int blk = u.pm * 4 + ai * 2 + wr; const int rowb = blk * 64;
            f32x4 p1[2], p2[2];
#pragma unroll
            for (int n = 0; n < 2; ++n) { p1[n] = (f32x4){0.f, 0.f, 0.f, 0.f}; p2[n] = p1[n]; }
#pragma unroll
            for (int m = 0; m < 4; ++m) {
                const int row = rowb + 16 * m + fr; const float r = rs_fromu(ssq[row], 1.0f / 1024.0f);
                f32x4 a[2], g[2], o[2], pp[2];
#pragma unroll
                for (int n = 0; n < 2; ++n) { a[n] = acc[ai][0][m][n] * r; g[n] = acc[ai][1][m][n] * r;
                    f32x4 c1, c2;
#pragma unroll
                    for (int e = 0; e < 4; ++e) { c1[e] = __shfl(a[n][e], s1); c2[e] = __shfl(a[n][e], s2); }
                    f32x4 a1, a2;
#pragma unroll
                    for (int e = 0; e < 4; ++e) { a1[e] = fr >= 1 ? c1[e] : p1[n][e]; a2[e] = fr >= 2 ? c2[e] : p2[n][e]; }
                    p1[n] = c1; p2[n] = c2;
                    if (m == 0) {
#pragma unroll
                        for (int e = 0; e < 4; ++e) { if (fr == 0) { a1[e] = 0.f; a2[e] = 0.f; } else if (fr == 1) a2[e] = 0.f; }
                    }
                    pp[n] = bb[n] + w0[n] * a2 + w1[n] * a1 + w2[n] * a[n];
#pragma unroll
                    for (int e = 0; e < 4; ++e) o[n][e] = gelu_t(pp[n][e]) * g[n][e];
                }
                if (m == 0 && fr < 2) {
                    float* hp = head + ((size_t)(blk * 2 + fr) * 2) * DFF + f0;
                    *(f32x4*)(hp) = pp[0]; *(f32x4*)(hp + 4) = pp[1]; *(f32x4*)(hp + DFF) = g[0]; *(f32x4*)(hp + DFF + 4) = g[1];
                } else {
                    *(u32x4*)(ACT + (size_t)row * DFF + f0) = pack8(o[0], o[1]);
                }
                if (m == 3 && fr >= 14) { float* tp = tail + (size_t)(blk * 2 + (fr - 14)) * DFF + f0; *(f32x4*)(tp) = a[0]; *(f32x4*)(tp + 4) = a[1]; }
            }
        }
    }
};

struct EpiMem {
    static constexpr bool PERM = true, AFTER_DRAIN = false;
    const float* rmem; float* out; bf16_t* MEMK; bf16_t* MEMVT;
    __device__ __forceinline__ void operator()(const AccT& acc, const pg8::Unit& u, int wr, int wc, int fr, int fq) const {
        const int row0 = u.pm * 256 + wr * 64 + fr; const int l = u.pn >> 2, kv = (u.pn >> 1) & 1; const int cb = (u.pn & 1) * 256 + wc * 32 + 8 * fq;
#pragma unroll
        for (int ai = 0; ai < 2; ++ai)
#pragma unroll
            for (int m = 0; m < 4; ++m) {
                const int row = row0 + ai * 128 + m * 16; const float r = rmem[row]; const int b = row >> 8, n = row & 255;
                float* fo = out + (kv ? OUT_MV : OUT_MK) + ((size_t)l * 4096 + row) * 512 + cb;
#pragma unroll
                for (int bj = 0; bj < 2; ++bj) { f32x4 x = acc[ai][bj][m][0] * r, y = acc[ai][bj][m][1] * r;
                    *(f32x4*)(fo + bj * 128) = x; *(f32x4*)(fo + bj * 128 + 4) = y;
                    if (!kv) *(u32x4*)(MEMK + (((size_t)l * 48 + b) * 256 + n) * 512 + cb + bj * 128) = pack8(x, y);
                    else { bf16_t* d = MEMVT + (((size_t)l * 48 + b) * 512 + cb + bj * 128) * 256 + n;
#pragma unroll
                        for (int e = 0; e < 4; ++e) { d[(size_t)e * 256] = f2bf(x[e]); d[(size_t)(4 + e) * 256] = f2bf(y[e]); } } }
            }
    }
};

__device__ __forceinline__ void tr_item(const float* src, int lsrc, int k0, int n0, const float* g, bf16_t* dst, int ldd, LAS float* scr, int lane) {
#pragma unroll 8
    for (int i = 0; i < 32; ++i) { const int kk = 2 * i + (lane >> 5); float v = src[(size_t)(k0 + kk) * lsrc + n0 + (lane & 31)]; if (g) v *= g[k0 + kk]; scr[kk * 33 + (lane & 31)] = v; }
    asm volatile("s_waitcnt lgkmcnt(0)" ::: "memory");
    const int c = lane & 7;
#pragma unroll
    for (int j = 0; j < 4; ++j) { const int n = (lane >> 3) + 8 * j; const LAS float* s = scr + (8 * c) * 33 + n;
        u32x4 o; o.x = cvt_pk_bf16(s[0 * 33], s[1 * 33]); o.y = cvt_pk_bf16(s[2 * 33], s[3 * 33]); o.z = cvt_pk_bf16(s[4 * 33], s[5 * 33]); o.w = cvt_pk_bf16(s[6 * 33], s[7 * 33]);
        *(u32x4*)(dst + (size_t)n * ldd + k0 + 8 * c) = o; }
    asm volatile("s_waitcnt lgkmcnt(0)" ::: "memory");
}
__device__ __forceinline__ void tr_plain(const float* src, int K, int N, const float* g, bf16_t* dst, int ldd, int item, LAS float* scr, int lane) {
    const int nblk = N / 32, kb = item / nblk, nb = item % nblk;
    tr_item(src, N, kb * 64, nb * 32, g, dst + (size_t)(nb * 32) * ldd, ldd, scr, lane);
}

struct Args { const float* in[26]; float* out; unsigned char* ws; int ph_lo, ph_hi, coop, pad; };
typedef __attribute__((address_space(4))) const Args* KArgs;

__device__ __forceinline__ void p0_prologue(KArgs a, LAS unsigned char* lds, int tid) {
    const int lane = tid & 63, wave = tid >> 6; const int G = gridDim.x;
    LAS float* scr = (LAS float*)(lds + wave * 8704);
    unsigned char* ws = a->ws;
    const int gw = blockIdx.x * NWAVES + wave, NGW = G * NWAVES;
    constexpr int I_INA = 16 * 48, I_SQ = 16 * 32, I_UP = 16 * 176, I_DN = 44 * 32, I_MV = 4 * 16, I_BV = 8 * 16;
    constexpr int N_INA = 2 * I_INA, N_B = 3 * I_SQ, N_MEM = 4 * I_SQ, N_OUT = 4 * I_SQ, N_UP = 4 * I_UP, N_DN = 4 * I_DN, N_MV = 128 * I_MV, N_BV = 32 * I_BV;
    constexpr int NITEMS = N_INA + N_B + N_MEM + N_OUT + N_UP + N_DN + N_MV + N_BV;
    for (int it = gw; it < NITEMS; it += NGW) {
        int r = it;
        if (r < N_INA) { const int l = r / I_INA; r %= I_INA; tr_plain(a->in[9] + (size_t)l * 1024 * 1536, 1024, 1536, a->in[8] + l * 1024, (bf16_t*)(ws + WS_WINA) + (size_t)l * 1536 * 1024, 1024, r, scr, lane); continue; } r -= N_INA;
        if (r < N_B) { const int s = r / I_SQ; r %= I_SQ;
            const float* src = s == 1 ? a->in[14] : a->in[15] + (size_t)(s >> 1) * 1024 * 1024; const float* g = s == 1 ? a->in[13] : a->in[8] + (2 + (s >> 1)) * 1024;
            tr_plain(src, 1024, 1024, g, (bf16_t*)(ws + WS_WB) + (size_t)s * 1024 * 1024, 1024, r, scr, lane); continue; } r -= N_B;
        if (r < N_MEM) { const int l = r / I_SQ; r %= I_SQ; tr_plain(a->in[18] + (size_t)l * 1024 * 1024, 1024, 1024, a->in[17] + l * 1024, (bf16_t*)(ws + WS_WMEM) + (size_t)l * 1024 * 1024, 1024, r, scr, lane); continue; } r -= N_MEM;
        if (r < N_OUT) { const int l = r / I_SQ; r %= I_SQ; tr_plain(a->in[19] + (size_t)l * 1024 * 1024, 1024, 1024, nullptr, (bf16_t*)(ws + WS_WOUT) + (size_t)l * 1024 * 1024, 1024, r, scr, lane); continue; } r -= N_OUT;
        if (r < N_UP) { const int l = r / I_UP; r %= I_UP; const int kb = r / 176, nb = r % 176; const int s0 = nb * 32; const int bj = s0 / DFF, f = s0 % DFF; const int drow = (f >> 7) * 256 + bj * 128 + (f & 127);
            tr_item(a->in[21] + (size_t)l * 1024 * 5632, 5632, kb * 64, s0, a->in[20] + l * 1024, (bf16_t*)(ws + WS_WUP) + ((size_t)l * 5632 + drow) * 1024, 1024, scr, lane); continue; } r -= N_UP;
        if (r < N_DN) { const int l = r / I_DN; r %= I_DN; tr_plain(a->in[24] + (size_t)l * DFF * 1024, DFF, 1024, nullptr, (bf16_t*)(ws + WS_WDOWN) + (size_t)l * 1024 * DFF, DFF, r, scr, lane); continue; } r -= N_DN;
        if (r < N_MV) { const int mi = r / I_MV; r %= I_MV; const int l = mi >> 5, bs = mi & 31;
            tr_plain(a->in[4] + (size_t)mi * 256 * 512, 256, 512, nullptr, (bf16_t*)(ws + WS_MEMVT) + ((size_t)l * 48 + 16 + bs) * 512 * 256, 256, r, scr, lane); continue; } r -= N_MV;
        { const int bs = r / I_BV; r %= I_BV; tr_plain(a->in[6] + (size_t)bs * 512 * 512, 512, 512, nullptr, (bf16_t*)(ws + WS_SVT) + (size_t)bs * 512 * 576, 576, r, scr, lane); }
    }
    for (int m = gw; m < MT + 4096; m += NGW) {
        const bool ismem = m >= MT; const int rr = ismem ? m - MT : m;
        const float* xr = ismem ? a->in[2] + (size_t)rr * 1024 : (rr < MP ? a->in[0] + (size_t)rr * 1024 : a->in[1] + (size_t)(rr - MP) * 1024);
        bf16_t* orow = (bf16_t*)(ws + (ismem ? WS_MPB : WS_HB)) + (size_t)rr * 1024;
        f32x4 v[4]; float s = 0.f;
#pragma unroll
        for (int j = 0; j < 4; ++j) { v[j] = *((const f32x4*)xr + lane + 64 * j); s += (v[j][0] * v[j][0] + v[j][1] * v[j][1]) + (v[j][2] * v[j][2] + v[j][3] * v[j][3]); }
        s = wave_sum(s);
#pragma unroll
        for (int j = 0; j < 4; ++j) { u32x2 o; o.x = cvt_pk_bf16(v[j][0], v[j][1]); o.y = cvt_pk_bf16(v[j][2], v[j][3]); *((u32x2*)orow + lane + 64 * j) = o; }
        if (lane == 0) { if (ismem) ((float*)(ws + WS_RMEM))[rr] = rs_from(s, 1.0f / 1024.0f); else ((ssq_t*)(ws + WS_SSQ))[rr] = to_fix(s); }
    }
    const size_t gt = (size_t)blockIdx.x * NTHR + tid, NT = (size_t)G * NTHR;
    { ssq_t* z = (ssq_t*)(ws + WS_SSQ) + MT; for (size_t i = gt; i < (size_t)10 * MT; i += NT) z[i] = 0ull; }
    { bf16_t* wsb = (bf16_t*)(ws + WS_WSB); const float* w = a->in[11];
      for (size_t i = gt; i < (size_t)2 * 8 * 128 * 128; i += NT) { const int jj = (int)(i & 127), ii = (int)((i >> 7) & 127); wsb[i] = jj <= ii ? f2bf(w[i]) : (unsigned short)0; } }
    {
      const f32x4* src = (const f32x4*)a->in[3]; bf16_t* dst = (bf16_t*)(ws + WS_MEMK);
      for (size_t i = gt; i < (size_t)4 * 32 * 256 * 512 / 4; i += NT) { const size_t e = i * 4; const size_t mi = e / (256 * 512), rem = e % (256 * 512); const size_t l = mi >> 5, bs = mi & 31;
          const f32x4 v = src[i]; u32x2 o; o.x = cvt_pk_bf16(v[0], v[1]); o.y = cvt_pk_bf16(v[2], v[3]); *(u32x2*)(dst + ((l * 48 + 16 + bs) * 256 * 512) + rem) = o; } }
    {
      const f32x4* src = (const f32x4*)a->in[5]; bf16_t* dst = (bf16_t*)(ws + WS_SK);
      for (size_t i = gt; i < (size_t)32 * 512 * 512 / 4; i += NT) { const size_t e = i * 4; const size_t bs = e / (512 * 512), rem = e % (512 * 512);
          const f32x4 v = src[i]; u32x2 o; o.x = cvt_pk_bf16(v[0], v[1]); o.y = cvt_pk_bf16(v[2], v[3]); *(u32x2*)(dst + bs * 576 * 512 + rem) = o; } }
}

#ifndef REP_MEM
#define REP_MEM 1
#endif
#ifndef REP_GATE
#define REP_GATE 1
#endif
#ifndef REP_BAND
#define REP_BAND 1
#endif
__device__ __forceinline__ void gate_unit(LAS unsigned char* lds, int tid, int chunk, int joff, int nib, int row0,
                                          const bf16_t* wsb, const bf16_t* VT, const bf16_t* U, const ssq_t* ssqv, const float* gv, const float* bs, bf16_t* CAT, float* av_out) {
    const int g = tid >> 6, lane = tid & 63, l32 = lane & 31, half = lane >> 5;
    LAS float* rv = (LAS float*)lds;
    __syncthreads();
    if (tid < nib * 32) rv[tid] = rs_fromu(ssqv[row0 + tid], 1.0f / 512.0f);
    __syncthreads();
    const bf16_t* vt_g = VT + ((size_t)chunk * 512 + g * 64) * 128 + joff;
    const bf16_t* w_g = wsb + (size_t)g * 128 * 128;
#pragma unroll 1
    for (int db = 0; db < 2; ++db) {
        f32x16 acc[4];
#pragma unroll
        for (int i = 0; i < 4; ++i)
#pragma unroll
            for (int e = 0; e < 16; ++e) acc[i][e] = 0.f;
        const bf16_t* vt_d = vt_g + (size_t)(db * 32 + l32) * 128 + half * 8;
        const bf16_t* w_d = w_g + (size_t)l32 * 128 + half * 8;
#pragma unroll
        for (int ks = 0; ks < 8; ++ks) {
            if (ks < nib * 2) {
                const int j0 = ks * 16 + half * 8;
                const u32x4 raw = *(const u32x4*)(vt_d + ks * 16);
                u32x4 sc;
#pragma unroll
                for (int q = 0; q < 4; ++q) { const float lo = __builtin_bit_cast(float, raw[q] << 16) * rv[j0 + 2 * q], hi = __builtin_bit_cast(float, raw[q] & 0xffff0000u) * rv[j0 + 2 * q + 1]; sc[q] = cvt_pk_bf16(lo, hi); }
                const bf16x8 bfr = __builtin_bit_cast(bf16x8, sc);
#pragma unroll
                for (int ib = 0; ib < 4; ++ib) {
                    if (ib < nib && ks < (ib + 1) * 2) {
                        const bf16x8 af = *(const bf16x8*)(w_d + ib * 32 * 128 + ks * 16);
                        acc[ib] = MFMA32(af, bfr, acc[ib]);
                    }
                }
            }
        }
        const int c = g * 64 + db * 32 + l32; const float gvc = gv[c];
        const bf16_t* ub = U + ((size_t)row0 + 4 * half) * 512 + c; bf16_t* cbp = CAT + ((size_t)row0 + 4 * half) * 1024 + c; const float* bsp = bs + g * 128 + 4 * half;
#pragma unroll
        for (int ib = 0; ib < 4; ++ib) {
            if (ib < nib) {
#pragma unroll
                for (int e = 0; e < 16; ++e) { const int i = ib * 32 + (e & 3) + 8 * (e >> 2);
                    const float s = acc[ib][e] * gvc + bsp[i];
                    cbp[(size_t)i * 1024] = f2bf(bf2f(ub[(size_t)i * 512]) * s); }
            }
        }
    }
    if (av_out) {
        for (int e = tid; e < 64 * 512; e += NTHR) { const int t = e >> 9, c = e & 511; av_out[e] = bf2f(VT[((size_t)chunk * 512 + c) * 128 + joff + t]) * rv[t] * gv[c]; }
    }
}

template <int D, bool BAND>
__device__ __forceinline__ void attn_unit(LAS unsigned char* lds, int tid, const bf16_t* Qw, bool hasq, const bf16_t* Kb, int ldk, const bf16_t* Vtb, int ldv,
                                          int jstart, int nkb, int jlo, int jhi, bf16_t* Ow, LAS const float* btab, int relq) {
    constexpr int KROW = (D + 8) * 2, VROW = 144, KBYTES = 64 * KROW, VBYTES = D * VROW, BUF = KBYTES + VBYTES, STAGE = 2 * BUF, NR = D / 64, KK = D / 16, DB = D / 32;
    const int lane = tid & 63, l32 = lane & 31, half = lane >> 5;
    bf16x8 qf[KK];
#pragma unroll
    for (int kk = 0; kk < KK; ++kk) qf[kk] = hasq ? *(const bf16x8*)(Qw + (size_t)l32 * 512 + kk * 16 + half * 8) : (bf16x8){0, 0, 0, 0, 0, 0, 0, 0};
    f32x16 O[DB];
#pragma unroll
    for (int d = 0; d < DB; ++d)
#pragma unroll
        for (int e = 0; e < 16; ++e) O[d][e] = 0.f;
    float mrun = -1e30f, lsum = 0.f;
    u32x4 kreg[2][NR], vreg[2][NR];
#define ATT_GLOAD(st) do { _Pragma("unroll") for (int bk = 0; bk < 2; ++bk) { const int j_ = 2 * (st) + bk; _Pragma("unroll") for (int i = 0; i < NR; ++i) { const int id = tid + i * NTHR; const int kr = id / (D / 8), kc = id % (D / 8); \
        kreg[bk][i] = *(const u32x4*)(Kb + (long)(j_ * 64 + kr) * ldk + kc * 8); const int vr = id >> 3, vc = id & 7; vreg[bk][i] = *(const u32x4*)(Vtb + (long)vr * ldv + j_ * 64 + vc * 8); } } } while (0)
#define ATT_LSTORE(buf) do { _Pragma("unroll") for (int bk = 0; bk < 2; ++bk) { LAS unsigned char* b_ = lds + (buf) * STAGE + bk * BUF; _Pragma("unroll") for (int i = 0; i < NR; ++i) { const int id = tid + i * NTHR; const int kr = id / (D / 8), kc = id % (D / 8); \
        *(LAS u32x4*)(b_ + kr * KROW + kc * 16) = kreg[bk][i]; const int vr = id >> 3, vc = id & 7; *(LAS u32x4*)(b_ + KBYTES + vr * VROW + vc * 16) = vreg[bk][i]; } } } while (0)
    const int st0 = jstart >> 1, nst = (nkb + 1) >> 1;
    __syncthreads();
    ATT_GLOAD(st0); ATT_LSTORE(0);
    __syncthreads();
    for (int st = st0; st < nst; ++st) {
        const int cur = (st - st0) & 1;
        if (st + 1 < nst) ATT_GLOAD(st + 1);
#pragma unroll
        for (int bk = 0; bk < 2; ++bk) {
            const int j = 2 * st + bk;
            if (hasq && j >= jlo && j <= jhi) {
                const LAS unsigned char* b = lds + cur * STAGE + bk * BUF;
                f32x16 S[2];
#pragma unroll
                for (int s = 0; s < 2; ++s) {
#pragma unroll
                    for (int e = 0; e < 16; ++e) S[s][e] = 0.f;
#pragma unroll
                    for (int kk = 0; kk < KK; ++kk) { const bf16x8 af = *(const LAS bf16x8*)(b + (s * 32 + l32) * KROW + (kk * 16 + half * 8) * 2); S[s] = MFMA32(af, qf[kk], S[s]); }
                }
                if (BAND) {
                    if (j <= jlo + 3) {
                        const float cbias = btab[319];
#pragma unroll
                        for (int s = 0; s < 2; ++s)
#pragma unroll
                            for (int e = 0; e < 16; ++e) S[s][e] += cbias;
                    } else {
#pragma unroll
                        for (int s = 0; s < 2; ++s)
#pragma unroll
                            for (int e = 0; e < 16; ++e) { const int kidx = j * 64 + s * 32 + crow(e, half); int rel = relq - kidx; rel = rel > 256 ? 256 : rel; S[s][e] += btab[rel + 63]; }
                    }
                }
                float mx = S[0][0];
#pragma unroll
                for (int e = 1; e < 16; ++e) mx = fmaxf(mx, S[0][e]);
#pragma unroll
                for (int e = 0; e < 16; ++e) mx = fmaxf(mx, S[1][e]);
                mx = fmaxf(mx, __shfl_xor(mx, 32));
                const float mnew = fmaxf(mrun, mx); const float alpha = __builtin_amdgcn_exp2f(mrun - mnew); mrun = mnew;
                float ps = 0.f;
#pragma unroll
                for (int s = 0; s < 2; ++s)
#pragma unroll
                    for (int e = 0; e < 16; ++e) { const float p = __builtin_amdgcn_exp2f(S[s][e] - mnew); S[s][e] = p; ps += p; }
                lsum = lsum * alpha + ps;
#pragma unroll
                for (int d = 0; d < DB; ++d)
#pragma unroll
                    for (int e = 0; e < 16; ++e) O[d][e] *= alpha;
#pragma unroll
                for (int s = 0; s < 2; ++s)
#pragma unroll
                    for (int t = 0; t < 2; ++t) {
                        u32x4 pk;
#pragma unroll
                        for (int q = 0; q < 4; ++q) pk[q] = cvt_pk_bf16(S[s][8 * t + 2 * q], S[s][8 * t + 2 * q + 1]);
                        const bf16x8 pb = __builtin_bit_cast(bf16x8, pk);
#pragma unroll
                        for (int d = 0; d < DB; ++d) {
                            const LAS unsigned char* vp = b + KBYTES + (d * 32 + l32) * VROW + (s * 32 + 16 * t + 4 * half) * 2;
                            const u32x2 v0 = *(const LAS u32x2*)vp, v1 = *(const LAS u32x2*)(vp + 16);
                            const u32x4 vv = {v0.x, v0.y, v1.x, v1.y};
                            O[d] = MFMA32(__builtin_bit_cast(bf16x8, vv), pb, O[d]);
                        }
                    }
            }
        }
        if (st + 1 < nst) ATT_LSTORE(cur ^ 1);
        __syncthreads();
    }
#undef ATT_GLOAD
#undef ATT_LSTORE
    if (hasq) {
        const float l = lsum + __shfl_xor(lsum, 32); const float inv = 1.0f / l;
#pragma unroll
        for (int d = 0; d < DB; ++d)
#pragma unroll
            for (int gq = 0; gq < 4; ++gq) {
                u32x2 o; o.x = cvt_pk_bf16(O[d][4 * gq] * inv, O[d][4 * gq + 1] * inv); o.y = cvt_pk_bf16(O[d][4 * gq + 2] * inv, O[d][4 * gq + 3] * inv);
                *(u32x2*)(Ow + (size_t)l32 * 1024 + d * 32 + 8 * gq + 4 * half) = o;
            }
    }
}

__device__ __forceinline__ void mixer_phase(KArgs a, LAS unsigned char* lds, int tid_in, int l) {
    unsigned char* ws = a->ws; const int G = gridDim.x;
    bf16_t* CAT = (bf16_t*)(ws + WS_CAT);
    constexpr int N_MEMP = 16 * 16 * 4, N_MEMS = 32 * 4;
#ifndef NO_MEMATT
    {
        int tid = tid_in; asm volatile("" : "+v"(tid)); const int wave = tid >> 6;
        const bf16_t* QM = (const bf16_t*)(ws + WS_QM);
        for (int it = blockIdx.x; it < REP_MEM * (N_MEMP + N_MEMS); it += G) {
            int r = it % (N_MEMP + N_MEMS); int bb, h, q0, nq;
            if (r < N_MEMP) { h = r & 3; const int qb = (r >> 2) & 15; bb = r >> 6; q0 = bb * SEQ + qb * 256; nq = 256; }
            else { r -= N_MEMP; h = r & 3; const int bs = r >> 2; bb = 16 + bs; q0 = MP + bs * 64; nq = 64; }
            const bool hasq = wave * 32 < nq; const int qrow = q0 + wave * 32;
            attn_unit<128, false>(lds, tid, QM + (size_t)qrow * 512 + h * 128, hasq, (const bf16_t*)(ws + WS_MEMK) + ((size_t)l * 48 + bb) * 256 * 512 + h * 128, 512,
                                  (const bf16_t*)(ws + WS_MEMVT) + (((size_t)l * 48 + bb) * 512 + h * 128) * 256, 256, 0, 4, 0, 3, CAT + (size_t)qrow * 1024 + 512 + h * 128, nullptr, 0);
        }
    }
#endif
    if (l < 2) {
#ifndef NO_GATE
        int tid = tid_in; asm volatile("" : "+v"(tid));
        for (int r_ = blockIdx.x; r_ < REP_GATE * (512 + 32); r_ += G) { const int r = r_ % (512 + 32);
            int chunk, joff, nib, row0; float* av = nullptr;
            if (r < 512) { chunk = r; joff = 0; nib = 4; row0 = r * 128; }
            else { const int bs = r - 512; chunk = 512 + (bs >> 1); joff = (bs & 1) * 64; nib = 2; row0 = MP + bs * 64; av = a->out + OUT_AV + ((size_t)l * 32 + bs) * 64 * 512; }
            gate_unit(lds, tid, chunk, joff, nib, row0, (const bf16_t*)(ws + WS_WSB) + (size_t)l * 8 * 128 * 128, (const bf16_t*)(ws + WS_VT), (const bf16_t*)(ws + WS_U),
                      (const ssq_t*)(ws + WS_SSQ) + (size_t)(9 + l) * MT, a->in[10] + l * 512, a->in[12] + l * 8 * 128, CAT, av);
        }
#endif
    } else {
#ifndef NO_BAND
        int tid = tid_in; asm volatile("" : "+v"(tid)); const int wave = tid >> 6;
        const int jl = l - 2; const bf16_t* Q = (const bf16_t*)(ws + WS_U);
        LAS float* btab = (LAS float*)(lds + 76800);
        for (int it = blockIdx.x; it < REP_BAND * (16 * 8 * 16 + 32 * 8); it += G) {
            int r = it % (16 * 8 * 16 + 32 * 8);
            int h, qrow, jstart, nkb, jlo, jhi, relq; const bf16_t* Kb; const bf16_t* Vtb; int ldv; bool hasq;
            if (r < 16 * 8 * 16) { h = r & 7; const int cg4 = (r >> 3) & 15; const int b = r >> 7; const int c0 = cg4 * 4;
                qrow = b * SEQ + c0 * 64 + wave * 32; hasq = true; nkb = 12; jstart = c0 >= 8 ? 0 : 8 - c0; jlo = wave >> 1; jhi = jlo + 8;
                Kb = (const bf16_t*)(ws + WS_PK) + ((long)b * SEQ + (long)(c0 - 8) * 64) * 512 + h * 64;
                Vtb = (const bf16_t*)(ws + WS_PVT) + ((long)b * 512 + h * 64) * 4096 + (long)(c0 - 8) * 64; ldv = 4096;
                relq = 512 + (wave >> 1) * 64 + (wave & 1) * 32 + (tid & 31); }
            else { r -= 16 * 8 * 16; h = r & 7; const int bs = r >> 3; qrow = MP + bs * 64 + wave * 32; hasq = wave < 2; nkb = 9; jstart = 0; jlo = 0; jhi = 8;
                Kb = (const bf16_t*)(ws + WS_SK) + (size_t)bs * 576 * 512 + h * 64; Vtb = (const bf16_t*)(ws + WS_SVT) + ((size_t)bs * 512 + h * 64) * 576; ldv = 576;
                relq = 512 + (wave & 1) * 32 + (tid & 31); }
            __syncthreads();
            if (tid < 320) btab[tid] = a->in[16][((size_t)jl * 8 + h) * 513 + 193 + tid] * LOG2E;
            attn_unit<64, true>(lds, tid, Q + (size_t)qrow * 512 + h * 64, hasq, Kb, 512, Vtb, ldv, jstart, nkb, jlo, jhi, CAT + (size_t)qrow * 1024 + h * 64, btab, relq);
        }
#endif
    }
}

__device__ __forceinline__ void fixup_phase(KArgs a, int tid, int l) {
    unsigned char* ws = a->ws; const float* tail = (const float*)(ws + WS_TAIL); const float* head = (const float*)(ws + WS_HEAD); bf16_t* ACT = (bf16_t*)(ws + WS_ACT);
    const float* cw = a->in[22] + (size_t)l * 3 * DFF; const float* sc = a->in[7] + (size_t)l * 32 * 2 * DFF;
    const size_t gt = (size_t)blockIdx.x * NTHR + tid, NT = (size_t)gridDim.x * NTHR;
    for (size_t i = gt; i < (size_t)NBLK64 * DFF; i += NT) {
        const int blk = (int)(i / DFF), f = (int)(i % DFF);
        float pm2, pm1;
        if (blk >= MP / 64) { const int bs = blk - MP / 64; pm2 = sc[((size_t)bs * 2 + 0) * DFF + f]; pm1 = sc[((size_t)bs * 2 + 1) * DFF + f]; }
        else if ((blk & 63) == 0) { pm2 = 0.f; pm1 = 0.f; }
        else { pm2 = tail[((size_t)(blk - 1) * 2 + 0) * DFF + f]; pm1 = tail[((size_t)(blk - 1) * 2 + 1) * DFF + f]; }
        const float w0 = cw[f], w1 = cw[DFF + f];
        const float* hp = head + (size_t)blk * 4 * DFF + f;
        const float c0 = hp[0] + w0 * pm2 + w1 * pm1, g0 = hp[DFF], c1 = hp[2 * DFF] + w0 * pm1, g1 = hp[3 * DFF];
        ACT[(size_t)blk * 64 * DFF + f] = f2bf(gelu_t(c0) * g0);
        ACT[((size_t)blk * 64 + 1) * DFF + f] = f2bf(gelu_t(c1) * g1);
        const float t0 = tail[((size_t)blk * 2 + 0) * DFF + f], t1 = tail[((size_t)blk * 2 + 1) * DFF + f];
        if (blk >= MP / 64) { float* o = a->out + OUT_CS + ((size_t)l * 32 + (blk - MP / 64)) * 2 * DFF + f; o[0] = t0; o[DFF] = t1; }
        else if ((blk & 63) == 63) { float* o = a->out + OUT_CP + ((size_t)l * 16 + (blk >> 6)) * 2 * DFF + f; o[0] = t0; o[DFF] = t1; }
    }
}

__device__ __forceinline__ void final_phase(KArgs a, int tid) {
    const ssq_t* ssq = (const ssq_t*)(a->ws + WS_SSQ) + (size_t)4 * MT; const float* g = a->in[25]; const bf16_t* hb = (const bf16_t*)(a->ws + WS_HB);
    const int lane = tid & 63; const int gw = blockIdx.x * NWAVES + (tid >> 6), NGW = gridDim.x * NWAVES;
    for (int m = gw; m < MT; m += NGW) {
        const float r = rs_fromu(ssq[m], 1.0f / 1024.0f); f32x4* row = (f32x4*)(a->out + (size_t)m * 1024); const u32x2* hr = (const u32x2*)(hb + (size_t)m * 1024);
#pragma unroll
        for (int j = 0; j < 4; ++j) { const f32x4 gg = *((const f32x4*)g + lane + 64 * j); const u32x2 w = hr[lane + 64 * j]; f32x4 v;
            v[0] = __builtin_bit_cast(float, w.x << 16); v[1] = __builtin_bit_cast(float, w.x & 0xffff0000u); v[2] = __builtin_bit_cast(float, w.y << 16); v[3] = __builtin_bit_cast(float, w.y & 0xffff0000u);
            row[lane + 64 * j] = v * r * gg; }
    }
}


#define XB_TMO      128
#define XB_XCNT(j)  (256  + 64 * (j))
#define XB_XSUB(j)  (1280 + 64 * (j))
#define XB_XGEN(j)  (2304 + 64 * (j))
#define XB_TOP      3328
#define XB_TOPGEN   3392
#define XCD_BAR_WORDS 3456
#define XB_SPIN_CAP (1u << 18)

__device__ __forceinline__ unsigned xb_ld(unsigned* p)              { return __hip_atomic_load(p, __ATOMIC_RELAXED, __HIP_MEMORY_SCOPE_AGENT); }
__device__ __forceinline__ unsigned xb_add(unsigned* p, unsigned v) { return __hip_atomic_fetch_add(p, v, __ATOMIC_RELAXED, __HIP_MEMORY_SCOPE_AGENT); }
__device__ __forceinline__ unsigned xb_xcc_id() { return (unsigned)__builtin_amdgcn_s_getreg((3 << 11) | 20) & 0xFu; }
#define XB_SPIN(cond, bar) do { unsigned _sp = 0; while (cond) { __builtin_amdgcn_s_sleep(1); \
    if ((++_sp & 255u) == 0u) { if (xb_ld(&(bar)[XB_TMO])) break; if (_sp > XB_SPIN_CAP) { atomicAdd(&(bar)[XB_TMO], 1u); break; } } } } while (0)

struct XcdBarrier {
    unsigned* bar; unsigned x;
    volatile LAS unsigned* st;
};

__device__ __forceinline__ XcdBarrier xcd_barrier_post(unsigned* bar, volatile LAS unsigned* st) {
    XcdBarrier b; b.bar = bar; b.x = xb_xcc_id(); b.st = st;
    if (threadIdx.x == 0) (void)xb_add(&bar[XB_XCNT(b.x)], 1u);
    return b;
}
__device__ __forceinline__ void xcd_barrier_complete(unsigned* bar, unsigned x, unsigned& nloc, unsigned& nx) {
    const unsigned G = gridDim.x * gridDim.y * gridDim.z;
    unsigned sum, cnt, mine, sp = 0u;
    for (;;) {
        sum = 0u; cnt = 0u; mine = 0u;
#pragma unroll
        for (unsigned j = 0; j < 16; ++j) { const unsigned c = xb_ld(&bar[XB_XCNT(j)]); sum += c; cnt += (c > 0u) ? 1u : 0u; mine = (j == x) ? c : mine; }
        if (sum == G) break;
        __builtin_amdgcn_s_sleep(1);
        if ((++sp & 255u) == 0u) { if (xb_ld(&bar[XB_TMO])) break; if (sp > XB_SPIN_CAP) { atomicAdd(&bar[XB_TMO], 1u); break; } }
    }
    nloc = mine > 0u ? mine : 1u; nx = cnt > 0u ? cnt : 1u;
}

__device__ __forceinline__ void xcd_barrier(const XcdBarrier& b) {
    asm volatile("s_waitcnt vmcnt(0)" ::: "memory");
    __syncthreads();
    if (threadIdx.x == 0) {
        unsigned* bar = b.bar;
        __builtin_amdgcn_s_waitcnt(0);
        unsigned nloc = b.st[0], nx = b.st[1];
        if (nloc == 0u) { xcd_barrier_complete(bar, b.x, nloc, nx); b.st[0] = nloc; b.st[1] = nx; }
        const unsigned old = xb_add(&bar[XB_XSUB(b.x)], 1u);
        const unsigned gen = old / nloc;
        if (old + 1u == (gen + 1u) * nloc) {
            __builtin_amdgcn_fence(__ATOMIC_RELEASE, "agent");
            asm volatile("s_waitcnt vmcnt(0)" ::: "memory");
            const unsigned og = xb_add(&bar[XB_TOP], 1u);
            const unsigned tg = og / nx;
            if (og + 1u == (tg + 1u) * nx) xb_add(&bar[XB_TOPGEN], 1u);
            else XB_SPIN(xb_ld(&bar[XB_TOPGEN]) == tg, bar);
            __builtin_amdgcn_fence(__ATOMIC_ACQUIRE, "agent");
            xb_add(&bar[XB_XGEN(b.x)], 1u);
            asm volatile("s_waitcnt vmcnt(0)" ::: "memory");
        } else {
            XB_SPIN(xb_ld(&bar[XB_XGEN(b.x)]) == gen, bar);
            __builtin_amdgcn_fence(__ATOMIC_ACQUIRE, "agent");
            asm volatile("s_waitcnt vmcnt(0)" ::: "memory");
        }
    }
    __syncthreads();
}

#ifndef REP_P0
#define REP_P0 1
#endif
#ifndef REP_MIX
#define REP_MIX 1
#endif
#ifndef REP_UP
#define REP_UP 1
#endif
#ifndef REP_FIX
#define REP_FIX 1
#endif
#ifndef REP_G
#define REP_G 1
#endif
__device__ __forceinline__ void launder(int& t) { asm volatile("" : "+v"(t)); }
__global__ void __launch_bounds__(NTHR, 2) fwd_kernel(Args a) {
    extern __shared__ __attribute__((aligned(16))) unsigned char lds_raw[];
    LAS unsigned char* lds = (LAS unsigned char*)lds_raw;
    int tid = threadIdx.x; const int G = gridDim.x;
    KArgs kp = (KArgs)__builtin_amdgcn_kernarg_segment_ptr();
    volatile LAS unsigned* bst = (volatile LAS unsigned*)(lds + LDS_BYTES - 64);
    if (tid < 2) bst[tid] = 0u;
    __syncthreads();
    XcdBarrier bar; bar.bar = (unsigned*)(a.ws + WS_BAR); bar.x = 0; bar.st = bst;
    if (a.coop) bar = xcd_barrier_post((unsigned*)(a.ws + WS_BAR), bst);
#define PH_ARGS() KArgs q = kp; asm volatile("" : "+s"(q)); unsigned char* ws = q->ws; ssq_t* ssqb = (ssq_t*)(ws + WS_SSQ); bf16_t* HB = (bf16_t*)(ws + WS_HB); (void)ssqb; (void)HB;
    int ph = 0;
#ifndef REP_SYNC
#define REP_SYNC 1
#endif
#define SEAM() do { if (a.coop && ph + 1 < a.ph_hi) { for (int rs_ = 0; rs_ < REP_SYNC; ++rs_) { if (a.coop == 2) cg::this_grid().sync(); else xcd_barrier(bar); } } } while (0)
#define IN_PH() (launder(tid), ph >= a.ph_lo && ph < a.ph_hi)
#ifndef EN_MASK
#define EN_MASK 0xffff
#endif
#define EN(k) ((EN_MASK >> (k)) & 1)

    if (IN_PH()) { PH_ARGS(); for (int rep = 0; rep < REP_P0; ++rep) p0_prologue(q, lds, tid); SEAM(); } ++ph;

#pragma unroll 1
    for (int l = 0; l < 4; ++l) {
        if (IN_PH()) { PH_ARGS();
            if (l < 2) { if (EN(1)) {
                pg8::Gemm g{HB, (const bf16_t*)(ws + WS_WINA) + (size_t)l * 1536 * 1024, MT, 1536, 1024}; pg8::StaticOrder S; S.init(MT, 1536, G, (int)blockIdx.x);
                EpiInA E{ssqb + (size_t)l * MT, (bf16_t*)(ws + WS_U), (bf16_t*)(ws + WS_VT), (bf16_t*)(ws + WS_QM), ssqb + (size_t)(9 + l) * MT, 0.08838834764831845f * LOG2E};
                S.rep = REP_G; pg8::gemm_phase<EpiInA, pg8::StaticOrder, true, true>(lds, g, S, E, tid); }
                if (EN(2) && l == 0) {
                    pg8::Gemm g2{(const bf16_t*)(ws + WS_MPB), (const bf16_t*)(ws + WS_WMEM), 4096, 4096, 1024}; pg8::StaticOrder S2; S2.init(4096, 4096, G, (int)blockIdx.x);
                    EpiMem E2{(const float*)(ws + WS_RMEM), q->out, (bf16_t*)(ws + WS_MEMK), (bf16_t*)(ws + WS_MEMVT)};
                    pg8::gemm_phase<EpiMem, pg8::StaticOrder, true, true>(lds, g2, S2, E2, tid);
                }
            } else if (EN(3)) {
                const int N = l == 2 ? 2048 : 1024;
                pg8::Gemm g{HB, (const bf16_t*)(ws + WS_WB) + (size_t)(l == 2 ? 0 : 2048) * 1024, MT, N, 1024}; pg8::StaticOrder S; S.init(MT, N, G, (int)blockIdx.x);
                EpiInB E{ssqb + (size_t)l * MT, (bf16_t*)(ws + WS_U), (bf16_t*)(ws + WS_QM), (bf16_t*)(ws + WS_PK), (bf16_t*)(ws + WS_PVT), (bf16_t*)(ws + WS_SK), (bf16_t*)(ws + WS_SVT), q->out,
                         0.125f * LOG2E, 0.08838834764831845f * LOG2E};
                S.rep = REP_G; pg8::gemm_phase<EpiInB, pg8::StaticOrder, true, true>(lds, g, S, E, tid);
            }
            SEAM();
        } ++ph;
        if (IN_PH()) { PH_ARGS(); for (int rep = 0; rep < REP_MIX; ++rep) mixer_phase(q, lds, tid, l); SEAM(); } ++ph;
        if (IN_PH()) { PH_ARGS(); if (EN(5)) {
            pg8::Gemm g{(const bf16_t*)(ws + WS_CAT), (const bf16_t*)(ws + WS_WOUT) + (size_t)l * 1024 * 1024, MT, 1024, 1024}; pg8::StaticOrder S; S.init(MT, 1024, G, (int)blockIdx.x);
            EpiRes E{HB, ssqb + (size_t)(5 + l) * MT};
            S.rep = REP_G; pg8::gemm_phase<EpiRes, pg8::StaticOrder, true, true>(lds, g, S, E, tid); }
            SEAM();
        } ++ph;
        if (IN_PH()) { PH_ARGS(); if (EN(6)) {
            pg8::Gemm g{HB, (const bf16_t*)(ws + WS_WUP) + (size_t)l * 5632 * 1024, MT, 5632, 1024}; pg8::StaticOrder S; S.init(MT, 5632, G, (int)blockIdx.x);
            EpiUp E{ssqb + (size_t)(5 + l) * MT, q->in[22] + (size_t)l * 3 * DFF, q->in[23] + (size_t)l * DFF, (bf16_t*)(ws + WS_ACT), (float*)(ws + WS_TAIL), (float*)(ws + WS_HEAD)};
            S.rep = REP_UP; pg8::gemm_phase<EpiUp, pg8::StaticOrder, true, true>(lds, g, S, E, tid); }
            SEAM();
        } ++ph;
        if (IN_PH()) { PH_ARGS(); for (int rep = 0; rep < REP_FIX; ++rep) fixup_phase(q, tid, l); SEAM(); } ++ph;
        if (IN_PH()) { PH_ARGS(); if (EN(8)) {
            pg8::Gemm g{(const bf16_t*)(ws + WS_ACT), (const bf16_t*)(ws + WS_WDOWN) + (size_t)l * 1024 * DFF, MT, 1024, DFF}; pg8::StaticOrder S; S.init(MT, 1024, G, (int)blockIdx.x);
            EpiRes E{HB, ssqb + (size_t)(l + 1) * MT};
            S.rep = REP_G; pg8::gemm_phase<EpiRes, pg8::StaticOrder, true, true>(lds, g, S, E, tid); }
            SEAM();
        } ++ph;
    }
    if (IN_PH()) { PH_ARGS(); for (int rep = 0; rep < REP_FIX; ++rep) final_phase(q, tid); } ++ph;
#undef SEAM
#undef IN_PH
}
constexpr int N_PHASES = 26;

#ifndef MK_MULTI
#define MK_MULTI 0
#endif

extern "C" void kernel_launch(void* const* d_in, const int* in_sizes, int n_in, void* d_out, int out_size, void* d_ws, size_t ws_size, hipStream_t stream) {
    static int grid = 0;
    if (grid == 0) {
        if (n_in != 26 || (size_t)out_size != OUT_END || ws_size < WS_END) { fprintf(stderr, "kernel_launch: unexpected sizes n_in %d out %d ws %zu (need %zu)\n", n_in, out_size, ws_size, (size_t)WS_END); grid = -1; return; }
        int dev = 0, cus = 0, per_cu = 0;
        if (hipGetDevice(&dev) != hipSuccess || hipDeviceGetAttribute(&cus, hipDeviceAttributeMultiprocessorCount, dev) != hipSuccess) { grid = -1; return; }
        if (hipFuncSetAttribute((const void*)fwd_kernel, hipFuncAttributeMaxDynamicSharedMemorySize, LDS_BYTES) != hipSuccess) { fprintf(stderr, "kernel_launch: hipFuncSetAttribute failed\n"); grid = -1; return; }
        if (hipOccupancyMaxActiveBlocksPerMultiprocessor(&per_cu, (const void*)fwd_kernel, NTHR, LDS_BYTES) != hipSuccess || per_cu < 1) { fprintf(stderr, "kernel_launch: occupancy query says %d\n", per_cu); per_cu = 1; }
        (void)hipGetLastError();
        grid = cus * 1;
    }
    if (grid < 0) return;
    Args a{};
    for (int i = 0; i < 26; ++i) a.in[i] = (const float*)d_in[i];
    a.out = (float*)d_out; a.ws = (unsigned char*)d_ws;
#if MK_MULTI
    for (int p = 0; p < N_PHASES; ++p) { a.ph_lo = p; a.ph_hi = p + 1; a.coop = 0; hipLaunchKernelGGL(fwd_kernel, dim3(grid), dim3(NTHR), LDS_BYTES, stream, a); }
#else
    a.ph_lo = 0; a.ph_hi = N_PHASES; a.coop = 1;
    if (hipMemsetAsync((char*)d_ws + WS_BAR, 0, BAR_BYTES, stream) != hipSuccess) { fprintf(stderr, "memset failed\n"); return; }
    void* args[] = {&a};
    hipError_t e = hipLaunchCooperativeKernel((const void*)fwd_kernel, dim3(grid), dim3(NTHR), args, LDS_BYTES, stream);
    if (e != hipSuccess) fprintf(stderr, "cooperative launch failed: %s (grid %d)\n", hipGetErrorString(e), grid);
#endif
}
```

```cpp
#include <hip/hip_runtime.h>
#include <hip/hip_cooperative_groups.h>
#include <cstdio>
#include <cstdint>
namespace cg = cooperative_groups;
namespace pg8 {
#define PG8_LAS __attribute__((address_space(3)))
typedef unsigned short bf16_t;
typedef short bf16x8 __attribute__((ext_vector_type(8)));
typedef float f32x4 __attribute__((ext_vector_type(4)));
typedef unsigned u32x4 __attribute__((ext_vector_type(4)));
constexpr int BM = 256, BK = 64, HALF = 128, HTB = HALF * BK * 2  , STAGE_BYTES = 8 * HTB, NXCD = 8, WGM = 8;

__host__ __device__ __forceinline__ int lds_byte(int r, int c) { const int st = (r >> 4) * 2 + (c >> 5), rr = r & 15, cc = c & 31, ob = rr * 64 + cc * 2; return st * 1024 + (ob ^ (((ob >> 9) & 1) << 5)); }
__host__ __device__ __forceinline__ void stage_rc(int b, int& R, int& C) { const int st = b / 1024, sb = b % 1024, swz = sb ^ (((sb >> 9) & 1) << 5); R = (st >> 1) * 16 + swz / 64; C = (st & 1) * 32 + (swz % 64) / 2; }
__host__ __device__ __forceinline__ int perm32(int rho) { const int n = rho >> 4, i = rho & 15; return 8 * (i >> 2) + 4 * n + (i & 3); }

struct Unit { int pm, pn, pass; };
struct Gemm { const bf16_t* A; const bf16_t* Bt; int M, N, K; };

struct StaticOrder {
    int nM, nN, nwg, G, c, rep = 1;
    __host__ __device__ void init(int M, int N, int G_, int c_) { nM = M / BM; nN = N / BM; nwg = nM * nN; G = G_; c = c_; }
    __host__ __device__ bool next(int i, Unit& u) const {
        const long L = (long)i * G + c; if (L >= (long)nwg * rep) return false;
        int wgid = (int)(L % nwg); u.pass = (int)(L / nwg); { const int q = nwg / NXCD, r = nwg % NXCD, xcd = wgid % NXCD, off = wgid / NXCD; wgid = (xcd < r ? xcd * (q + 1) : r * (q + 1) + (xcd - r) * q) + off; }
        const int nig = WGM * nN, gid = wgid / nig, fm = gid * WGM, gsz = (nM - fm) < WGM ? (nM - fm) : WGM;
        u.pm = fm + ((wgid % nig) % gsz); u.pn = (wgid % nig) / gsz; return true;
    }
    __device__ __forceinline__ void a_ready(const Unit&) const {}
    __device__ __forceinline__ void done(const Unit&) const {}
};

__device__ __forceinline__ unsigned cvt_pk_bf16(float lo, float hi) { unsigned r; asm volatile("v_cvt_pk_bf16_f32 %0, %1, %2" : "=v"(r) : "v"(lo), "v"(hi)); return r; }
template <class Epi, class Sched, bool ALIGN_EPI = false, bool SP2 = false>
__device__ __forceinline__ void gemm_phase(PG8_LAS unsigned char* lds, const Gemm g, const Sched& S, const Epi& E, const int tid) {
    const int wid = __builtin_amdgcn_readfirstlane(tid >> 6), lane = tid & 63, wr = wid >> 2, wc = wid & 3, fr = lane & 15, fq = lane >> 4;
    const int K = g.K, nt = K / BK;
    unsigned voffA[2], voffB[2];
#pragma unroll
    for (int i = 0; i < 2; ++i) { int R, C; stage_rc(tid * 16 + i * 8192, R, C); const int Rb = Epi::PERM ? ((R & ~31) + perm32(R & 31)) : R;
        voffA[i] = (unsigned)(R * K + C) * 2u; voffB[i] = (unsigned)(Rb * K + C) * 2u; }
    const size_t kstep = (size_t)(BK * 2);
    const size_t hstep = (size_t)HALF * K * 2;
    const size_t tstep = 2 * hstep;
    const unsigned ldsw = (unsigned)wid * 1024u;
    const int aoff = lds_byte(wr * 64 + fr, fq * 8), boff = lds_byte(wc * 32 + fr, fq * 8);
#define PG8_SA(b, h) (((b) * 2 + (h)) * HTB)
#define PG8_SB(b, h) ((4 + (b) * 2 + (h)) * HTB)
#define PG8_STAGE(bufoff, gbase, voff) do { _Pragma("unroll") for (int _i = 0; _i < 2; ++_i) \
        __builtin_amdgcn_global_load_lds((const unsigned*)((const char*)(gbase) + (voff)[_i]), (PG8_LAS unsigned*)(lds + (bufoff) + ldsw + _i * 8192), 16, 0, 0); } while (0)
#define PG8_LDA(dst, b, h) do { _Pragma("unroll") for (int m = 0; m < 4; ++m) _Pragma("unroll") for (int k = 0; k < 2; ++k) dst[m][k] = *(const PG8_LAS bf16x8*)(lds + PG8_SA(b, h) + aoff + m * 2048 + k * 1024); } while (0)
#define PG8_LDB(dst, b, h) do { _Pragma("unroll") for (int n = 0; n < 2; ++n) _Pragma("unroll") for (int k = 0; k < 2; ++k) dst[n][k] = *(const PG8_LAS bf16x8*)(lds + PG8_SB(b, h) + boff + n * 2048 + k * 1024); } while (0)
#define PG8_MMA(ai, bj, At, Bt) do { __builtin_amdgcn_s_setprio(1); _Pragma("unroll") for (int m = 0; m < 4; ++m) _Pragma("unroll") for (int n = 0; n < 2; ++n) _Pragma("unroll") for (int k = 0; k < 2; ++k) \
        acc[ai][bj][m][n] = __builtin_amdgcn_mfma_f32_16x16x32_bf16(Bt[n][k], At[m][k], acc[ai][bj][m][n], 0, 0, 0); __builtin_amdgcn_s_setprio(0); } while (0)
#define PG8_WAIT_V(n) asm volatile("s_waitcnt vmcnt(" #n ")" ::: "memory")
#define PG8_WAIT_L(n) asm volatile("s_waitcnt lgkmcnt(" #n ")" ::: "memory")
#define PG8_BAR __builtin_amdgcn_s_barrier()
#define PG8_SCHED __builtin_amdgcn_sched_barrier(0)
    Unit cur, nxt; int ui = 0;
    if (!S.next(0, cur)) return;
    f32x4 acc[2][2][4][2];
#pragma unroll
    for (int a = 0; a < 2; ++a)
#pragma unroll
        for (int b = 0; b < 2; ++b)
#pragma unroll
            for (int m = 0; m < 4; ++m)
#pragma unroll
                for (int n = 0; n < 2; ++n) acc[a][b][m][n] = (f32x4){0.f, 0.f, 0.f, 0.f};
    bf16x8 At[4][2], B0[2][2], B1[2][2];
    const char* cA = (const char*)g.A + (size_t)cur.pm * tstep; const char* cB = (const char*)g.Bt + (size_t)cur.pn * tstep;
    S.a_ready(cur);
    if constexpr (SP2) {
        PG8_STAGE(PG8_SB(0, 0), cB, voffB); PG8_STAGE(PG8_SB(0, 1), cB + hstep, voffB); PG8_STAGE(PG8_SA(0, 0), cA, voffA); PG8_STAGE(PG8_SA(0, 1), cA + hstep, voffA);
        if (wr == 1) PG8_BAR;
        PG8_WAIT_V(2); PG8_BAR;
        PG8_STAGE(PG8_SB(1, 0), cB + kstep, voffB); PG8_STAGE(PG8_SA(1, 0), cA + kstep, voffA); PG8_STAGE(PG8_SB(1, 1), cB + hstep + kstep, voffB);
        PG8_WAIT_V(6); PG8_BAR;
    } else {
        PG8_STAGE(PG8_SB(0, 0), cB, voffB); PG8_STAGE(PG8_SA(0, 0), cA, voffA); PG8_STAGE(PG8_SB(0, 1), cB + hstep, voffB); PG8_STAGE(PG8_SA(0, 1), cA + hstep, voffA);
        if (wr == 1) PG8_BAR;
        PG8_WAIT_V(4); PG8_BAR;
        PG8_STAGE(PG8_SB(1, 0), cB + kstep, voffB); PG8_STAGE(PG8_SA(1, 0), cA + kstep, voffA); PG8_STAGE(PG8_SB(1, 1), cB + hstep + kstep, voffB);
        PG8_WAIT_V(6); PG8_BAR;
    }
    for (;;) {
        const bool has_next = S.next(ui + 1, nxt);
        const char* nA = has_next ? (const char*)g.A + (size_t)nxt.pm * tstep : cA; const char* nB = has_next ? (const char*)g.Bt + (size_t)nxt.pn * tstep : cB;
        for (int t = 0; t < nt; t += 2) {
            const bool last = (t == nt - 2);
            const char* a1 = cA + (size_t)(t + 1) * kstep;
            const char* a2 = last ? nA : cA + (size_t)(t + 2) * kstep; const char* b2 = last ? nB : cB + (size_t)(t + 2) * kstep;
            const char* a3 = a2 + kstep; const char* b3 = b2 + kstep;
            if (last && has_next) S.a_ready(nxt);
            if constexpr (SP2) {
            PG8_LDB(B0, 0, 0); PG8_LDB(B1, 0, 1); PG8_SCHED; PG8_LDA(At, 0, 0); PG8_STAGE(PG8_SA(1, 1), a1 + hstep, voffA);
            PG8_WAIT_V(8); PG8_WAIT_L(0); PG8_BAR; PG8_MMA(0, 0, At, B0); PG8_MMA(0, 1, At, B1); PG8_BAR; PG8_SCHED;
            PG8_LDA(At, 0, 1); PG8_STAGE(PG8_SB(0, 0), b2, voffB); PG8_STAGE(PG8_SB(0, 1), b2 + hstep, voffB); PG8_STAGE(PG8_SA(0, 0), a2, voffA);
            PG8_WAIT_V(8); PG8_WAIT_L(0); PG8_BAR; PG8_MMA(1, 0, At, B0); PG8_MMA(1, 1, At, B1); PG8_BAR; PG8_SCHED;
            PG8_LDB(B0, 1, 0); PG8_LDB(B1, 1, 1); PG8_SCHED; PG8_LDA(At, 1, 0); PG8_STAGE(PG8_SA(0, 1), a2 + hstep, voffA);
            PG8_WAIT_V(8); PG8_WAIT_L(0); PG8_BAR; PG8_MMA(0, 0, At, B0); PG8_MMA(0, 1, At, B1); PG8_BAR; PG8_SCHED;
            PG8_LDA(At, 1, 1); PG8_STAGE(PG8_SB(1, 0), b3, voffB); PG8_STAGE(PG8_SB(1, 1), b3 + hstep, voffB); PG8_STAGE(PG8_SA(1, 0), a3, voffA);
            PG8_WAIT_V(8); PG8_WAIT_L(0); PG8_BAR; PG8_MMA(1, 0, At, B0); PG8_MMA(1, 1, At, B1); PG8_BAR; PG8_SCHED;
            } else {
            PG8_LDB(B0, 0, 0); PG8_SCHED; PG8_LDA(At, 0, 0); PG8_STAGE(PG8_SA(1, 1), a1 + hstep, voffA);
            PG8_WAIT_L(8); PG8_BAR; PG8_WAIT_L(0); PG8_MMA(0, 0, At, B0); PG8_BAR; PG8_SCHED;
            PG8_LDB(B1, 0, 1); PG8_STAGE(PG8_SB(0, 0), b2, voffB);
            PG8_BAR; PG8_WAIT_L(0); PG8_MMA(0, 1, At, B1); PG8_BAR;
            PG8_LDA(At, 0, 1); PG8_STAGE(PG8_SA(0, 0), a2, voffA);
            PG8_BAR; PG8_WAIT_L(0); PG8_MMA(1, 0, At, B0); PG8_BAR; PG8_SCHED;
            PG8_STAGE(PG8_SB(0, 1), b2 + hstep, voffB);
            PG8_WAIT_V(6); PG8_BAR; PG8_MMA(1, 1, At, B1); PG8_BAR;
            PG8_LDB(B0, 1, 0); PG8_SCHED; PG8_LDA(At, 1, 0); PG8_STAGE(PG8_SA(0, 1), a2 + hstep, voffA);
            PG8_WAIT_L(8); PG8_BAR; PG8_WAIT_L(0); PG8_MMA(0, 0, At, B0); PG8_BAR; PG8_SCHED;
            PG8_LDB(B1, 1, 1); PG8_STAGE(PG8_SB(1, 0), b3, voffB);
            PG8_BAR; PG8_WAIT_L(0); PG8_MMA(0, 1, At, B1); PG8_BAR;
            PG8_LDA(At, 1, 1); PG8_STAGE(PG8_SA(1, 0), a3, voffA);
            PG8_BAR; PG8_WAIT_L(0); PG8_MMA(1, 0, At, B0); PG8_BAR; PG8_SCHED;
            PG8_STAGE(PG8_SB(1, 1), b3 + hstep, voffB);
            PG8_WAIT_V(6); PG8_BAR; PG8_MMA(1, 1, At, B1); PG8_BAR;
            }
        }
        if constexpr (ALIGN_EPI) { if (wr == 0) PG8_BAR; }
        if constexpr (!Epi::AFTER_DRAIN) { if (cur.pass == S.rep - 1) E(acc, cur, wr, wc, fr, fq); S.done(cur); }
        if (!has_next) break;
#pragma unroll
        for (int a = 0; a < 2; ++a)
#pragma unroll
            for (int b = 0; b < 2; ++b)
#pragma unroll
                for (int m = 0; m < 4; ++m)
#pragma unroll
                    for (int n = 0; n < 2; ++n) acc[a][b][m][n] = (f32x4){0.f, 0.f, 0.f, 0.f};
        cur = nxt; cA = nA; cB = nB; ++ui;
        if constexpr (ALIGN_EPI) { if (wr == 1) PG8_BAR; }
    }
    PG8_WAIT_V(0);
    if constexpr (!ALIGN_EPI) { if (wr == 0) PG8_BAR; }
    PG8_BAR;
    if constexpr (Epi::AFTER_DRAIN) { E.fused(acc, cur, wr, wc, fr, fq, lds, wid, lane); S.done(cur); }
#undef PG8_SA
#undef PG8_SB
#undef PG8_STAGE
#undef PG8_LDA
#undef PG8_LDB
#undef PG8_MMA
#undef PG8_WAIT_V
#undef PG8_WAIT_L
#undef PG8_BAR
#undef PG8_SCHED
}
}

#define LAS __attribute__((address_space(3)))
typedef unsigned short bf16_t;
typedef short bf16x8 __attribute__((ext_vector_type(8)));
typedef float f32x4 __attribute__((ext_vector_type(4)));
typedef float f32x16 __attribute__((ext_vector_type(16)));
typedef unsigned u32x4 __attribute__((ext_vector_type(4)));
typedef unsigned u32x2 __attribute__((ext_vector_type(2)));
using pg8::cvt_pk_bf16;

constexpr int NWAVES = 8, NTHR = 512;
constexpr int DM = 1024, DFF = 2816, SEQ = 4096, NB = 16, NBS = 32, DSEQ = 64;
constexpr int MP = NB * SEQ, MS = NBS * DSEQ, MT = MP + MS;
constexpr int NBLK64 = MT / 64;
constexpr float EPS = 1e-6f, LOG2E = 1.4426950408889634f;
constexpr int LDS_BYTES = 147456;

constexpr size_t OUT_Y = 0;
constexpr size_t OUT_MK = (size_t)MT * DM;
constexpr size_t OUT_MV = OUT_MK + (size_t)4 * 16 * 256 * 512;
constexpr size_t OUT_BK = OUT_MV + (size_t)4 * 16 * 256 * 512;
constexpr size_t OUT_BV = OUT_BK + (size_t)16 * 512 * 512;
constexpr size_t OUT_CP = OUT_BV + (size_t)16 * 512 * 512;
constexpr size_t OUT_AV = OUT_CP + (size_t)4 * 16 * 2 * DFF;
constexpr size_t OUT_SK = OUT_AV + (size_t)2 * 32 * 64 * 512;
constexpr size_t OUT_SV = OUT_SK + (size_t)32 * 64 * 512;
constexpr size_t OUT_CS = OUT_SV + (size_t)32 * 64 * 512;
constexpr size_t OUT_END = OUT_CS + (size_t)4 * 32 * 2 * DFF;

constexpr size_t al256(size_t x) { return (x + 255) & ~(size_t)255; }
constexpr size_t WS_BAR = 0, BAR_BYTES = 16384;
constexpr size_t WS_SSQ = BAR_BYTES;
constexpr size_t WS_RMEM = al256(WS_SSQ + (size_t)11 * MT * 8);
constexpr size_t WS_WINA = al256(WS_RMEM + 4096 * 4);
constexpr size_t WS_WB = WS_WINA + (size_t)2 * 1536 * 1024 * 2;
constexpr size_t WS_WMEM = WS_WB + (size_t)3072 * 1024 * 2;
constexpr size_t WS_WOUT = WS_WMEM + (size_t)4096 * 1024 * 2;
constexpr size_t WS_WUP = WS_WOUT + (size_t)4096 * 1024 * 2;
constexpr size_t WS_WDOWN = WS_WUP + (size_t)4 * 5632 * 1024 * 2;
constexpr size_t WS_WSB = WS_WDOWN + (size_t)4 * 1024 * 2816 * 2;
constexpr size_t WS_MPB = WS_WSB + (size_t)2 * 8 * 128 * 128 * 2;
constexpr size_t WS_HB = WS_MPB + (size_t)4096 * 1024 * 2;
constexpr size_t WS_MEMK = WS_HB + (size_t)MT * 1024 * 2;
constexpr size_t WS_MEMVT = WS_MEMK + (size_t)4 * 48 * 256 * 512 * 2;
constexpr size_t WS_PK = WS_MEMVT + (size_t)4 * 48 * 256 * 512 * 2;
constexpr size_t WS_PVT = WS_PK + (size_t)MP * 512 * 2;
constexpr size_t WS_SK = WS_PVT + (size_t)MP * 512 * 2;
constexpr size_t WS_SVT = WS_SK + (size_t)32 * 576 * 512 * 2;
constexpr size_t WS_TAIL = WS_SVT + (size_t)32 * 576 * 512 * 2;
constexpr size_t WS_HEAD = WS_TAIL + (size_t)NBLK64 * 2 * DFF * 4;
constexpr size_t WS_OVL = WS_HEAD + (size_t)NBLK64 * 4 * DFF * 4;
constexpr size_t WS_ACT = WS_OVL;
constexpr size_t WS_U = WS_OVL;
constexpr size_t WS_VT = WS_U + (size_t)MT * 512 * 2;
constexpr size_t WS_QM = WS_VT + (size_t)MT * 512 * 2;
constexpr size_t WS_CAT = WS_QM + (size_t)MT * 512 * 2;
constexpr size_t WS_END = WS_OVL + (size_t)MT * DFF * 2;
static_assert(WS_CAT + (size_t)MT * 1024 * 2 <= WS_END, "overlay");
static_assert(WS_END <= (size_t)1073741824, "workspace budget");

__device__ __forceinline__ float bf2f(unsigned short b) { return __builtin_bit_cast(float, (unsigned)b << 16); }
__device__ __forceinline__ unsigned short f2bf(float f) { unsigned u = __builtin_bit_cast(unsigned, f); return (unsigned short)((u + 0x7fffu + ((u >> 16) & 1u)) >> 16); }
__device__ __forceinline__ float gelu_t(float x) {
    const float t = x * (1.0f + 0.044715f * x * x);
    const float e = __builtin_amdgcn_exp2f(-2.302208198f * t);
    return x * __builtin_amdgcn_rcpf(1.0f + e);
}
typedef unsigned long long ssq_t;
__device__ __forceinline__ float rs_from(float ssq, float invn) { return rsqrtf(ssq * invn + EPS); }
__device__ __forceinline__ float rs_fromu(ssq_t v, float invn) { return rsqrtf((float)v * (invn * (1.0f / 1048576.0f)) + EPS); }
__device__ __forceinline__ ssq_t to_fix(float ss) { return (ssq_t)(ss * 1048576.0f); }
__device__ __forceinline__ u32x4 pack8(const f32x4& a, const f32x4& b) { u32x4 w; w.x = cvt_pk_bf16(a[0], a[1]); w.y = cvt_pk_bf16(a[2], a[3]); w.z = cvt_pk_bf16(b[0], b[1]); w.w = cvt_pk_bf16(b[2], b[3]); return w; }
__device__ __forceinline__ float wave_sum(float v) {
#pragma unroll
    for (int o = 1; o < 64; o <<= 1) v += __shfl_xor(v, o);
    return v;
}
#define MFMA32(a, b, c) __builtin_amdgcn_mfma_f32_32x32x16_bf16((a), (b), (c), 0, 0, 0)
__device__ __forceinline__ int crow(int r, int hi) { return (r & 3) + 8 * (r >> 2) + 4 * hi; }

typedef f32x4 AccT[2][2][4][2];

struct EpiInA {
    static constexpr bool PERM = true, AFTER_DRAIN = false;
    const ssq_t* ssq; bf16_t* U; bf16_t* VT; bf16_t* QM; ssq_t* ssqv; float qscale;
    __device__ __forceinline__ void operator()(const AccT& acc, const pg8::Unit& u, int wr, int wc, int fr, int fq) const {
        const int row0 = u.pm * 256 + wr * 64 + fr; const int ty = u.pn >> 1; const int cb = (u.pn & 1) * 256 + wc * 32 + 8 * fq;
#pragma unroll
        for (int ai = 0; ai < 2; ++ai)
#pragma unroll
            for (int m = 0; m < 4; ++m) {
                const int row = row0 + ai * 128 + m * 16; const float r = rs_fromu(ssq[row], 1.0f / 1024.0f);
                if (ty == 0) {
#pragma unroll
                    for (int bj = 0; bj < 2; ++bj) { f32x4 a = acc[ai][bj][m][0] * r, b = acc[ai][bj][m][1] * r;
#pragma unroll
                        for (int e = 0; e < 4; ++e) { a[e] = gelu_t(a[e]); b[e] = gelu_t(b[e]); }
                        *(u32x4*)(U + (size_t)row * 512 + cb + bj * 128) = pack8(a, b); }
                } else if (ty == 2) {
                    const float s = r * qscale;
#pragma unroll
                    for (int bj = 0; bj < 2; ++bj) { f32x4 a = acc[ai][bj][m][0] * s, b = acc[ai][bj][m][1] * s;
                        *(u32x4*)(QM + (size_t)row * 512 + cb + bj * 128) = pack8(a, b); }
                } else {
                    float ss = 0.f; bf16_t* vt = VT + (size_t)(row >> 7) * 512 * 128 + (row & 127);
#pragma unroll
                    for (int bj = 0; bj < 2; ++bj)
#pragma unroll
                        for (int n = 0; n < 2; ++n)
#pragma unroll
                            for (int e = 0; e < 4; ++e) { const unsigned short hb = f2bf(gelu_t(acc[ai][bj][m][n][e] * r)); const float vr = bf2f(hb); ss += vr * vr;
                                vt[(size_t)(cb + bj * 128 + 4 * n + e) * 128] = hb; }
                    ss += __shfl_xor(ss, 16); ss += __shfl_xor(ss, 32);
                    if (fq == 0) atomicAdd(ssqv + row, to_fix(ss));
                }
            }
    }
};

struct EpiInB {
    static constexpr bool PERM = true, AFTER_DRAIN = false;
    const ssq_t* ssq; bf16_t* Q; bf16_t* QM; bf16_t* PK; bf16_t* PVT; bf16_t* SK; bf16_t* SVT; float* out; float qscale, mscale;
    __device__ __forceinline__ void operator()(const AccT& acc, const pg8::Unit& u, int wr, int wc, int fr, int fq) const {
        const int row0 = u.pm * 256 + wr * 64 + fr; const int ty = u.pn >> 1; const int cb = (u.pn & 1) * 256 + wc * 32 + 8 * fq;
        const bool samp = u.pm >= 256;
#pragma unroll
        for (int ai = 0; ai < 2; ++ai)
#pragma unroll
            for (int m = 0; m < 4; ++m) {
                const int row = row0 + ai * 128 + m * 16; const float r = rs_fromu(ssq[row], 1.0f / 1024.0f);
                if (ty < 2) {
                    const float s = r * (ty == 0 ? qscale : mscale); bf16_t* dst = (ty == 0 ? Q : QM) + (size_t)row * 512 + cb;
#pragma unroll
                    for (int bj = 0; bj < 2; ++bj) { f32x4 a = acc[ai][bj][m][0] * s, b = acc[ai][bj][m][1] * s; *(u32x4*)(dst + bj * 128) = pack8(a, b); }
                } else if (ty == 2) {
                    bf16_t* dst; float* fo = nullptr;
                    if (!samp) { dst = PK + (size_t)row * 512 + cb; const int t = row & 4095; if (t >= 3584) fo = out + OUT_BK + ((size_t)(row >> 12) * 512 + (t - 3584)) * 512 + cb; }
                    else { const int rs = row - MP, bs = rs >> 6, t = rs & 63; dst = SK + ((size_t)bs * 576 + 512 + t) * 512 + cb; fo = out + OUT_SK + (size_t)rs * 512 + cb; }
#pragma unroll
                    for (int bj = 0; bj < 2; ++bj) { f32x4 a = acc[ai][bj][m][0] * r, b = acc[ai][bj][m][1] * r; *(u32x4*)(dst + bj * 128) = pack8(a, b);
                        if (fo) { *(f32x4*)(fo + bj * 128) = a; *(f32x4*)(fo + bj * 128 + 4) = b; } }
                } else {
                    bf16_t* dst; size_t cst; float* fo = nullptr;
                    if (!samp) { const int b = row >> 12, t = row & 4095; dst = PVT + (size_t)b * 512 * 4096 + t; cst = 4096; if (t >= 3584) fo = out + OUT_BV + ((size_t)b * 512 + (t - 3584)) * 512 + cb; }
                    else { const int rs = row - MP, bs = rs >> 6, t = rs & 63; dst = SVT + (size_t)bs * 512 * 576 + 512 + t; cst = 576; fo = out + OUT_SV + (size_t)rs * 512 + cb; }
#pragma unroll
                    for (int bj = 0; bj < 2; ++bj) { f32x4 a = acc[ai][bj][m][0] * r, b = acc[ai][bj][m][1] * r;
#pragma unroll
                        for (int e = 0; e < 4; ++e) { dst[(size_t)(cb + bj * 128 + e) * cst] = f2bf(a[e]); dst[(size_t)(cb + bj * 128 + 4 + e) * cst] = f2bf(b[e]); }
                        if (fo) { *(f32x4*)(fo + bj * 128) = a; *(f32x4*)(fo + bj * 128 + 4) = b; } }
                }
            }
    }
};

struct EpiRes {
    static constexpr bool PERM = true, AFTER_DRAIN = false;
    bf16_t* hb; ssq_t* ssq_next;
    __device__ __forceinline__ void operator()(const AccT& acc, const pg8::Unit& u, int wr, int wc, int fr, int fq) const {
        const int row0 = u.pm * 256 + wr * 64 + fr; const int cb = u.pn * 256 + wc * 32 + 8 * fq;
#pragma unroll
        for (int ai = 0; ai < 2; ++ai)
#pragma unroll
            for (int m = 0; m < 4; ++m) {
                const int row = row0 + ai * 128 + m * 16; float ss = 0.f;
#pragma unroll
                for (int bj = 0; bj < 2; ++bj) { bf16_t* p = hb + (size_t)row * 1024 + cb + bj * 128; const u32x4 rw = *(const u32x4*)p;
                    f32x4 a, b;
                    a[0] = __builtin_bit_cast(float, rw.x << 16); a[1] = __builtin_bit_cast(float, rw.x & 0xffff0000u); a[2] = __builtin_bit_cast(float, rw.y << 16); a[3] = __builtin_bit_cast(float, rw.y & 0xffff0000u);
                    b[0] = __builtin_bit_cast(float, rw.z << 16); b[1] = __builtin_bit_cast(float, rw.z & 0xffff0000u); b[2] = __builtin_bit_cast(float, rw.w << 16); b[3] = __builtin_bit_cast(float, rw.w & 0xffff0000u);
                    a = a + acc[ai][bj][m][0]; b = b + acc[ai][bj][m][1];
                    *(u32x4*)p = pack8(a, b);
                    ss += (a[0] * a[0] + a[1] * a[1]) + (a[2] * a[2] + a[3] * a[3]) + (b[0] * b[0] + b[1] * b[1]) + (b[2] * b[2] + b[3] * b[3]); }
                ss += __shfl_xor(ss, 16); ss += __shfl_xor(ss, 32);
                if (fq == 0) atomicAdd(ssq_next + row, to_fix(ss));
            }
    }
};

struct EpiUp {
    static constexpr bool PERM = true, AFTER_DRAIN = false;
    const ssq_t* ssq; const float* cw; const float* cbias; bf16_t* ACT; float* tail; float* head;
    __device__ __forceinline__ void operator()(const AccT& acc, const pg8::Unit& u, int wr, int wc, int fr, int fq) const {
        const int f0 = u.pn * 128 + wc * 32 + 8 * fq; const int lane = fq * 16 + fr;
        const int s1 = (lane & 48) | ((fr - 1) & 15), s2 = (lane & 48) | ((fr - 2) & 15);
        f32x4 w0[2], w1[2], w2[2], bb[2];
#pragma unroll
        for (int n = 0; n < 2; ++n) { w0[n] = *(const f32x4*)(cw + f0 + 4 * n); w1[n] = *(const f32x4*)(cw + DFF + f0 + 4 * n); w2[n] = *(const f32x4*)(cw + 2 * DFF + f0 + 4 * n); bb[n] = *(const f32x4*)(cbias + f0 + 4 * n); }
#pragma unroll
        for (int ai = 0; ai < 2; ++ai) {
            const int blk = u.pm * 4 + ai * 2 + wr; const int rowb = blk * 64;
            f32x4 p1[2], p2[2];
#pragma unroll
            for (int n = 0; n < 2; ++n) { p1[n] = (f32x4){0.f, 0.f, 0.f, 0.f}; p2[n] = p1[n]; }
#pragma unroll
            for (int m = 0; m < 4; ++m) {
                const int row = rowb + 16 * m + fr; const float r = rs_fromu(ssq[row], 1.0f / 1024.0f);
                f32x4 a[2], g[2], o[2], pp[2];
#pragma unroll
                for (int n = 0; n < 2; ++n) { a[n] = acc[ai][0][m][n] * r; g[n] = acc[ai][1][m][n] * r;
                    f32x4 c1, c2;
#pragma unroll
                    for (int e = 0; e < 4; ++e) { c1[e] = __shfl(a[n][e], s1); c2[e] = __shfl(a[n][e], s2); }
                    f32x4 a1, a2;
#pragma unroll
                    for (int e = 0; e < 4; ++e) { a1[e] = fr >= 1 ? c1[e] : p1[n][e]; a2[e] = fr >= 2 ? c2[e] : p2[n][e]; }
                    p1[n] = c1; p2[n] = c2;
                    if (m == 0) {
#pragma unroll
                        for (int e = 0; e < 4; ++e) { if (fr == 0) { a1[e] = 0.f; a2[e] = 0.f; } else if (fr == 1) a2[e] = 0.f; }
                    }
                    pp[n] = bb[n] + w0[n] * a2 + w1[n] * a1 + w2[n] * a[n];
#pragma unroll
                    for (int e = 0; e < 4; ++e) o[n][e] = gelu_t(pp[n][e]) * g[n][e];
                }
                if (m == 0 && fr < 2) {
                    float* hp = head + ((size_t)(blk * 2 + fr) * 2) * DFF + f0;
                    *(f32x4*)(hp) = pp[0]; *(f32x4*)(hp + 4) = pp[1]; *(f32x4*)(hp + DFF) = g[0]; *(f32x4*)(hp + DFF + 4) = g[1];
                } else {
                    *(u32x4*)(ACT + (size_t)row * DFF + f0) = pack8(o[0], o[1]);
                }
                if (m == 3 && fr >= 14) { float* tp = tail + (size_t)(blk * 2 + (fr - 14)) * DFF + f0; *(f32x4*)(tp) = a[0]; *(f32x4*)(tp + 4) = a[1]; }
            }
        }
    }
};

struct EpiMem {
    static constexpr bool PERM = true, AFTER_DRAIN = false;
    const float* rmem; float* out; bf16_t* MEMK; bf16_t* MEMVT;
    __device__ __forceinline__ void operator()(const AccT& acc, const pg8::Unit& u, int wr, int wc, int fr, int fq) const {
        const int row0 = u.pm * 256 + wr * 64 + fr; const int l = u.pn >> 2, kv = (u.pn >> 1) & 1; const int cb = (u.pn & 1) * 256 + wc * 32 + 8 * fq;
#pragma unroll
        for (int ai = 0; ai < 2; ++ai)
#pragma unroll
            for (int m = 0; m < 4; ++m) {
                const int row = row0 + ai * 128 + m * 16; const float r = rmem[row]; const int b = row >> 8, n = row & 255;
                float* fo = out + (kv ? OUT_MV : OUT_MK) + ((size_t)l * 4096 + row) * 512 + cb;
#pragma unroll
                for (int bj = 0; bj < 2; ++bj) { f32x4 x = acc[ai][bj][m][0] * r, y = acc[ai][bj][m][1] * r;
                    *(f32x4*)(fo + bj * 128) = x; *(f32x4*)(fo + bj * 128 + 4) = y;
                    if (!kv) *(u32x4*)(MEMK + (((size_t)l * 48 + b) * 256 + n) * 512 + cb + bj * 128) = pack8(x, y);
                    else { bf16_t* d = MEMVT + (((size_t)l * 48 + b) * 512 + cb + bj * 128) * 256 + n;
#pragma unroll
                        for (int e = 0; e < 4; ++e) { d[(size_t)e * 256] = f2bf(x[e]); d[(size_t)(4 + e) * 256] = f2bf(y[e]); } } }
            }
    }
};

__device__ __forceinline__ void tr_item(const float* src, int lsrc, int k0, int n0, const float* g, bf16_t* dst, int ldd, LAS float* scr, int lane) {
    float tv[32];
#pragma unroll
    for (int i = 0; i < 32; ++i) { const int kk = 2 * i + (lane >> 5); tv[i] = src[(size_t)(k0 + kk) * lsrc + n0 + (lane & 31)]; }
#pragma unroll
    for (int i = 0; i < 32; ++i) { const int kk = 2 * i + (lane >> 5); float v = tv[i]; if (g) v *= g[k0 + kk]; scr[kk * 33 + (lane & 31)] = v; }
    asm volatile("s_waitcnt lgkmcnt(0)" ::: "memory");
    const int c = lane & 7;
#pragma unroll
    for (int j = 0; j < 4; ++j) { const int n = (lane >> 3) + 8 * j; const LAS float* s = scr + (8 * c) * 33 + n;
        u32x4 o; o.x = cvt_pk_bf16(s[0 * 33], s[1 * 33]); o.y = cvt_pk_bf16(s[2 * 33], s[3 * 33]); o.z = cvt_pk_bf16(s[4 * 33], s[5 * 33]); o.w = cvt_pk_bf16(s[6 * 33], s[7 * 33]);
        *(u32x4*)(dst + (size_t)n * ldd + k0 + 8 * c) = o; }
    asm volatile("s_waitcnt lgkmcnt(0)" ::: "memory");
}
__device__ __forceinline__ void tr_plain(const float* src, int K, int N, const float* g, bf16_t* dst, int ldd, int item, LAS float* scr, int lane) {
    const int nblk = N / 32, kb = item / nblk, nb = item % nblk;
    tr_item(src, N, kb * 64, nb * 32, g, dst + (size_t)(nb * 32) * ldd, ldd, scr, lane);
}

struct Args { const float* in[26]; float* out; unsigned char* ws; int ph_lo, ph_hi, coop, pad; };
typedef __attribute__((address_space(4))) const Args* KArgs;

__device__ __forceinline__ void p0_prologue(KArgs a, LAS unsigned char* lds, int tid) {
    const int lane = tid & 63, wave = tid >> 6; const int G = gridDim.x;
    LAS float* scr = (LAS float*)(lds + wave * 8704);
    unsigned char* ws = a->ws;
    const int gw = blockIdx.x * NWAVES + wave, NGW = G * NWAVES;
    constexpr int I_INA = 16 * 48, I_SQ = 16 * 32, I_UP = 16 * 176, I_DN = 44 * 32, I_MV = 4 * 16, I_BV = 8 * 16;
    constexpr int N_INA = 2 * I_INA, N_B = 3 * I_SQ, N_MEM = 4 * I_SQ, N_OUT = 4 * I_SQ, N_UP = 4 * I_UP, N_DN = 4 * I_DN, N_MV = 128 * I_MV, N_BV = 32 * I_BV;
    constexpr int NITEMS = N_INA + N_B + N_MEM + N_OUT + N_UP + N_DN + N_MV + N_BV;
    for (int it = gw; it < NITEMS; it += NGW) {
        int r = it;
        if (r < N_INA) { const int l = r / I_INA; r %= I_INA; tr_plain(a->in[9] + (size_t)l * 1024 * 1536, 1024, 1536, a->in[8] + l * 1024, (bf16_t*)(ws + WS_WINA) + (size_t)l * 1536 * 1024, 1024, r, scr, lane); continue; } r -= N_INA;
        if (r < N_B) { const int s = r / I_SQ; r %= I_SQ;
            const float* src = s == 1 ? a->in[14] : a->in[15] + (size_t)(s >> 1) * 1024 * 1024; const float* g = s == 1 ? a->in[13] : a->in[8] + (2 + (s >> 1)) * 1024;
            tr_plain(src, 1024, 1024, g, (bf16_t*)(ws + WS_WB) + (size_t)s * 1024 * 1024, 1024, r, scr, lane); continue; } r -= N_B;
        if (r < N_MEM) { const int l = r / I_SQ; r %= I_SQ; tr_plain(a->in[18] + (size_t)l * 1024 * 1024, 1024, 1024, a->in[17] + l * 1024, (bf16_t*)(ws + WS_WMEM) + (size_t)l * 1024 * 1024, 1024, r, scr, lane); continue; } r -= N_MEM;
        if (r < N_OUT) { const int l = r / I_SQ; r %= I_SQ; tr_plain(a->in[19] + (size_t)l * 1024 * 1024, 1024, 1024, nullptr, (bf16_t*)(ws + WS_WOUT) + (size_t)l * 1024 * 1024, 1024, r, scr, lane); continue; } r -= N_OUT;
        if (r < N_UP) { const int l = r / I_UP; r %= I_UP; const int kb = r / 176, nb = r % 176; const int s0 = nb * 32; const int bj = s0 / DFF, f = s0 % DFF; const int drow = (f >> 7) * 256 + bj * 128 + (f & 127);
            tr_item(a->in[21] + (size_t)l * 1024 * 5632, 5632, kb * 64, s0, a->in[20] + l * 1024, (bf16_t*)(ws + WS_WUP) + ((size_t)l * 5632 + drow) * 1024, 1024, scr, lane); continue; } r -= N_UP;
        if (r < N_DN) { const int l = r / I_DN; r %= I_DN; tr_plain(a->in[24] + (size_t)l * DFF * 1024, DFF, 1024, nullptr, (bf16_t*)(ws + WS_WDOWN) + (size_t)l * 1024 * DFF, DFF, r, scr, lane); continue; } r -= N_DN;
        if (r < N_MV) { const int mi = r / I_MV; r %= I_MV; const int l = mi >> 5, bs = mi & 31;
            tr_plain(a->in[4] + (size_t)mi * 256 * 512, 256, 512, nullptr, (bf16_t*)(ws + WS_MEMVT) + ((size_t)l * 48 + 16 + bs) * 512 * 256, 256, r, scr, lane); continue; } r -= N_MV;
        { const int bs = r / I_BV; r %= I_BV; tr_plain(a->in[6] + (size_t)bs * 512 * 512, 512, 512, nullptr, (bf16_t*)(ws + WS_SVT) + (size_t)bs * 512 * 576, 576, r, scr, lane); }
    }
    for (int m0 = gw; m0 < MT + 4096; m0 += 2 * NGW) {
        f32x4 v[2][4]; float sq[2];
#pragma unroll
        for (int u = 0; u < 2; ++u) { const int m = m0 + u * NGW; if (m < MT + 4096) {
            const bool ismem = m >= MT; const int rr = ismem ? m - MT : m;
            const float* xr = ismem ? a->in[2] + (size_t)rr * 1024 : (rr < MP ? a->in[0] + (size_t)rr * 1024 : a->in[1] + (size_t)(rr - MP) * 1024);
#pragma unroll
            for (int j = 0; j < 4; ++j) v[u][j] = *((const f32x4*)xr + lane + 64 * j); } }
#pragma unroll
        for (int u = 0; u < 2; ++u) { const int m = m0 + u * NGW; if (m < MT + 4096) {
            const bool ismem = m >= MT; const int rr = ismem ? m - MT : m;
            bf16_t* orow = (bf16_t*)(ws + (ismem ? WS_MPB : WS_HB)) + (size_t)rr * 1024;
            float s = 0.f;
#pragma unroll
            for (int j = 0; j < 4; ++j) s += (v[u][j][0] * v[u][j][0] + v[u][j][1] * v[u][j][1]) + (v[u][j][2] * v[u][j][2] + v[u][j][3] * v[u][j][3]);
            s = wave_sum(s); sq[u] = s;
#pragma unroll
            for (int j = 0; j < 4; ++j) { u32x2 o; o.x = cvt_pk_bf16(v[u][j][0], v[u][j][1]); o.y = cvt_pk_bf16(v[u][j][2], v[u][j][3]); *((u32x2*)orow + lane + 64 * j) = o; }
            if (lane == 0) { if (ismem) ((float*)(ws + WS_RMEM))[rr] = rs_from(sq[u], 1.0f / 1024.0f); else ((ssq_t*)(ws + WS_SSQ))[rr] = to_fix(sq[u]); } } }
    }
    const size_t gt = (size_t)blockIdx.x * NTHR + tid, NT = (size_t)G * NTHR;
    { ssq_t* z = (ssq_t*)(ws + WS_SSQ) + MT; for (size_t i = gt; i < (size_t)10 * MT; i += NT) z[i] = 0ull; }
    { bf16_t* wsb = (bf16_t*)(ws + WS_WSB); const float* w = a->in[11];
      for (size_t i = gt; i < (size_t)2 * 8 * 128 * 128; i += NT) { const int jj = (int)(i & 127), ii = (int)((i >> 7) & 127); wsb[i] = jj <= ii ? f2bf(w[i]) : (unsigned short)0; } }
    {
      const f32x4* src = (const f32x4*)a->in[3]; bf16_t* dst = (bf16_t*)(ws + WS_MEMK);
      for (size_t i = gt; i < (size_t)4 * 32 * 256 * 512 / 4; i += NT) { const size_t e = i * 4; const size_t mi = e / (256 * 512), rem = e % (256 * 512); const size_t l = mi >> 5, bs = mi & 31;
          const f32x4 v = src[i]; u32x2 o; o.x = cvt_pk_bf16(v[0], v[1]); o.y = cvt_pk_bf16(v[2], v[3]); *(u32x2*)(dst + ((l * 48 + 16 + bs) * 256 * 512) + rem) = o; } }
    {
      const f32x4* src = (const f32x4*)a->in[5]; bf16_t* dst = (bf16_t*)(ws + WS_SK);
      for (size_t i = gt; i < (size_t)32 * 512 * 512 / 4; i += NT) { const size_t e = i * 4; const size_t bs = e / (512 * 512), rem = e % (512 * 512);
          const f32x4 v = src[i]; u32x2 o; o.x = cvt_pk_bf16(v[0], v[1]); o.y = cvt_pk_bf16(v[2], v[3]); *(u32x2*)(dst + bs * 576 * 512 + rem) = o; } }
}

#ifndef REP_MEM
#define REP_MEM 1
#endif
#ifndef REP_GATE
#define REP_GATE 1
#endif
#ifndef REP_BAND
#define REP_BAND 1
#endif
__device__ __forceinline__ void gate_unit(LAS unsigned char* lds, int tid, int chunk, int joff, int nib, int row0,
                                          const bf16_t* wsb, const bf16_t* VT, const bf16_t* U, const ssq_t* ssqv, const float* gv, const float* bs, bf16_t* CAT, float* av_out) {
    const int g = tid >> 6, lane = tid & 63, l32 = lane & 31, half = lane >> 5;
    LAS float* rv = (LAS float*)lds;
    __syncthreads();
    if (tid < nib * 32) rv[tid] = rs_fromu(ssqv[row0 + tid], 1.0f / 512.0f);
    __syncthreads();
    const bf16_t* vt_g = VT + ((size_t)chunk * 512 + g * 64) * 128 + joff;
    const bf16_t* w_g = wsb + (size_t)g * 128 * 128;
#pragma unroll 1
    for (int db = 0; db < 2; ++db) {
        f32x16 acc[4];
#pragma unroll
        for (int i = 0; i < 4; ++i)
#pragma unroll
            for (int e = 0; e < 16; ++e) acc[i][e] = 0.f;
        const bf16_t* vt_d = vt_g + (size_t)(db * 32 + l32) * 128 + half * 8;
        const bf16_t* w_d = w_g + (size_t)l32 * 128 + half * 8;
#pragma unroll
        for (int ks = 0; ks < 8; ++ks) {
            if (ks < nib * 2) {
                const int j0 = ks * 16 + half * 8;
                const u32x4 raw = *(const u32x4*)(vt_d + ks * 16);
                u32x4 sc;
#pragma unroll
                for (int q = 0; q < 4; ++q) { const float lo = __builtin_bit_cast(float, raw[q] << 16) * rv[j0 + 2 * q], hi = __builtin_bit_cast(float, raw[q] & 0xffff0000u) * rv[j0 + 2 * q + 1]; sc[q] = cvt_pk_bf16(lo, hi); }
                const bf16x8 bfr = __builtin_bit_cast(bf16x8, sc);
#pragma unroll
                for (int ib = 0; ib < 4; ++ib) {
                    if (ib < nib && ks < (ib + 1) * 2) {
                        const bf16x8 af = *(const bf16x8*)(w_d + ib * 32 * 128 + ks * 16);
                        acc[ib] = MFMA32(af, bfr, acc[ib]);
                    }
                }
            }
        }
        const int c = g * 64 + db * 32 + l32; const float gvc = gv[c];
        const bf16_t* ub = U + ((size_t)row0 + 4 * half) * 512 + c; bf16_t* cbp = CAT + ((size_t)row0 + 4 * half) * 1024 + c; const float* bsp = bs + g * 128 + 4 * half;
#pragma unroll
        for (int ib = 0; ib < 4; ++ib) {
            if (ib < nib) {
#pragma unroll
                for (int e = 0; e < 16; ++e) { const int i = ib * 32 + (e & 3) + 8 * (e >> 2);
                    const float s = acc[ib][e] * gvc + bsp[i];
                    cbp[(size_t)i * 1024] = f2bf(bf2f(ub[(size_t)i * 512]) * s); }
            }
        }
    }
    if (av_out) {
        for (int e = tid; e < 64 * 512; e += NTHR) { const int t = e >> 9, c = e & 511; av_out[e] = bf2f(VT[((size_t)chunk * 512 + c) * 128 + joff + t]) * rv[t] * gv[c]; }
    }
}

template <int D, bool BAND>
__device__ __forceinline__ void attn_unit(LAS unsigned char* lds, int tid, const bf16_t* Qw, bool hasq, const bf16_t* Kb, int ldk, const bf16_t* Vtb, int ldv,
                                          int jstart, int nkb, int jlo, int jhi, bf16_t* Ow, LAS const float* btab, int relq) {
    constexpr int KROW = (D + 8) * 2, VROW = 144, KBYTES = 64 * KROW, VBYTES = D * VROW, BUF = KBYTES + VBYTES, STAGE = 2 * BUF, NR = D / 64, KK = D / 16, DB = D / 32;
    const int lane = tid & 63, l32 = lane & 31, half = lane >> 5;
    bf16x8 qf[KK];
#pragma unroll
    for (int kk = 0; kk < KK; ++kk) qf[kk] = hasq ? *(const bf16x8*)(Qw + (size_t)l32 * 512 + kk * 16 + half * 8) : (bf16x8){0, 0, 0, 0, 0, 0, 0, 0};
    f32x16 O[DB];
#pragma unroll
    for (int d = 0; d < DB; ++d)
#pragma unroll
        for (int e = 0; e < 16; ++e) O[d][e] = 0.f;
    float mrun = -1e30f, lsum = 0.f;
    u32x4 kreg[2][NR], vreg[2][NR];
#define ATT_GLOAD(st) do { _Pragma("unroll") for (int bk = 0; bk < 2; ++bk) { const int j_ = 2 * (st) + bk; _Pragma("unroll") for (int i = 0; i < NR; ++i) { const int id = tid + i * NTHR; const int kr = id / (D / 8), kc = id % (D / 8); \
        kreg[bk][i] = *(const u32x4*)(Kb + (long)(j_ * 64 + kr) * ldk + kc * 8); const int vr = id >> 3, vc = id & 7; vreg[bk][i] = *(const u32x4*)(Vtb + (long)vr * ldv + j_ * 64 + vc * 8); } } } while (0)
#define ATT_LSTORE(buf) do { _Pragma("unroll") for (int bk = 0; bk < 2; ++bk) { LAS unsigned char* b_ = lds + (buf) * STAGE + bk * BUF; _Pragma("unroll") for (int i = 0; i < NR; ++i) { const int id = tid + i * NTHR; const int kr = id / (D / 8), kc = id % (D / 8); \
        *(LAS u32x4*)(b_ + kr * KROW + kc * 16) = kreg[bk][i]; const int vr = id >> 3, vc = id & 7; *(LAS u32x4*)(b_ + KBYTES + vr * VROW + vc * 16) = vreg[bk][i]; } } } while (0)
    const int st0 = jstart >> 1, nst = (nkb + 1) >> 1;
    __syncthreads();
    ATT_GLOAD(st0); ATT_LSTORE(0);
    __syncthreads();
    for (int st = st0; st < nst; ++st) {
        const int cur = (st - st0) & 1;
        if (st + 1 < nst) ATT_GLOAD(st + 1);
#pragma unroll
        for (int bk = 0; bk < 2; ++bk) {
            const int j = 2 * st + bk;
            if (hasq && j >= jlo && j <= jhi) {
                const LAS unsigned char* b = lds + cur * STAGE + bk * BUF;
                f32x16 S[2];
#pragma unroll
                for (int s = 0; s < 2; ++s) {
#pragma unroll
                    for (int e = 0; e < 16; ++e) S[s][e] = 0.f;
#pragma unroll
                    for (int kk = 0; kk < KK; ++kk) { const bf16x8 af = *(const LAS bf16x8*)(b + (s * 32 + l32) * KROW + (kk * 16 + half * 8) * 2); S[s] = MFMA32(af, qf[kk], S[s]); }
                }
                if (BAND) {
                    if (j <= jlo + 3) {
                        const float cbias = btab[319];
#pragma unroll
                        for (int s = 0; s < 2; ++s)
#pragma unroll
                            for (int e = 0; e < 16; ++e) S[s][e] += cbias;
                    } else {
#pragma unroll
                        for (int s = 0; s < 2; ++s)
#pragma unroll
                            for (int e = 0; e < 16; ++e) { const int kidx = j * 64 + s * 32 + crow(e, half); int rel = relq - kidx; rel = rel > 256 ? 256 : rel; S[s][e] += btab[rel + 63]; }
                    }
                }
                float mx = S[0][0];
#pragma unroll
                for (int e = 1; e < 16; ++e) mx = fmaxf(mx, S[0][e]);
#pragma unroll
                for (int e = 0; e < 16; ++e) mx = fmaxf(mx, S[1][e]);
                mx = fmaxf(mx, __shfl_xor(mx, 32));
                const float mnew = fmaxf(mrun, mx); const float alpha = __builtin_amdgcn_exp2f(mrun - mnew); mrun = mnew;
                float ps = 0.f;
#pragma unroll
                for (int s = 0; s < 2; ++s)
#pragma unroll
                    for (int e = 0; e < 16; ++e) { const float p = __builtin_amdgcn_exp2f(S[s][e] - mnew); S[s][e] = p; ps += p; }
                lsum = lsum * alpha + ps;
#pragma unroll
                for (int d = 0; d < DB; ++d)
#pragma unroll
                    for (int e = 0; e < 16; ++e) O[d][e] *= alpha;
#pragma unroll
                for (int s = 0; s < 2; ++s)
#pragma unroll
                    for (int t = 0; t < 2; ++t) {
                        u32x4 pk;
#pragma unroll
                        for (int q = 0; q < 4; ++q) pk[q] = cvt_pk_bf16(S[s][8 * t + 2 * q], S[s][8 * t + 2 * q + 1]);
                        const bf16x8 pb = __builtin_bit_cast(bf16x8, pk);
#pragma unroll
                        for (int d = 0; d < DB; ++d) {
                            const LAS unsigned char* vp = b + KBYTES + (d * 32 + l32) * VROW + (s * 32 + 16 * t + 4 * half) * 2;
                            const u32x2 v0 = *(const LAS u32x2*)vp, v1 = *(const LAS u32x2*)(vp + 16);
                            const u32x4 vv = {v0.x, v0.y, v1.x, v1.y};
                            O[d] = MFMA32(__builtin_bit_cast(bf16x8, vv), pb, O[d]);
                        }
                    }
            }
        }
        if (st + 1 < nst) ATT_LSTORE(cur ^ 1);
        __syncthreads();
    }
#undef ATT_GLOAD
#undef ATT_LSTORE
    if (hasq) {
        const float l = lsum + __shfl_xor(lsum, 32); const float inv = 1.0f / l;
#pragma unroll
        for (int d = 0; d < DB; ++d)
#pragma unroll
            for (int gq = 0; gq < 4; ++gq) {
                u32x2 o; o.x = cvt_pk_bf16(O[d][4 * gq] * inv, O[d][4 * gq + 1] * inv); o.y = cvt_pk_bf16(O[d][4 * gq + 2] * inv, O[d][4 * gq + 3] * inv);
                *(u32x2*)(Ow + (size_t)l32 * 1024 + d * 32 + 8 * gq + 4 * half) = o;
            }
    }
}

__device__ __forceinline__ void mixer_phase(KArgs a, LAS unsigned char* lds, int tid_in, int l) {
    unsigned char* ws = a->ws; const int G = gridDim.x;
    bf16_t* CAT = (bf16_t*)(ws + WS_CAT);
    constexpr int N_MEMP = 16 * 16 * 4, N_MEMS = 32 * 4;
#ifndef NO_MEMATT
    {
        int tid = tid_in; asm volatile("" : "+v"(tid)); const int wave = tid >> 6;
        const bf16_t* QM = (const bf16_t*)(ws + WS_QM);
        for (int it = blockIdx.x; it < REP_MEM * (N_MEMP + N_MEMS); it += G) {
            int r = it % (N_MEMP + N_MEMS); int bb, h, q0, nq;
            if (r < N_MEMP) { h = r & 3; const int qb = (r >> 2) & 15; bb = r >> 6; q0 = bb * SEQ + qb * 256; nq = 256; }
            else { r -= N_MEMP; h = r & 3; const int bs = r >> 2; bb = 16 + bs; q0 = MP + bs * 64; nq = 64; }
            const bool hasq = wave * 32 < nq; const int qrow = q0 + wave * 32;
            attn_unit<128, false>(lds, tid, QM + (size_t)qrow * 512 + h * 128, hasq, (const bf16_t*)(ws + WS_MEMK) + ((size_t)l * 48 + bb) * 256 * 512 + h * 128, 512,
                                  (const bf16_t*)(ws + WS_MEMVT) + (((size_t)l * 48 + bb) * 512 + h * 128) * 256, 256, 0, 4, 0, 3, CAT + (size_t)qrow * 1024 + 512 + h * 128, nullptr, 0);
        }
    }
#endif
    if (l < 2) {
#ifndef NO_GATE
        int tid = tid_in; asm volatile("" : "+v"(tid));
        for (int r_ = blockIdx.x; r_ < REP_GATE * (512 + 32); r_ += G) { const int r = r_ % (512 + 32);
            int chunk, joff, nib, row0; float* av = nullptr;
            if (r < 512) { chunk = r; joff = 0; nib = 4; row0 = r * 128; }
            else { const int bs = r - 512; chunk = 512 + (bs >> 1); joff = (bs & 1) * 64; nib = 2; row0 = MP + bs * 64; av = a->out + OUT_AV + ((size_t)l * 32 + bs) * 64 * 512; }
            gate_unit(lds, tid, chunk, joff, nib, row0, (const bf16_t*)(ws + WS_WSB) + (size_t)l * 8 * 128 * 128, (const bf16_t*)(ws + WS_VT), (const bf16_t*)(ws + WS_U),
                      (const ssq_t*)(ws + WS_SSQ) + (size_t)(9 + l) * MT, a->in[10] + l * 512, a->in[12] + l * 8 * 128, CAT, av);
        }
#endif
    } else {
#ifndef NO_BAND
        int tid = tid_in; asm volatile("" : "+v"(tid)); const int wave = tid >> 6;
        const int jl = l - 2; const bf16_t* Q = (const bf16_t*)(ws + WS_U);
        LAS float* btab = (LAS float*)(lds + 76800);
        for (int it = blockIdx.x; it < REP_BAND * (16 * 8 * 16 + 32 * 8); it += G) {
            int r = it % (16 * 8 * 16 + 32 * 8);
            int h, qrow, jstart, nkb, jlo, jhi, relq; const bf16_t* Kb; const bf16_t* Vtb; int ldv; bool hasq;
            if (r < 16 * 8 * 16) { h = r & 7; const int cg4 = (r >> 3) & 15; const int b = r >> 7; const int c0 = cg4 * 4;
                qrow = b * SEQ + c0 * 64 + wave * 32; hasq = true; nkb = 12; jstart = c0 >= 8 ? 0 : 8 - c0; jlo = wave >> 1; jhi = jlo + 8;
                Kb = (const bf16_t*)(ws + WS_PK) + ((long)b * SEQ + (long)(c0 - 8) * 64) * 512 + h * 64;
                Vtb = (const bf16_t*)(ws + WS_PVT) + ((long)b * 512 + h * 64) * 4096 + (long)(c0 - 8) * 64; ldv = 4096;
                relq = 512 + (wave >> 1) * 64 + (wave & 1) * 32 + (tid & 31); }
            else { r -= 16 * 8 * 16; h = r & 7; const int bs = r >> 3; qrow = MP + bs * 64 + wave * 32; hasq = wave < 2; nkb = 9; jstart = 0; jlo = 0; jhi = 8;
                Kb = (const bf16_t*)(ws + WS_SK) + (size_t)bs * 576 * 512 + h * 64; Vtb = (const bf16_t*)(ws + WS_SVT) + ((size_t)bs * 512 + h * 64) * 576; ldv = 576;
                relq = 512 + (wave & 1) * 32 + (tid & 31); }
            __syncthreads();
            if (tid < 320) btab[tid] = a->in[16][((size_t)jl * 8 + h) * 513 + 193 + tid] * LOG2E;
            attn_unit<64, true>(lds, tid, Q + (size_t)qrow * 512 + h * 64, hasq, Kb, 512, Vtb, ldv, jstart, nkb, jlo, jhi, CAT + (size_t)qrow * 1024 + h * 64, btab, relq);
        }
#endif
    }
}

__device__ __forceinline__ void fixup_phase(KArgs a, int tid, int l) {
    unsigned char* ws = a->ws; const float* tail = (const float*)(ws + WS_TAIL); const float* head = (const float*)(ws + WS_HEAD); bf16_t* ACT = (bf16_t*)(ws + WS_ACT);
    const float* cw = a->in[22] + (size_t)l * 3 * DFF; const float* sc = a->in[7] + (size_t)l * 32 * 2 * DFF;
    const size_t gt = (size_t)blockIdx.x * NTHR + tid, NT = (size_t)gridDim.x * NTHR;
    constexpr int FV = DFF / 4;
    for (size_t i = gt; i < (size_t)NBLK64 * FV; i += NT) {
        const int blk = (int)(i / FV), f = (int)(i % FV) * 4;
        f32x4 pm2, pm1;
        if (blk >= MP / 64) { const int bs = blk - MP / 64; pm2 = *(const f32x4*)(sc + ((size_t)bs * 2 + 0) * DFF + f); pm1 = *(const f32x4*)(sc + ((size_t)bs * 2 + 1) * DFF + f); }
        else if ((blk & 63) == 0) { pm2 = (f32x4){0.f, 0.f, 0.f, 0.f}; pm1 = pm2; }
        else { pm2 = *(const f32x4*)(tail + ((size_t)(blk - 1) * 2 + 0) * DFF + f); pm1 = *(const f32x4*)(tail + ((size_t)(blk - 1) * 2 + 1) * DFF + f); }
        const f32x4 w0 = *(const f32x4*)(cw + f), w1 = *(const f32x4*)(cw + DFF + f);
        const float* hp = head + (size_t)blk * 4 * DFF + f;
        const f32x4 c0 = *(const f32x4*)hp + w0 * pm2 + w1 * pm1, g0 = *(const f32x4*)(hp + DFF), c1 = *(const f32x4*)(hp + 2 * DFF) + w0 * pm1, g1 = *(const f32x4*)(hp + 3 * DFF);
        u32x2 o0, o1;
        o0.x = cvt_pk_bf16(gelu_t(c0[0]) * g0[0], gelu_t(c0[1]) * g0[1]); o0.y = cvt_pk_bf16(gelu_t(c0[2]) * g0[2], gelu_t(c0[3]) * g0[3]);
        o1.x = cvt_pk_bf16(gelu_t(c1[0]) * g1[0], gelu_t(c1[1]) * g1[1]); o1.y = cvt_pk_bf16(gelu_t(c1[2]) * g1[2], gelu_t(c1[3]) * g1[3]);
        *(u32x2*)(ACT + (size_t)blk * 64 * DFF + f) = o0; *(u32x2*)(ACT + ((size_t)blk * 64 + 1) * DFF + f) = o1;
        if (blk >= MP / 64 || (blk & 63) == 63) {
            const f32x4 t0 = *(const f32x4*)(tail + ((size_t)blk * 2 + 0) * DFF + f), t1 = *(const f32x4*)(tail + ((size_t)blk * 2 + 1) * DFF + f);
            float* o = (blk >= MP / 64) ? a->out + OUT_CS + ((size_t)l * 32 + (blk - MP / 64)) * 2 * DFF + f : a->out + OUT_CP + ((size_t)l * 16 + (blk >> 6)) * 2 * DFF + f;
            *(f32x4*)o = t0; *(f32x4*)(o + DFF) = t1;
        }
    }
}

__device__ __forceinline__ void final_phase(KArgs a, int tid) {
    const ssq_t* ssq = (const ssq_t*)(a->ws + WS_SSQ) + (size_t)4 * MT; const float* g = a->in[25]; const bf16_t* hb = (const bf16_t*)(a->ws + WS_HB);
    const int lane = tid & 63; const int gw = blockIdx.x * NWAVES + (tid >> 6), NGW = gridDim.x * NWAVES;
    f32x4 gg[4];
#pragma unroll
    for (int j = 0; j < 4; ++j) gg[j] = *((const f32x4*)g + lane + 64 * j);
    for (int m0 = gw; m0 < MT; m0 += 2 * NGW) {
        u32x2 w[2][4]; float r[2];
#pragma unroll
        for (int u = 0; u < 2; ++u) { const int m = m0 + u * NGW; if (m < MT) { r[u] = rs_fromu(ssq[m], 1.0f / 1024.0f); const u32x2* hr = (const u32x2*)(hb + (size_t)m * 1024);
#pragma unroll
            for (int j = 0; j < 4; ++j) w[u][j] = hr[lane + 64 * j]; } }
#pragma unroll
        for (int u = 0; u < 2; ++u) { const int m = m0 + u * NGW; if (m < MT) { f32x4* row = (f32x4*)(a->out + (size_t)m * 1024);
#pragma unroll
            for (int j = 0; j < 4; ++j) { f32x4 v; v[0] = __builtin_bit_cast(float, w[u][j].x << 16); v[1] = __builtin_bit_cast(float, w[u][j].x & 0xffff0000u); v[2] = __builtin_bit_cast(float, w[u][j].y << 16); v[3] = __builtin_bit_cast(float, w[u][j].y & 0xffff0000u);
                row[lane + 64 * j] = v * r[u] * gg[j]; } } }
    }
}


#define XB_TMO      128
#define XB_XCNT(j)  (256  + 64 * (j))
#define XB_XSUB(j)  (1280 + 64 * (j))
#define XB_XGEN(j)  (2304 + 64 * (j))
#define XB_TOP      3328
#define XB_TOPGEN   3392
#define XCD_BAR_WORDS 3456
#define XB_SPIN_CAP (1u << 18)

__device__ __forceinline__ unsigned xb_ld(unsigned* p)              { return __hip_atomic_load(p, __ATOMIC_RELAXED, __HIP_MEMORY_SCOPE_AGENT); }
__device__ __forceinline__ unsigned xb_add(unsigned* p, unsigned v) { return __hip_atomic_fetch_add(p, v, __ATOMIC_RELAXED, __HIP_MEMORY_SCOPE_AGENT); }
__device__ __forceinline__ unsigned xb_xcc_id() { return (unsigned)__builtin_amdgcn_s_getreg((3 << 11) | 20) & 0xFu; }
#define XB_SPIN(cond, bar) do { unsigned _sp = 0; while (cond) { __builtin_amdgcn_s_sleep(1); \
    if ((++_sp & 255u) == 0u) { if (xb_ld(&(bar)[XB_TMO])) break; if (_sp > XB_SPIN_CAP) { atomicAdd(&(bar)[XB_TMO], 1u); break; } } } } while (0)

struct XcdBarrier {
    unsigned* bar; unsigned x;
    volatile LAS unsigned* st;
};

__device__ __forceinline__ XcdBarrier xcd_barrier_post(unsigned* bar, volatile LAS unsigned* st) {
    XcdBarrier b; b.bar = bar; b.x = xb_xcc_id(); b.st = st;
    if (threadIdx.x == 0) (void)xb_add(&bar[XB_XCNT(b.x)], 1u);
    return b;
}
__device__ __forceinline__ void xcd_barrier_complete(unsigned* bar, unsigned x, unsigned& nloc, unsigned& nx) {
    const unsigned G = gridDim.x * gridDim.y * gridDim.z;
    unsigned sum, cnt, mine, sp = 0u;
    for (;;) {
        sum = 0u; cnt = 0u; mine = 0u;
#pragma unroll
        for (unsigned j = 0; j < 16; ++j) { const unsigned c = xb_ld(&bar[XB_XCNT(j)]); sum += c; cnt += (c > 0u) ? 1u : 0u; mine = (j == x) ? c : mine; }
        if (sum == G) break;
        __builtin_amdgcn_s_sleep(1);
        if ((++sp & 255u) == 0u) { if (xb_ld(&bar[XB_TMO])) break; if (sp > XB_SPIN_CAP) { atomicAdd(&bar[XB_TMO], 1u); break; } }
    }
    nloc = mine > 0u ? mine : 1u; nx = cnt > 0u ? cnt : 1u;
}

__device__ __forceinline__ void xcd_barrier(const XcdBarrier& b) {
    asm volatile("s_waitcnt vmcnt(0)" ::: "memory");
    __syncthreads();
    if (threadIdx.x == 0) {
        unsigned* bar = b.bar;
        __builtin_amdgcn_s_waitcnt(0);
        unsigned nloc = b.st[0], nx = b.st[1];
        if (nloc == 0u) { xcd_barrier_complete(bar, b.x, nloc, nx); b.st[0] = nloc; b.st[1] = nx; }
        const unsigned old = xb_add(&bar[XB_XSUB(b.x)], 1u);
        const unsigned gen = old / nloc;
        if (old + 1u == (gen + 1u) * nloc) {
            __builtin_amdgcn_fence(__ATOMIC_RELEASE, "agent");
            asm volatile("s_waitcnt vmcnt(0)" ::: "memory");
            const unsigned og = xb_add(&bar[XB_TOP], 1u);
            const unsigned tg = og / nx;
            if (og + 1u == (tg + 1u) * nx) xb_add(&bar[XB_TOPGEN], 1u);
            else XB_SPIN(xb_ld(&bar[XB_TOPGEN]) == tg, bar);
            __builtin_amdgcn_fence(__ATOMIC_ACQUIRE, "agent");
            xb_add(&bar[XB_XGEN(b.x)], 1u);
            asm volatile("s_waitcnt vmcnt(0)" ::: "memory");
        } else {
            XB_SPIN(xb_ld(&bar[XB_XGEN(b.x)]) == gen, bar);
            __builtin_amdgcn_fence(__ATOMIC_ACQUIRE, "agent");
            asm volatile("s_waitcnt vmcnt(0)" ::: "memory");
        }
    }
    __syncthreads();
}

#ifndef REP_P0
#define REP_P0 1
#endif
#ifndef REP_MIX
#define REP_MIX 1
#endif
#ifndef REP_UP
#define REP_UP 1
#endif
#ifndef REP_FIX
#define REP_FIX 1
#endif
#ifndef REP_G
#define REP_G 1
#endif
__device__ __forceinline__ void launder(int& t) { asm volatile("" : "+v"(t)); }
__global__ void __launch_bounds__(NTHR, 2) fwd_kernel(Args a) {
    extern __shared__ __attribute__((aligned(16))) unsigned char lds_raw[];
    LAS unsigned char* lds = (LAS unsigned char*)lds_raw;
    int tid = threadIdx.x; const int G = gridDim.x;
    KArgs kp = (KArgs)__builtin_amdgcn_kernarg_segment_ptr();
    volatile LAS unsigned* bst = (volatile LAS unsigned*)(lds + LDS_BYTES - 64);
    if (tid < 2) bst[tid] = 0u;
    __syncthreads();
    XcdBarrier bar; bar.bar = (unsigned*)(a.ws + WS_BAR); bar.x = 0; bar.st = bst;
    if (a.coop) bar = xcd_barrier_post((unsigned*)(a.ws + WS_BAR), bst);
#define PH_ARGS() KArgs q = kp; asm volatile("" : "+s"(q)); unsigned char* ws = q->ws; ssq_t* ssqb = (ssq_t*)(ws + WS_SSQ); bf16_t* HB = (bf16_t*)(ws + WS_HB); (void)ssqb; (void)HB;
    int ph = 0;
#ifndef REP_SYNC
#define REP_SYNC 1
#endif
#define SEAM() do { if (a.coop && ph + 1 < a.ph_hi) { for (int rs_ = 0; rs_ < REP_SYNC; ++rs_) { if (a.coop == 2) cg::this_grid().sync(); else xcd_barrier(bar); } } } while (0)
#define IN_PH() (launder(tid), ph >= a.ph_lo && ph < a.ph_hi)
#ifndef EN_MASK
#define EN_MASK 0xffff
#endif
#define EN(k) ((EN_MASK >> (k)) & 1)

    if (IN_PH()) { PH_ARGS(); for (int rep = 0; rep < REP_P0; ++rep) p0_prologue(q, lds, tid); SEAM(); } ++ph;

#pragma unroll 1
    for (int l = 0; l < 4; ++l) {
        if (IN_PH()) { PH_ARGS();
            if (l < 2) { if (EN(1)) {
                pg8::Gemm g{HB, (const bf16_t*)(ws + WS_WINA) + (size_t)l * 1536 * 1024, MT, 1536, 1024}; pg8::StaticOrder S; S.init(MT, 1536, G, (int)blockIdx.x);
                EpiInA E{ssqb + (size_t)l * MT, (bf16_t*)(ws + WS_U), (bf16_t*)(ws + WS_VT), (bf16_t*)(ws + WS_QM), ssqb + (size_t)(9 + l) * MT, 0.08838834764831845f * LOG2E};
                S.rep = REP_G; pg8::gemm_phase<EpiInA, pg8::StaticOrder, true, true>(lds, g, S, E, tid); }
                if (EN(2) && l == 0) {
                    pg8::Gemm g2{(const bf16_t*)(ws + WS_MPB), (const bf16_t*)(ws + WS_WMEM), 4096, 4096, 1024}; pg8::StaticOrder S2; S2.init(4096, 4096, G, (int)blockIdx.x);
                    EpiMem E2{(const float*)(ws + WS_RMEM), q->out, (bf16_t*)(ws + WS_MEMK), (bf16_t*)(ws + WS_MEMVT)};
                    pg8::gemm_phase<EpiMem, pg8::StaticOrder, true, true>(lds, g2, S2, E2, tid);
                }
            } else if (EN(3)) {
                const int N = l == 2 ? 2048 : 1024;
                pg8::Gemm g{HB, (const bf16_t*)(ws + WS_WB) + (size_t)(l == 2 ? 0 : 2048) * 1024, MT, N, 1024}; pg8::StaticOrder S; S.init(MT, N, G, (int)blockIdx.x);
                EpiInB E{ssqb + (size_t)l * MT, (bf16_t*)(ws + WS_U), (bf16_t*)(ws + WS_QM), (bf16_t*)(ws + WS_PK), (bf16_t*)(ws + WS_PVT), (bf16_t*)(ws + WS_SK), (bf16_t*)(ws + WS_SVT), q->out,
                         0.125f * LOG2E, 0.08838834764831845f * LOG2E};
                S.rep = REP_G; pg8::gemm_phase<EpiInB, pg8::StaticOrder, true, true>(lds, g, S, E, tid);
            }
            SEAM();
        } ++ph;
        if (IN_PH()) { PH_ARGS(); for (int rep = 0; rep < REP_MIX; ++rep) mixer_phase(q, lds, tid, l); SEAM(); } ++ph;
        if (IN_PH()) { PH_ARGS(); if (EN(5)) {
            pg8::Gemm g{(const bf16_t*)(ws + WS_CAT), (const bf16_t*)(ws + WS_WOUT) + (size_t)l * 1024 * 1024, MT, 1024, 1024}; pg8::StaticOrder S; S.init(MT, 1024, G, (int)blockIdx.x);
            EpiRes E{HB, ssqb + (size_t)(5 + l) * MT};
            S.rep = REP_G; pg8::gemm_phase<EpiRes, pg8::StaticOrder, true, true>(lds, g, S, E, tid); }
            SEAM();
        } ++ph;
        if (IN_PH()) { PH_ARGS(); if (EN(6)) {
            pg8::Gemm g{HB, (const bf16_t*)(ws + WS_WUP) + (size_t)l * 5632 * 1024, MT, 5632, 1024}; pg8::StaticOrder S; S.init(MT, 5632, G, (int)blockIdx.x);
            EpiUp E{ssqb + (size_t)(5 + l) * MT, q->in[22] + (size_t)l * 3 * DFF, q->in[23] + (size_t)l * DFF, (bf16_t*)(ws + WS_ACT), (float*)(ws + WS_TAIL), (float*)(ws + WS_HEAD)};
            S.rep = REP_UP; pg8::gemm_phase<EpiUp, pg8::StaticOrder, true, true>(lds, g, S, E, tid); }
            SEAM();
        } ++ph;
        if (IN_PH()) { PH_ARGS(); for (int rep = 0; rep < REP_FIX; ++rep) fixup_phase(q, tid, l); SEAM(); } ++ph;
        if (IN_PH()) { PH_ARGS(); if (EN(8)) {
            pg8::Gemm g{(const bf16_t*)(ws + WS_ACT), (const bf16_t*)(ws + WS_WDOWN) + (size_t)l * 1024 * DFF, MT, 1024, DFF}; pg8::StaticOrder S; S.init(MT, 1024, G, (int)blockIdx.x);
            EpiRes E{HB, ssqb + (size_t)(l + 1) * MT};
            S.rep = REP_G; pg8::gemm_phase<EpiRes, pg8::StaticOrder, true, true>(lds, g, S, E, tid); }
            SEAM();
        } ++ph;
    }
    if (IN_PH()) { PH_ARGS(); for (int rep = 0; rep < REP_FIX; ++rep) final_phase(q, tid); } ++ph;
#undef SEAM
#undef IN_PH
}
constexpr int N_PHASES = 26;

#ifndef MK_MULTI
#define MK_MULTI 0
#endif

extern "C" void kernel_launch(void* const* d_in, const int* in_sizes, int n_in, void* d_out, int out_size, void* d_ws, size_t ws_size, hipStream_t stream) {
    static int grid = 0;
    if (grid == 0) {
        if (n_in != 26 || (size_t)out_size != OUT_END || ws_size < WS_END) { fprintf(stderr, "kernel_launch: unexpected sizes n_in %d out %d ws %zu (need %zu)\n", n_in, out_size, ws_size, (size_t)WS_END); grid = -1; return; }
        int dev = 0, cus = 0, per_cu = 0;
        if (hipGetDevice(&dev) != hipSuccess || hipDeviceGetAttribute(&cus, hipDeviceAttributeMultiprocessorCount, dev) != hipSuccess) { grid = -1; return; }
        if (hipFuncSetAttribute((const void*)fwd_kernel, hipFuncAttributeMaxDynamicSharedMemorySize, LDS_BYTES) != hipSuccess) { fprintf(stderr, "kernel_launch: hipFuncSetAttribute failed\n"); grid = -1; return; }
        if (hipOccupancyMaxActiveBlocksPerMultiprocessor(&per_cu, (const void*)fwd_kernel, NTHR, LDS_BYTES) != hipSuccess || per_cu < 1) { fprintf(stderr, "kernel_launch: occupancy query says %d\n", per_cu); per_cu = 1; }
        (void)hipGetLastError();
        grid = cus * 1;
    }
    if (grid < 0) return;
    Args a{};
    for (int i = 0; i < 26; ++i) a.in[i] = (const float*)d_in[i];
    a.out = (float*)d_out; a.ws = (unsigned char*)d_ws;
#if MK_MULTI
    for (int p = 0; p < N_PHASES; ++p) { a.ph_lo = p; a.ph_hi = p + 1; a.coop = 0; hipLaunchKernelGGL(fwd_kernel, dim3(grid), dim3(NTHR), LDS_BYTES, stream, a); }
#else
    a.ph_lo = 0; a.ph_hi = N_PHASES; a.coop = 1;
    if (hipMemsetAsync((char*)d_ws + WS_BAR, 0, BAR_BYTES, stream) != hipSuccess) { fprintf(stderr, "memset failed\n"); return; }
    void* args[] = {&a};
    hipError_t e = hipLaunchCooperativeKernel((const void*)fwd_kernel, dim3(grid), dim3(NTHR), args, LDS_BYTES, stream);
    if (e != hipSuccess) fprintf(stderr, "cooperative launch failed: %s (grid %d)\n", hipGetErrorString(e), grid);
#endif
}
```

```cpp
#include <hip/hip_runtime.h>
#include <hip/hip_cooperative_groups.h>
#include <cstdio>
#include <cstdint>
namespace cg = cooperative_groups;
namespace pg8 {
#define PG8_LAS __attribute__((address_space(3)))
typedef unsigned short bf16_t;
typedef short bf16x8 __attribute__((ext_vector_type(8)));
typedef float f32x4 __attribute__((ext_vector_type(4)));
typedef unsigned u32x4 __attribute__((ext_vector_type(4)));
constexpr int BM = 256, BK = 64, HALF = 128, HTB = HALF * BK * 2  , STAGE_BYTES = 8 * HTB, NXCD = 8, WGM = 8;

__host__ __device__ __forceinline__ int lds_byte(int r, int c) { const int st = (r >> 4) * 2 + (c >> 5), rr = r & 15, cc = c & 31, ob = rr * 64 + cc * 2; return st * 1024 + (ob ^ (((ob >> 9) & 1) << 5)); }
__host__ __device__ __forceinline__ void stage_rc(int b, int& R, int& C) { const int st = b / 1024, sb = b % 1024, swz = sb ^ (((sb >> 9) & 1) << 5); R = (st >> 1) * 16 + swz / 64; C = (st & 1) * 32 + (swz % 64) / 2; }
__host__ __device__ __forceinline__ int perm32(int rho) { const int n = rho >> 4, i = rho & 15; return 8 * (i >> 2) + 4 * n + (i & 3); }

struct Unit { int pm, pn, pass; };
struct Gemm { const bf16_t* A; const bf16_t* Bt; int M, N, K; };

struct StaticOrder {
    int nM, nN, nwg, G, c, rep = 1, epi_all = 0, epi_twice = 0;
    __host__ __device__ void init(int M, int N, int G_, int c_) { nM = M / BM; nN = N / BM; nwg = nM * nN; G = G_; c = c_; }
    __host__ __device__ bool next(int i, Unit& u) const {
        const unsigned L = (unsigned)i * (unsigned)G + (unsigned)c, n = (unsigned)nwg; if (L >= n * (unsigned)rep) return false;
        unsigned w = L; int p = 0; while (w >= n) { w -= n; ++p; }
        u.pass = p - (rep - 1);
        const unsigned q = n >> 3, r = n & 7u, xcd = w & 7u, off = w >> 3;
        const unsigned wgid = (xcd < r ? xcd * (q + 1u) : r * (q + 1u) + (xcd - r) * q) + off;
        const unsigned nig = (unsigned)(WGM * nN), gid = wgid / nig, rem = wgid - gid * nig, fm = gid * WGM;
        const unsigned gsz = ((unsigned)nM - fm) < (unsigned)WGM ? ((unsigned)nM - fm) : (unsigned)WGM;
        const unsigned q2 = rem / gsz;
        u.pm = (int)(fm + (rem - q2 * gsz)); u.pn = (int)q2; return true;
    }
    __device__ __forceinline__ void a_ready(const Unit&) const {}
    __device__ __forceinline__ void done(const Unit&) const {}
};

__device__ __forceinline__ unsigned cvt_pk_bf16(float lo, float hi) { unsigned r; asm volatile("v_cvt_pk_bf16_f32 %0, %1, %2" : "=v"(r) : "v"(lo), "v"(hi)); return r; }
template <class Epi, class Sched, bool ALIGN_EPI = false, bool SP2 = false>
__device__ __forceinline__ void gemm_phase(PG8_LAS unsigned char* lds, const Gemm g, const Sched& S, const Epi& E, const int tid, const unsigned delay = 0u) {
    const int wid = __builtin_amdgcn_readfirstlane(tid >> 6), lane = tid & 63, wr = wid >> 2, wc = wid & 3, fr = lane & 15, fq = lane >> 4;
    const int K = g.K, nt = K / BK;
    unsigned voffA[2], voffB[2];
#pragma unroll
    for (int i = 0; i < 2; ++i) { int R, C; stage_rc(tid * 16 + i * 8192, R, C); const int Rb = Epi::PERM ? ((R & ~31) + perm32(R & 31)) : R;
        voffA[i] = (unsigned)(R * K + C) * 2u; voffB[i] = (unsigned)(Rb * K + C) * 2u; }
    const size_t kstep = (size_t)(BK * 2);
    const size_t hstep = (size_t)HALF * K * 2;
    const size_t tstep = 2 * hstep;
    const unsigned ldsw = (unsigned)wid * 1024u;
    const int aoff = lds_byte(wr * 64 + fr, fq * 8), boff = lds_byte(wc * 32 + fr, fq * 8);
#define PG8_SA(b, h) (((b) * 2 + (h)) * HTB)
#define PG8_SB(b, h) ((4 + (b) * 2 + (h)) * HTB)
#define PG8_STAGE(bufoff, gbase, voff) do { _Pragma("unroll") for (int _i = 0; _i < 2; ++_i) \
        __builtin_amdgcn_global_load_lds((const unsigned*)((const char*)(gbase) + (voff)[_i]), (PG8_LAS unsigned*)(lds + (bufoff) + ldsw + _i * 8192), 16, 0, 0); } while (0)
#define PG8_LDA(dst, b, h) do { _Pragma("unroll") for (int m = 0; m < 4; ++m) _Pragma("unroll") for (int k = 0; k < 2; ++k) dst[m][k] = *(const PG8_LAS bf16x8*)(lds + PG8_SA(b, h) + aoff + m * 2048 + k * 1024); } while (0)
#define PG8_LDB(dst, b, h) do { _Pragma("unroll") for (int n = 0; n < 2; ++n) _Pragma("unroll") for (int k = 0; k < 2; ++k) dst[n][k] = *(const PG8_LAS bf16x8*)(lds + PG8_SB(b, h) + boff + n * 2048 + k * 1024); } while (0)
#define PG8_MMA(ai, bj, At, Bt) do { __builtin_amdgcn_s_setprio(1); _Pragma("unroll") for (int m = 0; m < 4; ++m) _Pragma("unroll") for (int n = 0; n < 2; ++n) _Pragma("unroll") for (int k = 0; k < 2; ++k) \
        acc[ai][bj][m][n] = __builtin_amdgcn_mfma_f32_16x16x32_bf16(Bt[n][k], At[m][k], acc[ai][bj][m][n], 0, 0, 0); __builtin_amdgcn_s_setprio(0); } while (0)
#define PG8_WAIT_V(n) asm volatile("s_waitcnt vmcnt(" #n ")" ::: "memory")
#define PG8_WAIT_L(n) asm volatile("s_waitcnt lgkmcnt(" #n ")" ::: "memory")
#define PG8_BAR __builtin_amdgcn_s_barrier()
#define PG8_SCHED __builtin_amdgcn_sched_barrier(0)
    Unit cur, nxt; int ui = 0;
    if (!S.next(0, cur)) return;
    if (delay) { if (tid == 0) { const unsigned long long t0 = __builtin_amdgcn_s_memrealtime(); while (__builtin_amdgcn_s_memrealtime() - t0 < delay) __builtin_amdgcn_s_sleep(8); } __syncthreads(); }
    unsigned long long rnext = 0ull;
    if constexpr (Epi::USE_R) { if (tid < 256) rnext = E.ssq[cur.pm * BM + tid]; }
    float cnext = 0.f;
    if constexpr (Epi::USE_C) cnext = E.c_load(cur, tid);
    f32x4 acc[2][2][4][2];
#pragma unroll
    for (int a = 0; a < 2; ++a)
#pragma unroll
        for (int b = 0; b < 2; ++b)
#pragma unroll
            for (int m = 0; m < 4; ++m)
#pragma unroll
                for (int n = 0; n < 2; ++n) acc[a][b][m][n] = (f32x4){0.f, 0.f, 0.f, 0.f};
    bf16x8 At[4][2], B0[2][2], B1[2][2];
    const char* cA = (const char*)g.A + (size_t)cur.pm * tstep; const char* cB = (const char*)g.Bt + (size_t)cur.pn * tstep;
    S.a_ready(cur);
    if constexpr (SP2) {
        PG8_STAGE(PG8_SB(0, 0), cB, voffB); PG8_STAGE(PG8_SB(0, 1), cB + hstep, voffB); PG8_STAGE(PG8_SA(0, 0), cA, voffA); PG8_STAGE(PG8_SA(0, 1), cA + hstep, voffA);
        if (wr == 1) PG8_BAR;
        PG8_WAIT_V(2); PG8_BAR;
        PG8_STAGE(PG8_SB(1, 0), cB + kstep, voffB); PG8_STAGE(PG8_SA(1, 0), cA + kstep, voffA); PG8_STAGE(PG8_SB(1, 1), cB + hstep + kstep, voffB);
        PG8_WAIT_V(6); PG8_BAR;
    } else {
        PG8_STAGE(PG8_SB(0, 0), cB, voffB); PG8_STAGE(PG8_SA(0, 0), cA, voffA); PG8_STAGE(PG8_SB(0, 1), cB + hstep, voffB); PG8_STAGE(PG8_SA(0, 1), cA + hstep, voffA);
        if (wr == 1) PG8_BAR;
        PG8_WAIT_V(4); PG8_BAR;
        PG8_STAGE(PG8_SB(1, 0), cB + kstep, voffB); PG8_STAGE(PG8_SA(1, 0), cA + kstep, voffA); PG8_STAGE(PG8_SB(1, 1), cB + hstep + kstep, voffB);
        PG8_WAIT_V(6); PG8_BAR;
    }
    for (;;) {
        const bool has_next = S.next(ui + 1, nxt);
        const char* nA = has_next ? (const char*)g.A + (size_t)nxt.pm * tstep : cA; const char* nB = has_next ? (const char*)g.Bt + (size_t)nxt.pn * tstep : cB;
        for (int t = 0; t < nt; t += 2) {
            const bool last = (t == nt - 2);
            const char* a1 = cA + (size_t)(t + 1) * kstep;
            const char* a2 = last ? nA : cA + (size_t)(t + 2) * kstep; const char* b2 = last ? nB : cB + (size_t)(t + 2) * kstep;
            const char* a3 = a2 + kstep; const char* b3 = b2 + kstep;
            if (last && has_next) S.a_ready(nxt);
            if constexpr (SP2) {
            PG8_LDB(B0, 0, 0); PG8_LDB(B1, 0, 1); PG8_SCHED; PG8_LDA(At, 0, 0); PG8_STAGE(PG8_SA(1, 1), a1 + hstep, voffA);
            PG8_WAIT_V(8); PG8_WAIT_L(0); PG8_BAR; PG8_MMA(0, 0, At, B0); PG8_MMA(0, 1, At, B1); PG8_BAR; PG8_SCHED;
            PG8_LDA(At, 0, 1); PG8_STAGE(PG8_SB(0, 0), b2, voffB); PG8_STAGE(PG8_SB(0, 1), b2 + hstep, voffB); PG8_STAGE(PG8_SA(0, 0), a2, voffA);
            PG8_WAIT_V(8); PG8_WAIT_L(0); PG8_BAR; PG8_MMA(1, 0, At, B0); PG8_MMA(1, 1, At, B1); PG8_BAR; PG8_SCHED;
            PG8_LDB(B0, 1, 0); PG8_LDB(B1, 1, 1); PG8_SCHED; PG8_LDA(At, 1, 0); PG8_STAGE(PG8_SA(0, 1), a2 + hstep, voffA);
            PG8_WAIT_V(8); PG8_WAIT_L(0); PG8_BAR; PG8_MMA(0, 0, At, B0); PG8_MMA(0, 1, At, B1); PG8_BAR; PG8_SCHED;
            PG8_LDA(At, 1, 1); PG8_STAGE(PG8_SB(1, 0), b3, voffB); PG8_STAGE(PG8_SB(1, 1), b3 + hstep, voffB); PG8_STAGE(PG8_SA(1, 0), a3, voffA);
            PG8_WAIT_V(8); PG8_WAIT_L(0); PG8_BAR; PG8_MMA(1, 0, At, B0); PG8_MMA(1, 1, At, B1); PG8_BAR; PG8_SCHED;
            } else {
            PG8_LDB(B0, 0, 0); PG8_SCHED; PG8_LDA(At, 0, 0); PG8_STAGE(PG8_SA(1, 1), a1 + hstep, voffA);
            PG8_WAIT_L(8); PG8_BAR; PG8_WAIT_L(0); PG8_MMA(0, 0, At, B0); PG8_BAR; PG8_SCHED;
            PG8_LDB(B1, 0, 1); PG8_STAGE(PG8_SB(0, 0), b2, voffB);
            PG8_BAR; PG8_WAIT_L(0); PG8_MMA(0, 1, At, B1); PG8_BAR;
            PG8_LDA(At, 0, 1); PG8_STAGE(PG8_SA(0, 0), a2, voffA);
            PG8_BAR; PG8_WAIT_L(0); PG8_MMA(1, 0, At, B0); PG8_BAR; PG8_SCHED;
            PG8_STAGE(PG8_SB(0, 1), b2 + hstep, voffB);
            PG8_WAIT_V(6); PG8_BAR; PG8_MMA(1, 1, At, B1); PG8_BAR;
            PG8_LDB(B0, 1, 0); PG8_SCHED; PG8_LDA(At, 1, 0); PG8_STAGE(PG8_SA(0, 1), a2 + hstep, voffA);
            PG8_WAIT_L(8); PG8_BAR; PG8_WAIT_L(0); PG8_MMA(0, 0, At, B0); PG8_BAR; PG8_SCHED;
            PG8_LDB(B1, 1, 1); PG8_STAGE(PG8_SB(1, 0), b3, voffB);
            PG8_BAR; PG8_WAIT_L(0); PG8_MMA(0, 1, At, B1); PG8_BAR;
            PG8_LDA(At, 1, 1); PG8_STAGE(PG8_SA(1, 0), a3, voffA);
            PG8_BAR; PG8_WAIT_L(0); PG8_MMA(1, 0, At, B0); PG8_BAR; PG8_SCHED;
            PG8_STAGE(PG8_SB(1, 1), b3 + hstep, voffB);
            PG8_WAIT_V(6); PG8_BAR; PG8_MMA(1, 1, At, B1); PG8_BAR;
            }
        }
        if constexpr (ALIGN_EPI) { if (wr == 0) PG8_BAR; }
        if constexpr (!Epi::AFTER_DRAIN) { if constexpr (Epi::USE_R) { if (tid < 256) ((PG8_LAS float*)(lds + 131072))[tid] = E.r_of(rnext); if constexpr (Epi::USE_C) ((PG8_LAS float*)(lds + 131072 + 1024))[tid] = cnext; __syncthreads(); }
        if (S.epi_all || cur.pass == 0) { E(acc, cur, wr, wc, fr, fq); if constexpr (Epi::TWICE) { asm volatile("" ::: "memory"); E(acc, cur, wr, wc, fr, fq); } } S.done(cur); }
        if (!has_next) break;
        if constexpr (Epi::USE_R) { if (tid < 256) rnext = E.ssq[nxt.pm * BM + tid]; }
        if constexpr (Epi::USE_C) cnext = E.c_load(nxt, tid);
#pragma unroll
        for (int a = 0; a < 2; ++a)
#pragma unroll
            for (int b = 0; b < 2; ++b)
#pragma unroll
                for (int m = 0; m < 4; ++m)
#pragma unroll
                    for (int n = 0; n < 2; ++n) acc[a][b][m][n] = (f32x4){0.f, 0.f, 0.f, 0.f};
        cur = nxt; cA = nA; cB = nB; ++ui;
        if constexpr (ALIGN_EPI) { if (wr == 1) PG8_BAR; }
    }
    PG8_WAIT_V(0);
    if constexpr (!ALIGN_EPI) { if (wr == 0) PG8_BAR; }
    PG8_BAR;
    if constexpr (Epi::AFTER_DRAIN) { E.fused(acc, cur, wr, wc, fr, fq, lds, wid, lane); S.done(cur); }
#undef PG8_SA
#undef PG8_SB
#undef PG8_STAGE
#undef PG8_LDA
#undef PG8_LDB
#undef PG8_MMA
#undef PG8_WAIT_V
#undef PG8_WAIT_L
#undef PG8_BAR
#undef PG8_SCHED
}
}
#ifndef EPI2_UP
#define EPI2_UP 0
#endif
#ifndef EPIALL_INB
#define EPIALL_INB 1
#endif
#ifndef NOSTORE_INB
#define NOSTORE_INB 0
#endif

#define LAS __attribute__((address_space(3)))
typedef unsigned short bf16_t;
typedef short bf16x8 __attribute__((ext_vector_type(8)));
typedef float f32x4 __attribute__((ext_vector_type(4)));
typedef float f32x16 __attribute__((ext_vector_type(16)));
typedef unsigned u32x4 __attribute__((ext_vector_type(4)));
typedef unsigned u32x2 __attribute__((ext_vector_type(2)));
using pg8::cvt_pk_bf16;

constexpr int NWAVES = 8, NTHR = 512;
constexpr int DM = 1024, DFF = 2816, SEQ = 4096, NB = 16, NBS = 32, DSEQ = 64;
constexpr int MP = NB * SEQ, MS = NBS * DSEQ, MT = MP + MS;
constexpr int NBLK64 = MT / 64;
constexpr float EPS = 1e-6f, LOG2E = 1.4426950408889634f;
constexpr int LDS_BYTES = 147456;

constexpr size_t OUT_Y = 0;
constexpr size_t OUT_MK = (size_t)MT * DM;
constexpr size_t OUT_MV = OUT_MK + (size_t)4 * 16 * 256 * 512;
constexpr size_t OUT_BK = OUT_MV + (size_t)4 * 16 * 256 * 512;
constexpr size_t OUT_BV = OUT_BK + (size_t)16 * 512 * 512;
constexpr size_t OUT_CP = OUT_BV + (size_t)16 * 512 * 512;
constexpr size_t OUT_AV = OUT_CP + (size_t)4 * 16 * 2 * DFF;
constexpr size_t OUT_SK = OUT_AV + (size_t)2 * 32 * 64 * 512;
constexpr size_t OUT_SV = OUT_SK + (size_t)32 * 64 * 512;
constexpr size_t OUT_CS = OUT_SV + (size_t)32 * 64 * 512;
constexpr size_t OUT_END = OUT_CS + (size_t)4 * 32 * 2 * DFF;

constexpr size_t al256(size_t x) { return (x + 255) & ~(size_t)255; }
constexpr size_t WS_BAR = 0, BAR_BYTES = 16384;
constexpr size_t WS_SSQ = BAR_BYTES;
constexpr size_t WS_RMEM = al256(WS_SSQ + (size_t)11 * MT * 8);
constexpr size_t WS_WINA = al256(WS_RMEM + 4096 * 4);
constexpr size_t WS_WB = WS_WINA + (size_t)2 * 1536 * 1024 * 2;
constexpr size_t WS_WMEM = WS_WB + (size_t)3072 * 1024 * 2;
constexpr size_t WS_WOUT = WS_WMEM + (size_t)4096 * 1024 * 2;
constexpr size_t WS_WUP = WS_WOUT + (size_t)4096 * 1024 * 2;
constexpr size_t WS_WDOWN = WS_WUP + (size_t)4 * 5632 * 1024 * 2;
constexpr size_t WS_WSB = WS_WDOWN + (size_t)4 * 1024 * 2816 * 2;
constexpr size_t WS_MPB = WS_WSB + (size_t)2 * 8 * 128 * 128 * 2;
constexpr size_t WS_HB = WS_MPB + (size_t)4096 * 1024 * 2;
constexpr size_t WS_MEMK = WS_HB + (size_t)MT * 1024 * 2;
constexpr size_t WS_MEMVT = WS_MEMK + (size_t)4 * 48 * 256 * 512 * 2;
constexpr size_t WS_PK = WS_MEMVT + (size_t)4 * 48 * 256 * 512 * 2;
constexpr size_t WS_PVT = WS_PK + (size_t)MP * 512 * 2;
constexpr size_t WS_SK = WS_PVT + (size_t)MP * 512 * 2;
constexpr size_t WS_SVT = WS_SK + (size_t)32 * 576 * 512 * 2;
constexpr size_t WS_TAIL = WS_SVT + (size_t)32 * 576 * 512 * 2;
constexpr size_t WS_HEAD = WS_TAIL + (size_t)NBLK64 * 2 * DFF * 4;
constexpr size_t WS_OVL = WS_HEAD + (size_t)NBLK64 * 4 * DFF * 4;
constexpr size_t WS_ACT = WS_OVL;
constexpr size_t WS_U = WS_OVL;
constexpr size_t WS_VT = WS_U + (size_t)MT * 512 * 2;
constexpr size_t WS_QM = WS_VT + (size_t)MT * 512 * 2;
constexpr size_t WS_CAT = WS_QM + (size_t)MT * 512 * 2;
constexpr size_t WS_END = WS_OVL + (size_t)MT * DFF * 2;
static_assert(WS_CAT + (size_t)MT * 1024 * 2 <= WS_END, "overlay");
static_assert(WS_END <= (size_t)1073741824, "workspace budget");

__device__ __forceinline__ float bf2f(unsigned short b) { return __builtin_bit_cast(float, (unsigned)b << 16); }
__device__ __forceinline__ unsigned short f2bf(float f) { unsigned u = __builtin_bit_cast(unsigned, f); return (unsigned short)((u + 0x7fffu + ((u >> 16) & 1u)) >> 16); }
__device__ __forceinline__ float gelu_t(float x) {
    const float t = x * (1.0f + 0.044715f * x * x);
    const float e = __builtin_amdgcn_exp2f(-2.302208198f * t);
    return x * __builtin_amdgcn_rcpf(1.0f + e);
}
typedef unsigned long long ssq_t;
__device__ __forceinline__ float rs_from(float ssq, float invn) { return rsqrtf(ssq * invn + EPS); }
__device__ __forceinline__ float rs_fromu(ssq_t v, float invn) { return rsqrtf((float)v * (invn * (1.0f / 1048576.0f)) + EPS); }
__device__ __forceinline__ ssq_t to_fix(float ss) { return (ssq_t)(ss * 1048576.0f); }
__device__ __forceinline__ u32x4 pack8(const f32x4& a, const f32x4& b) { u32x4 w; w.x = cvt_pk_bf16(a[0], a[1]); w.y = cvt_pk_bf16(a[2], a[3]); w.z = cvt_pk_bf16(b[0], b[1]); w.w = cvt_pk_bf16(b[2], b[3]); return w; }
__device__ __forceinline__ float wave_sum(float v) {
#pragma unroll
    for (int o = 1; o < 64; o <<= 1) v += __shfl_xor(v, o);
    return v;
}
#define MFMA32(a, b, c) __builtin_amdgcn_mfma_f32_32x32x16_bf16((a), (b), (c), 0, 0, 0)
__device__ __forceinline__ int crow(int r, int hi) { return (r & 3) + 8 * (r >> 2) + 4 * hi; }

typedef f32x4 AccT[2][2][4][2];

struct EpiInA {
    static constexpr bool PERM = true, AFTER_DRAIN = false, TWICE = false, USE_R = true, USE_C = false;
    const ssq_t* ssq; bf16_t* U; bf16_t* VT; bf16_t* QM; ssq_t* ssqv; float qscale; LAS const float* rtab;
    __device__ __forceinline__ float r_of(ssq_t v) const { return rs_fromu(v, 1.0f / 1024.0f); }
    __device__ __forceinline__ void operator()(const AccT& acc, const pg8::Unit& u, int wr, int wc, int fr, int fq) const {
        const int row0 = u.pm * 256 + wr * 64 + fr; const int ty = u.pn >> 1; const int cb = (u.pn & 1) * 256 + wc * 32 + 8 * fq;
#pragma unroll
        for (int ai = 0; ai < 2; ++ai)
#pragma unroll
            for (int m = 0; m < 4; ++m) {
                const int row = row0 + ai * 128 + m * 16; const float r = rtab[row - u.pm * 256];
                if (ty == 0) {
#pragma unroll
                    for (int bj = 0; bj < 2; ++bj) { f32x4 a = acc[ai][bj][m][0] * r, b = acc[ai][bj][m][1] * r;
#pragma unroll
                        for (int e = 0; e < 4; ++e) { a[e] = gelu_t(a[e]); b[e] = gelu_t(b[e]); }
                        *(u32x4*)(U + (size_t)row * 512 + cb + bj * 128) = pack8(a, b); }
                } else if (ty == 2) {
                    const float s = r * qscale;
#pragma unroll
                    for (int bj = 0; bj < 2; ++bj) { f32x4 a = acc[ai][bj][m][0] * s, b = acc[ai][bj][m][1] * s;
                        *(u32x4*)(QM + (size_t)row * 512 + cb + bj * 128) = pack8(a, b); }
                } else {
                    float ss = 0.f; bf16_t* vt = VT + (size_t)(row >> 7) * 512 * 128 + (row & 127);
#pragma unroll
                    for (int bj = 0; bj < 2; ++bj)
#pragma unroll
                        for (int n = 0; n < 2; ++n)
#pragma unroll
                            for (int e = 0; e < 4; ++e) { const unsigned short hb = f2bf(gelu_t(acc[ai][bj][m][n][e] * r)); const float vr = bf2f(hb); ss += vr * vr;
                                vt[(size_t)(cb + bj * 128 + 4 * n + e) * 128] = hb; }
                    ss += __shfl_xor(ss, 16); ss += __shfl_xor(ss, 32);
                    if (fq == 0) atomicAdd(ssqv + row, to_fix(ss));
                }
            }
    }
};

struct EpiInB {
    static constexpr bool PERM = true, AFTER_DRAIN = false, TWICE = false, USE_R = true, USE_C = false;
    const ssq_t* ssq; bf16_t* Q; bf16_t* QM; bf16_t* PK; bf16_t* PVT; bf16_t* SK; bf16_t* SVT; float* out; float qscale, mscale; LAS const float* rtab;
    __device__ __forceinline__ float r_of(ssq_t v) const { return rs_fromu(v, 1.0f / 1024.0f); }
    __device__ __forceinline__ void operator()(const AccT& acc, const pg8::Unit& u, int wr, int wc, int fr, int fq) const {
        const int row0 = u.pm * 256 + wr * 64 + fr; const int ty = u.pn >> 1; const int cb = (u.pn & 1) * 256 + wc * 32 + 8 * fq;
        const bool samp = u.pm >= 256;
#pragma unroll
        for (int ai = 0; ai < 2; ++ai)
#pragma unroll
            for (int m = 0; m < 4; ++m) {
                const int row = row0 + ai * 128 + m * 16; const float r = rtab[row - u.pm * 256];
                if (ty < 2) {
                    const float s = r * (ty == 0 ? qscale : mscale); bf16_t* dst = (ty == 0 ? Q : QM) + (size_t)row * 512 + cb;
#pragma unroll
                    for (int bj = 0; bj < 2; ++bj) { f32x4 a = acc[ai][bj][m][0] * s, b = acc[ai][bj][m][1] * s; const u32x4 pk_ = pack8(a, b); if (!NOSTORE_INB || u.pass == 0) *(u32x4*)(dst + bj * 128) = pk_; else asm volatile("" :: "v"(pk_)); }
                } else if (ty == 2) {
                    bf16_t* dst; float* fo = nullptr;
                    if (!samp) { dst = PK + (size_t)row * 512 + cb; const int t = row & 4095; if (t >= 3584) fo = out + OUT_BK + ((size_t)(row >> 12) * 512 + (t - 3584)) * 512 + cb; }
                    else { const int rs = row - MP, bs = rs >> 6, t = rs & 63; dst = SK + ((size_t)bs * 576 + 512 + t) * 512 + cb; fo = out + OUT_SK + (size_t)rs * 512 + cb; }
#pragma unroll
                    for (int bj = 0; bj < 2; ++bj) { f32x4 a = acc[ai][bj][m][0] * r, b = acc[ai][bj][m][1] * r; *(u32x4*)(dst + bj * 128) = pack8(a, b);
                        if (fo) { *(f32x4*)(fo + bj * 128) = a; *(f32x4*)(fo + bj * 128 + 4) = b; } }
                } else {
                    bf16_t* dst; size_t cst; float* fo = nullptr;
                    if (!samp) { const int b = row >> 12, t = row & 4095; dst = PVT + (size_t)b * 512 * 4096 + t; cst = 4096; if (t >= 3584) fo = out + OUT_BV + ((size_t)b * 512 + (t - 3584)) * 512 + cb; }
                    else { const int rs = row - MP, bs = rs >> 6, t = rs & 63; dst = SVT + (size_t)bs * 512 * 576 + 512 + t; cst = 576; fo = out + OUT_SV + (size_t)rs * 512 + cb; }
#pragma unroll
                    for (int bj = 0; bj < 2; ++bj) { f32x4 a = acc[ai][bj][m][0] * r, b = acc[ai][bj][m][1] * r;
#pragma unroll
                        for (int e = 0; e < 4; ++e) { dst[(size_t)(cb + bj * 128 + e) * cst] = f2bf(a[e]); dst[(size_t)(cb + bj * 128 + 4 + e) * cst] = f2bf(b[e]); }
                        if (fo) { *(f32x4*)(fo + bj * 128) = a; *(f32x4*)(fo + bj * 128 + 4) = b; } }
                }
            }
    }
};

struct EpiRes {
    static constexpr bool PERM = true, AFTER_DRAIN = false, TWICE = false, USE_R = false, USE_C = false;
    bf16_t* hb; ssq_t* ssq_next;
    __device__ __forceinline__ void operator()(const AccT& acc, const pg8::Unit& u, int wr, int wc, int fr, int fq) const {
        const int row0 = u.pm * 256 + wr * 64 + fr; const int cb = u.pn * 256 + wc * 32 + 8 * fq;
        bf16_t* base = hb + (size_t)row0 * 1024 + cb;
        u32x4 rw[2][4][2];
#pragma unroll
        for (int ai = 0; ai < 2; ++ai)
#pragma unroll
            for (int m = 0; m < 4; ++m)
#pragma unroll
                for (int bj = 0; bj < 2; ++bj) rw[ai][m][bj] = *(const u32x4*)(base + (size_t)(ai * 128 + m * 16) * 1024 + bj * 128);
        __builtin_amdgcn_sched_barrier(0);
#pragma unroll
        for (int ai = 0; ai < 2; ++ai)
#pragma unroll
            for (int m = 0; m < 4; ++m) {
                const int row = row0 + ai * 128 + m * 16; float ss = 0.f;
#pragma unroll
                for (int bj = 0; bj < 2; ++bj) { const u32x4 w = rw[ai][m][bj];
                    f32x4 a, b;
                    a[0] = __builtin_bit_cast(float, w.x << 16); a[1] = __builtin_bit_cast(float, w.x & 0xffff0000u); a[2] = __builtin_bit_cast(float, w.y << 16); a[3] = __builtin_bit_cast(float, w.y & 0xffff0000u);
                    b[0] = __builtin_bit_cast(float, w.z << 16); b[1] = __builtin_bit_cast(float, w.z & 0xffff0000u); b[2] = __builtin_bit_cast(float, w.w << 16); b[3] = __builtin_bit_cast(float, w.w & 0xffff0000u);
                    a = a + acc[ai][bj][m][0]; b = b + acc[ai][bj][m][1];
                    *(u32x4*)(base + (size_t)(ai * 128 + m * 16) * 1024 + bj * 128) = pack8(a, b);
                    ss += (a[0] * a[0] + a[1] * a[1]) + (a[2] * a[2] + a[3] * a[3]) + (b[0] * b[0] + b[1] * b[1]) + (b[2] * b[2] + b[3] * b[3]); }
                ss += __shfl_xor(ss, 16); ss += __shfl_xor(ss, 32);
                if (fq == 0) atomicAdd(ssq_next + row, to_fix(ss));
            }
    }
};

template <int CTRL> __device__ __forceinline__ float dpp_ror(float x) { return __int_as_float(__builtin_amdgcn_update_dpp(0, __float_as_int(x), CTRL, 0xf, 0xf, false)); }
struct EpiUp {
    static constexpr bool PERM = true, AFTER_DRAIN = false, TWICE = (EPI2_UP != 0), USE_R = true, USE_C = true;
    const ssq_t* ssq; const float* cw; const float* cbias; bf16_t* ACT; float* tail; float* head; LAS const float* rtab;
    __device__ __forceinline__ float r_of(ssq_t v) const { return rs_fromu(v, 1.0f / 1024.0f); }
    __device__ __forceinline__ float c_load(const pg8::Unit& u, int tid) const { const int f = u.pn * 128 + (tid & 127); return tid < 384 ? cw[(tid >> 7) * DFF + f] : cbias[f]; }
    __device__ __forceinline__ void operator()(const AccT& acc, const pg8::Unit& u, int wr, int wc, int fr, int fq) const {
        const int f0 = u.pn * 128 + wc * 32 + 8 * fq; const int lane = fq * 16 + fr;
        f32x4 w0[2], w1[2], w2[2], bb[2];
#pragma unroll
        for (int n = 0; n < 2; ++n) { LAS const float* ct = rtab + 256 + wc * 32 + 8 * fq + 4 * n; w0[n] = *(LAS const f32x4*)(ct); w1[n] = *(LAS const f32x4*)(ct + 128); w2[n] = *(LAS const f32x4*)(ct + 256); bb[n] = *(LAS const f32x4*)(ct + 384); }
#pragma unroll
        for (int ai = 0; ai < 2; ++ai) {
            const int blk = u.pm * 4 + ai * 2 + wr; const int rowb = blk * 64;
            f32x4 p1[2], p2[2];
#pragma unroll
            for (int n = 0; n < 2; ++n) { p1[n] = (f32x4){0.f, 0.f, 0.f, 0.f}; p2[n] = p1[n]; }
#pragma unroll
            for (int m = 0; m < 4; ++m) {
                const int row = rowb + 16 * m + fr; const float r = rtab[ai * 128 + wr * 64 + 16 * m + fr];
                f32x4 a[2], g[2], o[2], pp[2];
#pragma unroll
                for (int n = 0; n < 2; ++n) { a[n] = acc[ai][0][m][n] * r; g[n] = acc[ai][1][m][n] * r;
                    f32x4 c1, c2;
#pragma unroll
                    for (int e = 0; e < 4; ++e) { c1[e] = dpp_ror<0x121>(a[n][e]); c2[e] = dpp_ror<0x122>(a[n][e]); }
                    f32x4 a1, a2;
#pragma unroll
                    for (int e = 0; e < 4; ++e) { a1[e] = fr >= 1 ? c1[e] : p1[n][e]; a2[e] = fr >= 2 ? c2[e] : p2[n][e]; }
                    p1[n] = c1; p2[n] = c2;
                    pp[n] = bb[n] + w0[n] * a2 + w1[n] * a1 + w2[n] * a[n];
#pragma unroll
                    for (int e = 0; e < 4; ++e) o[n][e] = gelu_t(pp[n][e]) * g[n][e];
                }
                if (m == 0 && fr < 2) {
                    float* hp = head + ((size_t)(blk * 2 + fr) * 2) * DFF + f0;
                    *(f32x4*)(hp) = pp[0]; *(f32x4*)(hp + 4) = pp[1]; *(f32x4*)(hp + DFF) = g[0]; *(f32x4*)(hp + DFF + 4) = g[1];
                } else {
                    *(u32x4*)(ACT + (size_t)row * DFF + f0) = pack8(o[0], o[1]);
                }
                if (m == 3 && fr >= 14) { float* tp = tail + (size_t)(blk * 2 + (fr - 14)) * DFF + f0; *(f32x4*)(tp) = a[0]; *(f32x4*)(tp + 4) = a[1]; }
            }
        }
    }
};

struct EpiMem {
    static constexpr bool PERM = true, AFTER_DRAIN = false, TWICE = false, USE_R = false, USE_C = false;
    const float* rmem; float* out; bf16_t* MEMK; bf16_t* MEMVT;
    __device__ __forceinline__ void operator()(const AccT& acc, const pg8::Unit& u, int wr, int wc, int fr, int fq) const {
        const int row0 = u.pm * 256 + wr * 64 + fr; const int l = u.pn >> 2, kv = (u.pn >> 1) & 1; const int cb = (u.pn & 1) * 256 + wc * 32 + 8 * fq;
#pragma unroll
        for (int ai = 0; ai < 2; ++ai)
#pragma unroll
            for (int m = 0; m < 4; ++m) {
                const int row = row0 + ai * 128 + m * 16; const float r = rmem[row]; const int b = row >> 8, n = row & 255;
                float* fo = out + (kv ? OUT_MV : OUT_MK) + ((size_t)l * 4096 + row) * 512 + cb;
#pragma unroll
                for (int bj = 0; bj < 2; ++bj) { f32x4 x = acc[ai][bj][m][0] * r, y = acc[ai][bj][m][1] * r;
                    *(f32x4*)(fo + bj * 128) = x; *(f32x4*)(fo + bj * 128 + 4) = y;
                    if (!kv) *(u32x4*)(MEMK + (((size_t)l * 48 + b) * 256 + n) * 512 + cb + bj * 128) = pack8(x, y);
                    else { bf16_t* d = MEMVT + (((size_t)l * 48 + b) * 512 + cb + bj * 128) * 256 + n;
#pragma unroll
                        for (int e = 0; e < 4; ++e) { d[(size_t)e * 256] = f2bf(x[e]); d[(size_t)(4 + e) * 256] = f2bf(y[e]); } } }
            }
    }
};

__device__ __forceinline__ void tr_item(const float* src, int lsrc, int k0, int n0, const float* g, bf16_t* dst, int ldd, LAS float* scr, int lane) {
    float tv[32];
#pragma unroll
    for (int i = 0; i < 32; ++i) { const int kk = 2 * i + (lane >> 5); tv[i] = __builtin_nontemporal_load(src + (size_t)(k0 + kk) * lsrc + n0 + (lane & 31)); }
#pragma unroll
    for (int i = 0; i < 32; ++i) { const int kk = 2 * i + (lane >> 5); float v = tv[i]; if (g) v *= g[k0 + kk]; scr[kk * 33 + (lane & 31)] = v; }
    asm volatile("s_waitcnt lgkmcnt(0)" ::: "memory");
    const int c = lane & 7;
#pragma unroll
    for (int j = 0; j < 4; ++j) { const int n = (lane >> 3) + 8 * j; const LAS float* s = scr + (8 * c) * 33 + n;
        u32x4 o; o.x = cvt_pk_bf16(s[0 * 33], s[1 * 33]); o.y = cvt_pk_bf16(s[2 * 33], s[3 * 33]); o.z = cvt_pk_bf16(s[4 * 33], s[5 * 33]); o.w = cvt_pk_bf16(s[6 * 33], s[7 * 33]);
        *(u32x4*)(dst + (size_t)n * ldd + k0 + 8 * c) = o; }
    asm volatile("s_waitcnt lgkmcnt(0)" ::: "memory");
}
__device__ __forceinline__ void tr_plain(const float* src, int K, int N, const float* g, bf16_t* dst, int ldd, int item, LAS float* scr, int lane) {
    const int nblk = N / 32, kb = item / nblk, nb = item % nblk;
    tr_item(src, N, kb * 64, nb * 32, g, dst + (size_t)(nb * 32) * ldd, ldd, scr, lane);
}

struct Args { const float* in[26]; float* out; unsigned char* ws; int ph_lo, ph_hi, coop, pad; };
typedef __attribute__((address_space(4))) const Args* KArgs;

__device__ __forceinline__ void p0_prologue(KArgs a, LAS unsigned char* lds, int tid) {
    const int lane = tid & 63, wave = tid >> 6; const int G = gridDim.x;
    LAS float* scr = (LAS float*)(lds + wave * 8704);
    unsigned char* ws = a->ws;
    const int gw = blockIdx.x * NWAVES + wave, NGW = G * NWAVES;
    constexpr int I_INA = 16 * 48, I_SQ = 16 * 32, I_UP = 16 * 176, I_DN = 44 * 32, I_MV = 4 * 16, I_BV = 8 * 16;
    constexpr int N_INA = 2 * I_INA, N_B = 3 * I_SQ, N_MEM = 4 * I_SQ, N_OUT = 4 * I_SQ, N_UP = 4 * I_UP, N_DN = 4 * I_DN, N_MV = 128 * I_MV, N_BV = 32 * I_BV;
    constexpr int NITEMS = N_INA + N_B + N_MEM + N_OUT + N_UP + N_DN + N_MV + N_BV;
    for (int it = gw; it < NITEMS; it += NGW) {
        int r = it;
        if (r < N_INA) { const int l = r / I_INA; r %= I_INA; tr_plain(a->in[9] + (size_t)l * 1024 * 1536, 1024, 1536, a->in[8] + l * 1024, (bf16_t*)(ws + WS_WINA) + (size_t)l * 1536 * 1024, 1024, r, scr, lane); continue; } r -= N_INA;
        if (r < N_B) { const int s = r / I_SQ; r %= I_SQ;
            const float* src = s == 1 ? a->in[14] : a->in[15] + (size_t)(s >> 1) * 1024 * 1024; const float* g = s == 1 ? a->in[13] : a->in[8] + (2 + (s >> 1)) * 1024;
            tr_plain(src, 1024, 1024, g, (bf16_t*)(ws + WS_WB) + (size_t)s * 1024 * 1024, 1024, r, scr, lane); continue; } r -= N_B;
        if (r < N_MEM) { const int l = r / I_SQ; r %= I_SQ; tr_plain(a->in[18] + (size_t)l * 1024 * 1024, 1024, 1024, a->in[17] + l * 1024, (bf16_t*)(ws + WS_WMEM) + (size_t)l * 1024 * 1024, 1024, r, scr, lane); continue; } r -= N_MEM;
        if (r < N_OUT) { const int l = r / I_SQ; r %= I_SQ; tr_plain(a->in[19] + (size_t)l * 1024 * 1024, 1024, 1024, nullptr, (bf16_t*)(ws + WS_WOUT) + (size_t)l * 1024 * 1024, 1024, r, scr, lane); continue; } r -= N_OUT;
        if (r < N_UP) { const int l = r / I_UP; r %= I_UP; const int kb = r / 176, nb = r % 176; const int s0 = nb * 32; const int bj = s0 / DFF, f = s0 % DFF; const int drow = (f >> 7) * 256 + bj * 128 + (f & 127);
            tr_item(a->in[21] + (size_t)l * 1024 * 5632, 5632, kb * 64, s0, a->in[20] + l * 1024, (bf16_t*)(ws + WS_WUP) + ((size_t)l * 5632 + drow) * 1024, 1024, scr, lane); continue; } r -= N_UP;
        if (r < N_DN) { const int l = r / I_DN; r %= I_DN; tr_plain(a->in[24] + (size_t)l * DFF * 1024, DFF, 1024, nullptr, (bf16_t*)(ws + WS_WDOWN) + (size_t)l * 1024 * DFF, DFF, r, scr, lane); continue; } r -= N_DN;
        if (r < N_MV) { const int mi = r / I_MV; r %= I_MV; const int l = mi >> 5, bs = mi & 31;
            tr_plain(a->in[4] + (size_t)mi * 256 * 512, 256, 512, nullptr, (bf16_t*)(ws + WS_MEMVT) + ((size_t)l * 48 + 16 + bs) * 512 * 256, 256, r, scr, lane); continue; } r -= N_MV;
        { const int bs = r / I_BV; r %= I_BV; tr_plain(a->in[6] + (size_t)bs * 512 * 512, 512, 512, nullptr, (bf16_t*)(ws + WS_SVT) + (size_t)bs * 512 * 576, 576, r, scr, lane); }
    }
    for (int m0 = gw; m0 < MT + 4096; m0 += 4 * NGW) {
        f32x4 v[4][4]; float sq[4];
#pragma unroll
        for (int u = 0; u < 4; ++u) { const int m = m0 + u * NGW; if (m < MT + 4096) {
            const bool ismem = m >= MT; const int rr = ismem ? m - MT : m;
            const float* xr = ismem ? a->in[2] + (size_t)rr * 1024 : (rr < MP ? a->in[0] + (size_t)rr * 1024 : a->in[1] + (size_t)(rr - MP) * 1024);
#pragma unroll
            for (int j = 0; j < 4; ++j) v[u][j] = __builtin_nontemporal_load((const f32x4*)xr + lane + 64 * j); } }
#pragma unroll
        for (int u = 0; u < 4; ++u) { const int m = m0 + u * NGW; if (m < MT + 4096) {
            const bool ismem = m >= MT; const int rr = ismem ? m - MT : m;
            bf16_t* orow = (bf16_t*)(ws + (ismem ? WS_MPB : WS_HB)) + (size_t)rr * 1024;
            float s = 0.f;
#pragma unroll
            for (int j = 0; j < 4; ++j) s += (v[u][j][0] * v[u][j][0] + v[u][j][1] * v[u][j][1]) + (v[u][j][2] * v[u][j][2] + v[u][j][3] * v[u][j][3]);
            s = wave_sum(s); sq[u] = s;
#pragma unroll
            for (int j = 0; j < 4; ++j) { u32x2 o; o.x = cvt_pk_bf16(v[u][j][0], v[u][j][1]); o.y = cvt_pk_bf16(v[u][j][2], v[u][j][3]); *((u32x2*)orow + lane + 64 * j) = o; }
            if (lane == 0) { if (ismem) ((float*)(ws + WS_RMEM))[rr] = rs_from(sq[u], 1.0f / 1024.0f); else ((ssq_t*)(ws + WS_SSQ))[rr] = to_fix(sq[u]); } } }
    }
    const size_t gt = (size_t)blockIdx.x * NTHR + tid, NT = (size_t)G * NTHR;
    { ssq_t* z = (ssq_t*)(ws + WS_SSQ) + MT; for (size_t i = gt; i < (size_t)10 * MT; i += NT) z[i] = 0ull; }
    { bf16_t* wsb = (bf16_t*)(ws + WS_WSB); const float* w = a->in[11];
      for (size_t i = gt; i < (size_t)2 * 8 * 128 * 128; i += NT) { const int jj = (int)(i & 127), ii = (int)((i >> 7) & 127); wsb[i] = jj <= ii ? f2bf(w[i]) : (unsigned short)0; } }
    {
      const f32x4* src = (const f32x4*)a->in[3]; bf16_t* dst = (bf16_t*)(ws + WS_MEMK);
      constexpr size_t NV = (size_t)4 * 32 * 256 * 512 / 4;
      for (size_t i0 = gt; i0 < NV; i0 += 8 * NT) { f32x4 v[8];
#pragma unroll
          for (int k = 0; k < 8; ++k) { const size_t i = i0 + k * NT; if (i < NV) v[k] = __builtin_nontemporal_load(src + i); }
#pragma unroll
          for (int k = 0; k < 8; ++k) { const size_t i = i0 + k * NT; if (i < NV) { const size_t e = i * 4; const size_t mi = e / (256 * 512), rem = e % (256 * 512); const size_t l = mi >> 5, bs = mi & 31;
              u32x2 o; o.x = cvt_pk_bf16(v[k][0], v[k][1]); o.y = cvt_pk_bf16(v[k][2], v[k][3]); *(u32x2*)(dst + ((l * 48 + 16 + bs) * 256 * 512) + rem) = o; } } } }
    {
      const f32x4* src = (const f32x4*)a->in[5]; bf16_t* dst = (bf16_t*)(ws + WS_SK);
      constexpr size_t NV = (size_t)32 * 512 * 512 / 4;
      for (size_t i0 = gt; i0 < NV; i0 += 8 * NT) { f32x4 v[8];
#pragma unroll
          for (int k = 0; k < 8; ++k) { const size_t i = i0 + k * NT; if (i < NV) v[k] = __builtin_nontemporal_load(src + i); }
#pragma unroll
          for (int k = 0; k < 8; ++k) { const size_t i = i0 + k * NT; if (i < NV) { const size_t e = i * 4; const size_t bs = e / (512 * 512), rem = e % (512 * 512);
              u32x2 o; o.x = cvt_pk_bf16(v[k][0], v[k][1]); o.y = cvt_pk_bf16(v[k][2], v[k][3]); *(u32x2*)(dst + bs * 576 * 512 + rem) = o; } } } }
}

#ifndef REP_MEM
#define REP_MEM 1
#endif
#ifndef REP_GATE
#define REP_GATE 1
#endif
#ifndef REP_BAND
#define REP_BAND 1
#endif
template <int nib>
__device__ __forceinline__ void gate_unit(LAS unsigned char* lds, int tid, int chunk, int joff, int row0,
                                          const bf16_t* wsb, const bf16_t* VT, const bf16_t* U, const ssq_t* ssqv, const float* gv, const float* bs, bf16_t* CAT, float* av_out) {
    const int g = tid >> 6, lane = tid & 63, l32 = lane & 31, half = lane >> 5;
    LAS float* rv = (LAS float*)lds;
    __syncthreads();
    if (tid < nib * 32) rv[tid] = rs_fromu(ssqv[row0 + tid], 1.0f / 512.0f);
    __syncthreads();
    const bf16_t* vt_g = VT + ((size_t)chunk * 512 + g * 64) * 128 + joff;
    const bf16_t* w_g = wsb + (size_t)g * 128 * 128;
#pragma unroll 1
    for (int db = 0; db < 2; ++db) {
        f32x16 acc[4];
#pragma unroll
        for (int i = 0; i < 4; ++i)
#pragma unroll
            for (int e = 0; e < 16; ++e) acc[i][e] = 0.f;
        const bf16_t* vt_d = vt_g + (size_t)(db * 32 + l32) * 128 + half * 8;
        const bf16_t* w_d = w_g + (size_t)l32 * 128 + half * 8;
#pragma unroll
        for (int ks = 0; ks < 8; ++ks) {
            if (ks < nib * 2) {
                const int j0 = ks * 16 + half * 8;
                const u32x4 raw = *(const u32x4*)(vt_d + ks * 16);
                u32x4 sc;
#pragma unroll
                for (int q = 0; q < 4; ++q) { const float lo = __builtin_bit_cast(float, raw[q] << 16) * rv[j0 + 2 * q], hi = __builtin_bit_cast(float, raw[q] & 0xffff0000u) * rv[j0 + 2 * q + 1]; sc[q] = cvt_pk_bf16(lo, hi); }
                const bf16x8 bfr = __builtin_bit_cast(bf16x8, sc);
#pragma unroll
                for (int ib = 0; ib < 4; ++ib) {
                    if (ib < nib && ks < (ib + 1) * 2) {
                        const bf16x8 af = *(const bf16x8*)(w_d + ib * 32 * 128 + ks * 16);
                        acc[ib] = MFMA32(af, bfr, acc[ib]);
                    }
                }
            }
        }
        const int c = g * 64 + db * 32 + l32; const float gvc = gv[c];
        const bf16_t* ub = U + ((size_t)row0 + 4 * half) * 512 + c; bf16_t* cbp = CAT + ((size_t)row0 + 4 * half) * 1024 + c; const float* bsp = bs + g * 128 + 4 * half;
#pragma unroll
        for (int ib = 0; ib < nib; ++ib) {
            unsigned short uv[16]; float bv[16];
#pragma unroll
            for (int e = 0; e < 16; ++e) { const int i = ib * 32 + (e & 3) + 8 * (e >> 2); uv[e] = ub[(size_t)i * 512]; bv[e] = bsp[i]; }
#pragma unroll
            for (int e = 0; e < 16; ++e) { const int i = ib * 32 + (e & 3) + 8 * (e >> 2);
                const float s = acc[ib][e] * gvc + bv[e];
                cbp[(size_t)i * 1024] = f2bf(bf2f(uv[e]) * s); }
        }
    }
    if (av_out) {
        const int c = tid & 511; const float gvc = gv[c]; const bf16_t* vsrc = VT + ((size_t)chunk * 512 + c) * 128 + joff;
#pragma unroll 1
        for (int t0 = 0; t0 < 64; t0 += 16) {
            unsigned short vv[16];
#pragma unroll
            for (int k = 0; k < 16; ++k) vv[k] = vsrc[t0 + k];
#pragma unroll
            for (int k = 0; k < 16; ++k) av_out[(size_t)(t0 + k) * 512 + c] = bf2f(vv[k]) * rv[t0 + k] * gvc;
        }
    }
}

template <int D, bool BAND>
__device__ __forceinline__ void attn_unit(LAS unsigned char* lds, int tid, const bf16_t* Qw, bool hasq, const bf16_t* Kb, int ldk, const bf16_t* Vtb, int ldv,
                                          int jstart, int nkb, int jlo, int jhi, bf16_t* Ow, LAS const float* btab, int relq) {
    constexpr int KROW = (D + 8) * 2, VROW = 136, KBYTES = 64 * KROW, VBYTES = D * VROW, BUF = KBYTES + VBYTES, STAGE = 2 * BUF, NR = D / 64, KK = D / 16, DB = D / 32;
    const int lane = tid & 63, l32 = lane & 31, half = lane >> 5;
    bf16x8 qf[KK];
#pragma unroll
    for (int kk = 0; kk < KK; ++kk) qf[kk] = hasq ? *(const bf16x8*)(Qw + (size_t)l32 * 512 + kk * 16 + half * 8) : (bf16x8){0, 0, 0, 0, 0, 0, 0, 0};
    f32x16 O[DB];
#pragma unroll
    for (int d = 0; d < DB; ++d)
#pragma unroll
        for (int e = 0; e < 16; ++e) O[d][e] = 0.f;
    float mrun = -1e30f, lsum = 0.f;
    u32x4 kreg[2][NR], vreg[2][NR];
#define ATT_GLOAD(st) do { _Pragma("unroll") for (int bk = 0; bk < 2; ++bk) { const int j_ = 2 * (st) + bk; _Pragma("unroll") for (int i = 0; i < NR; ++i) { const int id = tid + i * NTHR; const int kr = id / (D / 8), kc = id % (D / 8); \
        kreg[bk][i] = *(const u32x4*)(Kb + (long)(j_ * 64 + kr) * ldk + kc * 8); const int vr = id >> 3, vc = id & 7; vreg[bk][i] = *(const u32x4*)(Vtb + (long)vr * ldv + j_ * 64 + vc * 8); } } } while (0)
#define ATT_LSTORE(buf) do { _Pragma("unroll") for (int bk = 0; bk < 2; ++bk) { LAS unsigned char* b_ = lds + (buf) * STAGE + bk * BUF; _Pragma("unroll") for (int i = 0; i < NR; ++i) { const int id = tid + i * NTHR; const int kr = id / (D / 8), kc = id % (D / 8); \
        *(LAS u32x4*)(b_ + kr * KROW + kc * 16) = kreg[bk][i]; const int vr = id >> 3, vc = id & 7; { const u32x4 v_ = vreg[bk][i]; *(LAS u32x2*)(b_ + KBYTES + vr * VROW + vc * 16) = (u32x2){v_.x, v_.y}; *(LAS u32x2*)(b_ + KBYTES + vr * VROW + vc * 16 + 8) = (u32x2){v_.z, v_.w}; } } } } while (0)
    const int st0 = jstart >> 1, nst = (nkb + 1) >> 1;
    __syncthreads();
    ATT_GLOAD(st0); ATT_LSTORE(0);
    __syncthreads();
    for (int st = st0; st < nst; ++st) {
        const int cur = (st - st0) & 1;
        if (st + 1 < nst) ATT_GLOAD(st + 1);
        if constexpr (D == 64) {
            const int j0 = 2 * st;
            const bool a0 = hasq && j0 >= jlo && j0 <= jhi, a1 = hasq && (j0 + 1) >= jlo && (j0 + 1) <= jhi;
            if (a0 || a1) {
                const LAS unsigned char* bb0 = lds + cur * STAGE;
                f32x16 S[4];
#pragma unroll
                for (int bk = 0; bk < 2; ++bk) {
                    const LAS unsigned char* b = bb0 + bk * BUF; const bool act = bk ? a1 : a0;
                    if (act) {
#pragma unroll
                        for (int s = 0; s < 2; ++s) {
                            bf16x8 kf[KK];
#pragma unroll
                            for (int kk = 0; kk < KK; ++kk) kf[kk] = *(const LAS bf16x8*)(b + (s * 32 + l32) * KROW + (kk * 16 + half * 8) * 2);
#pragma unroll
                            for (int e = 0; e < 16; ++e) S[bk * 2 + s][e] = 0.f;
#pragma unroll
                            for (int kk = 0; kk < KK; ++kk) S[bk * 2 + s] = MFMA32(kf[kk], qf[kk], S[bk * 2 + s]);
                        }
                        const int j = j0 + bk;
                        if (BAND) {
                            if (j <= jlo + 3) {
                                const float cbias = btab[0];
#pragma unroll
                                for (int s = 0; s < 2; ++s)
#pragma unroll
                                    for (int e = 0; e < 16; ++e) S[bk * 2 + s][e] += cbias;
                            } else {
                                const LAS float* bp = btab + (575 - relq + j * 64 + 4 * half);
#pragma unroll
                                for (int s = 0; s < 2; ++s)
#pragma unroll
                                    for (int e = 0; e < 16; ++e) S[bk * 2 + s][e] += bp[s * 32 + (e & 3) + 8 * (e >> 2)];
                            }
                        }
                    } else {
#pragma unroll
                        for (int s = 0; s < 2; ++s)
#pragma unroll
                            for (int e = 0; e < 16; ++e) S[bk * 2 + s][e] = -1e30f;
                    }
                }
                float mx = S[0][0];
#pragma unroll
                for (int q = 0; q < 4; ++q)
#pragma unroll
                    for (int e = 0; e < 16; ++e) mx = fmaxf(mx, S[q][e]);
                mx = fmaxf(mx, __shfl_xor(mx, 32));
                const float mnew = fmaxf(mrun, mx); const float alpha = __builtin_amdgcn_exp2f(mrun - mnew); mrun = mnew;
                float ps = 0.f;
#pragma unroll
                for (int q = 0; q < 4; ++q)
#pragma unroll
                    for (int e = 0; e < 16; ++e) { const float p = __builtin_amdgcn_exp2f(S[q][e] - mnew); S[q][e] = p; ps += p; }
                lsum = lsum * alpha + ps;
                if (__builtin_amdgcn_ballot_w64(alpha != 1.0f) != 0ull) {
#pragma unroll
                    for (int d = 0; d < DB; ++d)
#pragma unroll
                        for (int e = 0; e < 16; ++e) O[d][e] *= alpha;
                }
#pragma unroll
                for (int bk = 0; bk < 2; ++bk) {
                    const bool act = bk ? a1 : a0;
                    if (act) {
                        const LAS unsigned char* b = bb0 + bk * BUF;
#pragma unroll
                        for (int s = 0; s < 2; ++s)
#pragma unroll
                            for (int t = 0; t < 2; ++t) {
                                u32x2 vlo[DB], vhi[DB];
#pragma unroll
                                for (int d = 0; d < DB; ++d) { const LAS unsigned char* vp = b + KBYTES + (d * 32 + l32) * VROW + (s * 32 + 16 * t + 4 * half) * 2; vlo[d] = *(const LAS u32x2*)vp; vhi[d] = *(const LAS u32x2*)(vp + 16); }
                                u32x4 pk;
#pragma unroll
                                for (int q = 0; q < 4; ++q) pk[q] = cvt_pk_bf16(S[bk * 2 + s][8 * t + 2 * q], S[bk * 2 + s][8 * t + 2 * q + 1]);
                                const bf16x8 pb = __builtin_bit_cast(bf16x8, pk);
#pragma unroll
                                for (int d = 0; d < DB; ++d) { const u32x4 vv = {vlo[d].x, vlo[d].y, vhi[d].x, vhi[d].y}; O[d] = MFMA32(__builtin_bit_cast(bf16x8, vv), pb, O[d]); }
                            }
                    }
                }
            }
        } else {
#pragma unroll
        for (int bk = 0; bk < 2; ++bk) {
            const int j = 2 * st + bk;
            if (hasq && j >= jlo && j <= jhi) {
                const LAS unsigned char* b = lds + cur * STAGE + bk * BUF;
                f32x16 S[2];
#pragma unroll
                for (int s = 0; s < 2; ++s) {
#pragma unroll
                    for (int e = 0; e < 16; ++e) S[s][e] = 0.f;
#pragma unroll
                    for (int k0 = 0; k0 < KK; k0 += 4) {
                        bf16x8 kf[4];
#pragma unroll
                        for (int kk = 0; kk < 4; ++kk) kf[kk] = *(const LAS bf16x8*)(b + (s * 32 + l32) * KROW + ((k0 + kk) * 16 + half * 8) * 2);
#pragma unroll
                        for (int kk = 0; kk < 4; ++kk) S[s] = MFMA32(kf[kk], qf[k0 + kk], S[s]);
                    }
                }
                constexpr int NVS = (D == 64) ? 2 : 0;
                u32x2 vlo[2][2][DB], vhi[2][2][DB];
#pragma unroll
                for (int s = 0; s < NVS; ++s)
#pragma unroll
                    for (int t = 0; t < 2; ++t)
#pragma unroll
                        for (int d = 0; d < DB; ++d) { const LAS unsigned char* vp = b + KBYTES + (d * 32 + l32) * VROW + (s * 32 + 16 * t + 4 * half) * 2; vlo[s][t][d] = *(const LAS u32x2*)vp; vhi[s][t][d] = *(const LAS u32x2*)(vp + 16); }
                if (BAND) {
                    if (j <= jlo + 3) {
                        const float cbias = btab[0];
#pragma unroll
                        for (int s = 0; s < 2; ++s)
#pragma unroll
                            for (int e = 0; e < 16; ++e) S[s][e] += cbias;
                    } else {
                        const LAS float* bp = btab + (575 - relq + j * 64 + 4 * half);
#pragma unroll
                        for (int s = 0; s < 2; ++s)
#pragma unroll
                            for (int e = 0; e < 16; ++e) S[s][e] += bp[s * 32 + (e & 3) + 8 * (e >> 2)];
                    }
                }
                float mx = S[0][0];
#pragma unroll
                for (int e = 1; e < 16; ++e) mx = fmaxf(mx, S[0][e]);
#pragma unroll
                for (int e = 0; e < 16; ++e) mx = fmaxf(mx, S[1][e]);
                mx = fmaxf(mx, __shfl_xor(mx, 32));
                const float mnew = fmaxf(mrun, mx); const float alpha = __builtin_amdgcn_exp2f(mrun - mnew); mrun = mnew;
                float ps = 0.f;
#pragma unroll
                for (int s = 0; s < 2; ++s)
#pragma unroll
                    for (int e = 0; e < 16; ++e) { const float p = __builtin_amdgcn_exp2f(S[s][e] - mnew); S[s][e] = p; ps += p; }
                lsum = lsum * alpha + ps;
                if (__builtin_amdgcn_ballot_w64(alpha != 1.0f) != 0ull) {
#pragma unroll
                    for (int d = 0; d < DB; ++d)
#pragma unroll
                        for (int e = 0; e < 16; ++e) O[d][e] *= alpha;
                }
#pragma unroll
                for (int s = 0; s < 2; ++s) {
#pragma unroll
                    for (int t = 0; t < 2; ++t) {
                        if (s >= NVS) {
#pragma unroll
                            for (int d = 0; d < DB; ++d) { const LAS unsigned char* vp = b + KBYTES + (d * 32 + l32) * VROW + (s * 32 + 16 * t + 4 * half) * 2; vlo[s][t][d] = *(const LAS u32x2*)vp; vhi[s][t][d] = *(const LAS u32x2*)(vp + 16); }
                        }
                        u32x4 pk;
#pragma unroll
                        for (int q = 0; q < 4; ++q) pk[q] = cvt_pk_bf16(S[s][8 * t + 2 * q], S[s][8 * t + 2 * q + 1]);
                        const bf16x8 pb = __builtin_bit_cast(bf16x8, pk);
#pragma unroll
                        for (int d = 0; d < DB; ++d) {
                            const u32x4 vv = {vlo[s][t][d].x, vlo[s][t][d].y, vhi[s][t][d].x, vhi[s][t][d].y};
                            O[d] = MFMA32(__builtin_bit_cast(bf16x8, vv), pb, O[d]);
                        }
                    }
                }
            }
        }
        }
        if (st + 1 < nst) ATT_LSTORE(cur ^ 1);
        __syncthreads();
    }
#undef ATT_GLOAD
#undef ATT_LSTORE
    if (hasq) {
        const float l = lsum + __shfl_xor(lsum, 32); const float inv = 1.0f / l;
#pragma unroll
        for (int d = 0; d < DB; ++d)
#pragma unroll
            for (int gq = 0; gq < 4; ++gq) {
                u32x2 o; o.x = cvt_pk_bf16(O[d][4 * gq] * inv, O[d][4 * gq + 1] * inv); o.y = cvt_pk_bf16(O[d][4 * gq + 2] * inv, O[d][4 * gq + 3] * inv);
                *(u32x2*)(Ow + (size_t)l32 * 1024 + d * 32 + 8 * gq + 4 * half) = o;
            }
    }
}

__device__ __forceinline__ void mixer_phase(KArgs a, LAS unsigned char* lds, int tid_in, int l) {
    unsigned char* ws = a->ws; const int G = gridDim.x;
    bf16_t* CAT = (bf16_t*)(ws + WS_CAT);
    constexpr int N_MEMP = 16 * 16 * 4, N_MEMS = 32 * 4;
#ifndef NO_MEMATT
    {
        int tid = tid_in; asm volatile("" : "+v"(tid)); const int wave = tid >> 6;
        const bf16_t* QM = (const bf16_t*)(ws + WS_QM);
        for (int it = blockIdx.x; it < REP_MEM * (N_MEMP + N_MEMS); it += G) {
            int r = it % (N_MEMP + N_MEMS); int bb, h, q0, nq;
            if (r < N_MEMP) { h = r & 3; const int qb = (r >> 2) & 15; bb = r >> 6; q0 = bb * SEQ + qb * 256; nq = 256; }
            else { r -= N_MEMP; h = r & 3; const int bs = r >> 2; bb = 16 + bs; q0 = MP + bs * 64; nq = 64; }
            const bool hasq = wave * 32 < nq; const int qrow = q0 + wave * 32;
            attn_unit<128, false>(lds, tid, QM + (size_t)qrow * 512 + h * 128, hasq, (const bf16_t*)(ws + WS_MEMK) + ((size_t)l * 48 + bb) * 256 * 512 + h * 128, 512,
                                  (const bf16_t*)(ws + WS_MEMVT) + (((size_t)l * 48 + bb) * 512 + h * 128) * 256, 256, 0, 4, 0, 3, CAT + (size_t)qrow * 1024 + 512 + h * 128, nullptr, 0);
        }
    }
#endif
    if (l < 2) {
#ifndef NO_GATE
        int tid = tid_in; asm volatile("" : "+v"(tid));
        for (int r_ = G - 1 - (int)blockIdx.x; r_ < REP_GATE * (512 + 32); r_ += G) { const int r = r_ % (512 + 32);
            int chunk, joff, nib, row0; float* av = nullptr;
            if (r < 512) { chunk = r; joff = 0; nib = 4; row0 = r * 128; }
            else { const int bs = r - 512; chunk = 512 + (bs >> 1); joff = (bs & 1) * 64; nib = 2; row0 = MP + bs * 64; av = a->out + OUT_AV + ((size_t)l * 32 + bs) * 64 * 512; }
            if (nib == 4) gate_unit<4>(lds, tid, chunk, joff, row0, (const bf16_t*)(ws + WS_WSB) + (size_t)l * 8 * 128 * 128, (const bf16_t*)(ws + WS_VT), (const bf16_t*)(ws + WS_U),
                      (const ssq_t*)(ws + WS_SSQ) + (size_t)(9 + l) * MT, a->in[10] + l * 512, a->in[12] + l * 8 * 128, CAT, av);
            else gate_unit<2>(lds, tid, chunk, joff, row0, (const bf16_t*)(ws + WS_WSB) + (size_t)l * 8 * 128 * 128, (const bf16_t*)(ws + WS_VT), (const bf16_t*)(ws + WS_U),
                      (const ssq_t*)(ws + WS_SSQ) + (size_t)(9 + l) * MT, a->in[10] + l * 512, a->in[12] + l * 8 * 128, CAT, av);
        }
#endif
    } else {
#ifndef NO_BAND
        int tid = tid_in; asm volatile("" : "+v"(tid)); const int wave = tid >> 6;
        const int jl = l - 2; const bf16_t* Q = (const bf16_t*)(ws + WS_U);
        LAS float* btab = (LAS float*)(lds + 76800);
        for (int it = blockIdx.x; it < REP_BAND * (16 * 8 * 16 + 32 * 8); it += G) {
            int r = it % (16 * 8 * 16 + 32 * 8);
            int h, qrow, jstart, nkb, jlo, jhi, relq; const bf16_t* Kb; const bf16_t* Vtb; int ldv; bool hasq;
            if (r < 16 * 8 * 16) { h = r & 7; const int cg4 = (r >> 3) & 15; const int b = r >> 7; const int c0 = cg4 * 4;
                qrow = b * SEQ + c0 * 64 + wave * 32; hasq = true; nkb = 12; jstart = c0 >= 8 ? 0 : 8 - c0; jlo = wave >> 1; jhi = jlo + 8;
                Kb = (const bf16_t*)(ws + WS_PK) + ((long)b * SEQ + (long)(c0 - 8) * 64) * 512 + h * 64;
                Vtb = (const bf16_t*)(ws + WS_PVT) + ((long)b * 512 + h * 64) * 4096 + (long)(c0 - 8) * 64; ldv = 4096;
                relq = 512 + (wave >> 1) * 64 + (wave & 1) * 32 + (tid & 31); }
            else { r -= 16 * 8 * 16; h = r & 7; const int bs = r >> 3; qrow = MP + bs * 64 + wave * 32; hasq = wave < 2; nkb = 9; jstart = 0; jlo = 0; jhi = 8;
                Kb = (const bf16_t*)(ws + WS_SK) + (size_t)bs * 576 * 512 + h * 64; Vtb = (const bf16_t*)(ws + WS_SVT) + ((size_t)bs * 512 + h * 64) * 576; ldv = 576;
                relq = 512 + (wave & 1) * 32 + (tid & 31); }
            __syncthreads();
            for (int i = tid; i < 639; i += NTHR) { const int idx = 638 - i; btab[i] = a->in[16][((size_t)jl * 8 + h) * 513 + 193 + (idx > 319 ? 319 : idx)] * LOG2E; }
            attn_unit<64, true>(lds, tid, Q + (size_t)qrow * 512 + h * 64, hasq, Kb, 512, Vtb, ldv, jstart, nkb, jlo, jhi, CAT + (size_t)qrow * 1024 + h * 64, btab, relq);
        }
#endif
    }
}

__device__ __forceinline__ void fixup_phase(KArgs a, int tid, int l) {
    unsigned char* ws = a->ws; const float* tail = (const float*)(ws + WS_TAIL); const float* head = (const float*)(ws + WS_HEAD); bf16_t* ACT = (bf16_t*)(ws + WS_ACT);
    const float* cw = a->in[22] + (size_t)l * 3 * DFF; const float* sc = a->in[7] + (size_t)l * 32 * 2 * DFF;
    const size_t gt = (size_t)blockIdx.x * NTHR + tid, NT = (size_t)gridDim.x * NTHR;
    constexpr int FV = DFF / 4; constexpr size_t NI = (size_t)NBLK64 * FV;
    for (size_t i0 = gt; i0 < NI; i0 += 2 * NT) {
        f32x4 pm2[2], pm1[2], w0[2], w1[2], h0[2], g0[2], h1[2], g1[2], t0[2], t1[2]; int blk[2], f[2]; bool ok[2], st[2];
#pragma unroll
        for (int k = 0; k < 2; ++k) {
            const size_t i = i0 + k * NT; ok[k] = i < NI; blk[k] = 0; f[k] = 0; st[k] = false;
            if (ok[k]) {
                blk[k] = (int)(i / FV); f[k] = (int)(i % FV) * 4; const int b = blk[k], ff = f[k];
                if (b >= MP / 64) { const int bs = b - MP / 64; pm2[k] = *(const f32x4*)(sc + ((size_t)bs * 2 + 0) * DFF + ff); pm1[k] = *(const f32x4*)(sc + ((size_t)bs * 2 + 1) * DFF + ff); }
                else if ((b & 63) == 0) { pm2[k] = (f32x4){0.f, 0.f, 0.f, 0.f}; pm1[k] = pm2[k]; }
                else { pm2[k] = *(const f32x4*)(tail + ((size_t)(b - 1) * 2 + 0) * DFF + ff); pm1[k] = *(const f32x4*)(tail + ((size_t)(b - 1) * 2 + 1) * DFF + ff); }
                w0[k] = *(const f32x4*)(cw + ff); w1[k] = *(const f32x4*)(cw + DFF + ff);
                const float* hp = head + (size_t)b * 4 * DFF + ff;
                h0[k] = *(const f32x4*)hp; g0[k] = *(const f32x4*)(hp + DFF); h1[k] = *(const f32x4*)(hp + 2 * DFF); g1[k] = *(const f32x4*)(hp + 3 * DFF);
                st[k] = (b >= MP / 64) || ((b & 63) == 63);
                if (st[k]) { t0[k] = *(const f32x4*)(tail + ((size_t)b * 2 + 0) * DFF + ff); t1[k] = *(const f32x4*)(tail + ((size_t)b * 2 + 1) * DFF + ff); }
            }
        }
#pragma unroll
        for (int k = 0; k < 2; ++k) {
            if (ok[k]) {
                const int b = blk[k], ff = f[k];
                const f32x4 c0 = h0[k] + w0[k] * pm2[k] + w1[k] * pm1[k], c1 = h1[k] + w0[k] * pm1[k];
                u32x2 o0, o1;
                o0.x = cvt_pk_bf16(gelu_t(c0[0]) * g0[k][0], gelu_t(c0[1]) * g0[k][1]); o0.y = cvt_pk_bf16(gelu_t(c0[2]) * g0[k][2], gelu_t(c0[3]) * g0[k][3]);
                o1.x = cvt_pk_bf16(gelu_t(c1[0]) * g1[k][0], gelu_t(c1[1]) * g1[k][1]); o1.y = cvt_pk_bf16(gelu_t(c1[2]) * g1[k][2], gelu_t(c1[3]) * g1[k][3]);
                *(u32x2*)(ACT + (size_t)b * 64 * DFF + ff) = o0; *(u32x2*)(ACT + ((size_t)b * 64 + 1) * DFF + ff) = o1;
                if (st[k]) {
                    float* o = (b >= MP / 64) ? a->out + OUT_CS + ((size_t)l * 32 + (b - MP / 64)) * 2 * DFF + ff : a->out + OUT_CP + ((size_t)l * 16 + (b >> 6)) * 2 * DFF + ff;
                    *(f32x4*)o = t0[k]; *(f32x4*)(o + DFF) = t1[k];
                }
            }
        }
    }
}

__device__ __forceinline__ void final_phase(KArgs a, int tid) {
    const ssq_t* ssq = (const ssq_t*)(a->ws + WS_SSQ) + (size_t)4 * MT; const float* g = a->in[25]; const bf16_t* hb = (const bf16_t*)(a->ws + WS_HB);
    const int lane = tid & 63; const int gw = blockIdx.x * NWAVES + (tid >> 6), NGW = gridDim.x * NWAVES;
    f32x4 gg[4];
#pragma unroll
    for (int j = 0; j < 4; ++j) gg[j] = *((const f32x4*)g + lane + 64 * j);
    for (int m0 = gw; m0 < MT; m0 += 4 * NGW) {
        u32x2 w[4][4]; float r[4];
#pragma unroll
        for (int u = 0; u < 4; ++u) { const int m = m0 + u * NGW; if (m < MT) { r[u] = rs_fromu(ssq[m], 1.0f / 1024.0f); const u32x2* hr = (const u32x2*)(hb + (size_t)m * 1024);
#pragma unroll
            for (int j = 0; j < 4; ++j) w[u][j] = hr[lane + 64 * j]; } }
#pragma unroll
        for (int u = 0; u < 4; ++u) { const int m = m0 + u * NGW; if (m < MT) { f32x4* row = (f32x4*)(a->out + (size_t)m * 1024);
#pragma unroll
            for (int j = 0; j < 4; ++j) { f32x4 v; v[0] = __builtin_bit_cast(float, w[u][j].x << 16); v[1] = __builtin_bit_cast(float, w[u][j].x & 0xffff0000u); v[2] = __builtin_bit_cast(float, w[u][j].y << 16); v[3] = __builtin_bit_cast(float, w[u][j].y & 0xffff0000u);
                __builtin_nontemporal_store(v * r[u] * gg[j], row + lane + 64 * j); } } }
    }
}


#define XB_TMO      128
#define XB_XCNT(j)  (256  + 64 * (j))
#define XB_XSUB(j)  (1280 + 64 * (j))
#define XB_XGEN(j)  (2304 + 64 * (j))
#define XB_TOP      3328
#define XB_TOPGEN   3392
#define XCD_BAR_WORDS 3456
#define XB_SPIN_CAP (1u << 18)

__device__ __forceinline__ unsigned xb_ld(unsigned* p)              { return __hip_atomic_load(p, __ATOMIC_RELAXED, __HIP_MEMORY_SCOPE_AGENT); }
__device__ __forceinline__ unsigned xb_add(unsigned* p, unsigned v) { return __hip_atomic_fetch_add(p, v, __ATOMIC_RELAXED, __HIP_MEMORY_SCOPE_AGENT); }
__device__ __forceinline__ unsigned xb_xcc_id() { return (unsigned)__builtin_amdgcn_s_getreg((3 << 11) | 20) & 0xFu; }
#define XB_SPIN(cond, bar) do { unsigned _sp = 0; while (cond) { __builtin_amdgcn_s_sleep(1); \
    if ((++_sp & 255u) == 0u) { if (xb_ld(&(bar)[XB_TMO])) break; if (_sp > XB_SPIN_CAP) { atomicAdd(&(bar)[XB_TMO], 1u); break; } } } } while (0)

struct XcdBarrier {
    unsigned* bar; unsigned x;
    volatile LAS unsigned* st;
};

__device__ __forceinline__ XcdBarrier xcd_barrier_post(unsigned* bar, volatile LAS unsigned* st) {
    XcdBarrier b; b.bar = bar; b.x = xb_xcc_id(); b.st = st;
    if (threadIdx.x == 0) (void)xb_add(&bar[XB_XCNT(b.x)], 1u);
    return b;
}
__device__ __forceinline__ void xcd_barrier_complete(unsigned* bar, unsigned x, unsigned& nloc, unsigned& nx) {
    const unsigned G = gridDim.x * gridDim.y * gridDim.z;
    unsigned sum, cnt, mine, sp = 0u;
    for (;;) {
        sum = 0u; cnt = 0u; mine = 0u;
#pragma unroll
        for (unsigned j = 0; j < 16; ++j) { const unsigned c = xb_ld(&bar[XB_XCNT(j)]); sum += c; cnt += (c > 0u) ? 1u : 0u; mine = (j == x) ? c : mine; }
        if (sum == G) break;
        __builtin_amdgcn_s_sleep(1);
        if ((++sp & 255u) == 0u) { if (xb_ld(&bar[XB_TMO])) break; if (sp > XB_SPIN_CAP) { atomicAdd(&bar[XB_TMO], 1u); break; } }
    }
    nloc = mine > 0u ? mine : 1u; nx = cnt > 0u ? cnt : 1u;
}

__device__ __forceinline__ void xcd_barrier(const XcdBarrier& b) {
    asm volatile("s_waitcnt vmcnt(0)" ::: "memory");
    __syncthreads();
    if (threadIdx.x == 0) {
        unsigned* bar = b.bar;
        __builtin_amdgcn_s_waitcnt(0);
        unsigned nloc = b.st[0], nx = b.st[1];
        if (nloc == 0u) { xcd_barrier_complete(bar, b.x, nloc, nx); b.st[0] = nloc; b.st[1] = nx; }
        const unsigned old = xb_add(&bar[XB_XSUB(b.x)], 1u);
        const unsigned gen = old / nloc;
        if (old + 1u == (gen + 1u) * nloc) {
            __builtin_amdgcn_fence(__ATOMIC_RELEASE, "agent");
            asm volatile("s_waitcnt vmcnt(0)" ::: "memory");
            const unsigned og = xb_add(&bar[XB_TOP], 1u);
            const unsigned tg = og / nx;
            if (og + 1u == (tg + 1u) * nx) xb_add(&bar[XB_TOPGEN], 1u);
            else XB_SPIN(xb_ld(&bar[XB_TOPGEN]) == tg, bar);
            __builtin_amdgcn_fence(__ATOMIC_ACQUIRE, "agent");
            xb_add(&bar[XB_XGEN(b.x)], 1u);
            asm volatile("s_waitcnt vmcnt(0)" ::: "memory");
        } else {
            XB_SPIN(xb_ld(&bar[XB_XGEN(b.x)]) == gen, bar);
            __builtin_amdgcn_fence(__ATOMIC_ACQUIRE, "agent");
            asm volatile("s_waitcnt vmcnt(0)" ::: "memory");
        }
    }
    __syncthreads();
}

#ifndef REP_P0
#define REP_P0 1
#endif
#ifndef REP_MIX
#define REP_MIX 1
#endif
#ifndef REP_UP
#define REP_UP 1
#endif
#ifndef STAG_IN
#define STAG_IN 0
#endif
#ifndef STAG_OUT
#define STAG_OUT 0
#endif
#ifndef STAG_UP
#define STAG_UP 0
#endif
#ifndef STAG_DOWN
#define STAG_DOWN 0
#endif
#define STAG(d) ((((unsigned)blockIdx.x >> 3) & 1u) * (unsigned)(d))
#ifndef REP_FIX
#define REP_FIX 1
#endif
#ifndef REP_INA
#define REP_INA 1
#endif
#ifndef REP_INB
#define REP_INB 1
#endif
#ifndef REP_OUT
#define REP_OUT 1
#endif
#ifndef REP_DOWN
#define REP_DOWN 1
#endif
__device__ __forceinline__ void launder(int& t) { asm volatile("" : "+v"(t)); }
__global__ void __launch_bounds__(NTHR, 2) fwd_kernel(Args a) {
    extern __shared__ __attribute__((aligned(16))) unsigned char lds_raw[];
    LAS unsigned char* lds = (LAS unsigned char*)lds_raw;
    int tid = threadIdx.x; const int G = gridDim.x;
    KArgs kp = (KArgs)__builtin_amdgcn_kernarg_segment_ptr();
    volatile LAS unsigned* bst = (volatile LAS unsigned*)(lds + LDS_BYTES - 64);
    if (tid < 2) bst[tid] = 0u;
    __syncthreads();
    XcdBarrier bar; bar.bar = (unsigned*)(a.ws + WS_BAR); bar.x = 0; bar.st = bst;
    if (a.coop) bar = xcd_barrier_post((unsigned*)(a.ws + WS_BAR), bst);
#define PH_ARGS() KArgs q = kp; asm volatile("" : "+s"(q)); unsigned char* ws = q->ws; ssq_t* ssqb = (ssq_t*)(ws + WS_SSQ); bf16_t* HB = (bf16_t*)(ws + WS_HB); (void)ssqb; (void)HB;
    int ph = 0;
#ifndef REP_SYNC
#define REP_SYNC 1
#endif
#define SEAM() do { if (a.coop && ph + 1 < a.ph_hi) { for (int rs_ = 0; rs_ < REP_SYNC; ++rs_) { if (a.coop == 2) cg::this_grid().sync(); else xcd_barrier(bar); } } } while (0)
#define IN_PH() (launder(tid), ph >= a.ph_lo && ph < a.ph_hi)
#ifndef EN_MASK
#define EN_MASK 0xffff
#endif
#define EN(k) ((EN_MASK >> (k)) & 1)

    if (IN_PH()) { PH_ARGS(); for (int rep = 0; rep < REP_P0; ++rep) p0_prologue(q, lds, tid); SEAM(); } ++ph;

#pragma unroll 1
    for (int l = 0; l < 4; ++l) {
        if (IN_PH()) { PH_ARGS();
            if (l < 2) { if (EN(1)) {
                pg8::Gemm g{HB, (const bf16_t*)(ws + WS_WINA) + (size_t)l * 1536 * 1024, MT, 1536, 1024}; pg8::StaticOrder S; S.init(MT, 1536, G, (int)blockIdx.x);
                EpiInA E{ssqb + (size_t)l * MT, (bf16_t*)(ws + WS_U), (bf16_t*)(ws + WS_VT), (bf16_t*)(ws + WS_QM), ssqb + (size_t)(9 + l) * MT, 0.08838834764831845f * LOG2E, (LAS const float*)(lds + 131072)};
                S.rep = REP_INA; S.epi_all = 1; pg8::gemm_phase<EpiInA, pg8::StaticOrder, true, true>(lds, g, S, E, tid, STAG(STAG_IN)); }
                if (EN(2) && l == 0) {
                    pg8::Gemm g2{(const bf16_t*)(ws + WS_MPB), (const bf16_t*)(ws + WS_WMEM), 4096, 4096, 1024}; pg8::StaticOrder S2; S2.init(4096, 4096, G, (int)blockIdx.x);
                    EpiMem E2{(const float*)(ws + WS_RMEM), q->out, (bf16_t*)(ws + WS_MEMK), (bf16_t*)(ws + WS_MEMVT)};
                    pg8::gemm_phase<EpiMem, pg8::StaticOrder, true, true>(lds, g2, S2, E2, tid);
                }
            } else if (EN(3)) {
                const int N = l == 2 ? 2048 : 1024;
                pg8::Gemm g{HB, (const bf16_t*)(ws + WS_WB) + (size_t)(l == 2 ? 0 : 2048) * 1024, MT, N, 1024}; pg8::StaticOrder S; S.init(MT, N, G, (int)blockIdx.x);
                EpiInB E{ssqb + (size_t)l * MT, (bf16_t*)(ws + WS_U), (bf16_t*)(ws + WS_QM), (bf16_t*)(ws + WS_PK), (bf16_t*)(ws + WS_PVT), (bf16_t*)(ws + WS_SK), (bf16_t*)(ws + WS_SVT), q->out,
                         0.125f * LOG2E, 0.08838834764831845f * LOG2E, (LAS const float*)(lds + 131072)};
                S.rep = REP_INB; S.epi_all = EPIALL_INB; pg8::gemm_phase<EpiInB, pg8::StaticOrder, true, true>(lds, g, S, E, tid, STAG(STAG_IN));
            }
            SEAM();
        } ++ph;
        if (IN_PH()) { PH_ARGS(); for (int rep = 0; rep < REP_MIX; ++rep) mixer_phase(q, lds, tid, l); SEAM(); } ++ph;
        if (IN_PH()) { PH_ARGS(); if (EN(5)) {
            pg8::Gemm g{(const bf16_t*)(ws + WS_CAT), (const bf16_t*)(ws + WS_WOUT) + (size_t)l * 1024 * 1024, MT, 1024, 1024}; pg8::StaticOrder S; S.init(MT, 1024, G, (int)blockIdx.x);
            EpiRes E{HB, ssqb + (size_t)(5 + l) * MT};
            S.rep = REP_OUT; S.epi_all = 1; pg8::gemm_phase<EpiRes, pg8::StaticOrder, true, true>(lds, g, S, E, tid, STAG(STAG_OUT)); }
            SEAM();
        } ++ph;
        if (IN_PH()) { PH_ARGS(); if (EN(6)) {
            pg8::Gemm g{HB, (const bf16_t*)(ws + WS_WUP) + (size_t)l * 5632 * 1024, MT, 5632, 1024}; pg8::StaticOrder S; S.init(MT, 5632, G, (int)blockIdx.x);
            EpiUp E{ssqb + (size_t)(5 + l) * MT, q->in[22] + (size_t)l * 3 * DFF, q->in[23] + (size_t)l * DFF, (bf16_t*)(ws + WS_ACT), (float*)(ws + WS_TAIL), (float*)(ws + WS_HEAD), (LAS const float*)(lds + 131072)};
            S.rep = REP_UP; pg8::gemm_phase<EpiUp, pg8::StaticOrder, true, true>(lds, g, S, E, tid, STAG(STAG_UP)); }
            SEAM();
        } ++ph;
        if (IN_PH()) { PH_ARGS(); for (int rep = 0; rep < REP_FIX; ++rep) fixup_phase(q, tid, l); SEAM(); } ++ph;
        if (IN_PH()) { PH_ARGS(); if (EN(8)) {
            pg8::Gemm g{(const bf16_t*)(ws + WS_ACT), (const bf16_t*)(ws + WS_WDOWN) + (size_t)l * 1024 * DFF, MT, 1024, DFF}; pg8::StaticOrder S; S.init(MT, 1024, G, (int)blockIdx.x);
            EpiRes E{HB, ssqb + (size_t)(l + 1) * MT};
            S.rep = REP_DOWN; S.epi_all = 1; pg8::gemm_phase<EpiRes, pg8::StaticOrder, true, true>(lds, g, S, E, tid, STAG(STAG_DOWN)); }
            SEAM();
        } ++ph;
    }
    if (IN_PH()) { PH_ARGS(); for (int rep = 0; rep < REP_FIX; ++rep) final_phase(q, tid); } ++ph;
#undef SEAM
#undef IN_PH
}
constexpr int N_PHASES = 26;

#ifndef MK_MULTI
#define MK_MULTI 0
#endif

extern "C" void kernel_launch(void* const* d_in, const int* in_sizes, int n_in, void* d_out, int out_size, void* d_ws, size_t ws_size, hipStream_t stream) {
    static int grid = 0;
    if (grid == 0) {
        if (n_in != 26 || (size_t)out_size != OUT_END || ws_size < WS_END) { fprintf(stderr, "kernel_launch: unexpected sizes n_in %d out %d ws %zu (need %zu)\n", n_in, out_size, ws_size, (size_t)WS_END); grid = -1; return; }
        int dev = 0, cus = 0, per_cu = 0;
        if (hipGetDevice(&dev) != hipSuccess || hipDeviceGetAttribute(&cus, hipDeviceAttributeMultiprocessorCount, dev) != hipSuccess) { grid = -1; return; }
        if (hipFuncSetAttribute((const void*)fwd_kernel, hipFuncAttributeMaxDynamicSharedMemorySize, LDS_BYTES) != hipSuccess) { fprintf(stderr, "kernel_launch: hipFuncSetAttribute failed\n"); grid = -1; return; }
        if (hipOccupancyMaxActiveBlocksPerMultiprocessor(&per_cu, (const void*)fwd_kernel, NTHR, LDS_BYTES) != hipSuccess || per_cu < 1) { fprintf(stderr, "kernel_launch: occupancy query says %d\n", per_cu); per_cu = 1; }
        (void)hipGetLastError();
        grid = cus * 1;
    }
    if (grid < 0) return;
    Args a{};
    for (int i = 0; i < 26; ++i) a.in[i] = (const float*)d_in[i];
    a.out = (float*)d_out; a.ws = (unsigned char*)d_ws;
#if MK_MULTI
    for (int p = 0; p < N_PHASES; ++p) { a.ph_lo = p; a.ph_hi = p + 1; a.coop = 0; hipLaunchKernelGGL(fwd_kernel, dim3(grid), dim3(NTHR), LDS_BYTES, stream, a); }
#else
    a.ph_lo = 0; a.ph_hi = N_PHASES; a.coop = 1;
    if (hipMemsetAsync((char*)d_ws + WS_BAR, 0, BAR_BYTES, stream) != hipSuccess) { fprintf(stderr, "memset failed\n"); return; }
    void* args[] = {&a};
    hipError_t e = hipLaunchCooperativeKernel((const void*)fwd_kernel, dim3(grid), dim3(NTHR), args, LDS_BYTES, stream);
    if (e != hipSuccess) fprintf(stderr, "cooperative launch failed: %s (grid %d)\n", hipGetErrorString(e), grid);
#endif
}
```

```cpp
#include <hip/hip_runtime.h>
#include <hip/hip_cooperative_groups.h>
#include <cstdio>
#include <cstdint>
namespace cg = cooperative_groups;
namespace pg8 {
#define PG8_LAS __attribute__((address_space(3)))
typedef unsigned short bf16_t;
typedef short bf16x8 __attribute__((ext_vector_type(8)));
typedef float f32x4 __attribute__((ext_vector_type(4)));
typedef unsigned u32x4 __attribute__((ext_vector_type(4)));
constexpr int BM = 256, BK = 64, HALF = 128, HTB = HALF * BK * 2  , STAGE_BYTES = 8 * HTB, NXCD = 8, WGM = 8;

__host__ __device__ __forceinline__ int lds_byte(int r, int c) { const int st = (r >> 4) * 2 + (c >> 5), rr = r & 15, cc = c & 31, ob = rr * 64 + cc * 2; return st * 1024 + (ob ^ (((ob >> 9) & 1) << 5)); }
__host__ __device__ __forceinline__ void stage_rc(int b, int& R, int& C) { const int st = b / 1024, sb = b % 1024, swz = sb ^ (((sb >> 9) & 1) << 5); R = (st >> 1) * 16 + swz / 64; C = (st & 1) * 32 + (swz % 64) / 2; }
__host__ __device__ __forceinline__ int perm32(int rho) { const int n = rho >> 4, i = rho & 15; return 8 * (i >> 2) + 4 * n + (i & 3); }

struct Unit { int pm, pn, pass; };
struct Gemm { const bf16_t* A; const bf16_t* Bt; int M, N, K; };

struct StaticOrder {
    int nM, nN, nwg, G, c, rep = 1, epi_all = 0, epi_twice = 0;
    __host__ __device__ void init(int M, int N, int G_, int c_) { nM = M / BM; nN = N / BM; nwg = nM * nN; G = G_; c = c_; }
    __host__ __device__ bool next(int i, Unit& u) const {
        const unsigned L = (unsigned)i * (unsigned)G + (unsigned)c, n = (unsigned)nwg; if (L >= n * (unsigned)rep) return false;
        unsigned w = L; int p = 0; while (w >= n) { w -= n; ++p; }
        u.pass = p - (rep - 1);
        const unsigned q = n >> 3, r = n & 7u, xcd = w & 7u, off = w >> 3;
        const unsigned wgid = (xcd < r ? xcd * (q + 1u) : r * (q + 1u) + (xcd - r) * q) + off;
        const unsigned nig = (unsigned)(WGM * nN), gid = wgid / nig, rem = wgid - gid * nig, fm = gid * WGM;
        const unsigned gsz = ((unsigned)nM - fm) < (unsigned)WGM ? ((unsigned)nM - fm) : (unsigned)WGM;
        const unsigned q2 = rem / gsz;
        u.pm = (int)(fm + (rem - q2 * gsz)); u.pn = (int)q2; return true;
    }
    __device__ __forceinline__ void a_ready(const Unit&) const {}
    __device__ __forceinline__ void done(const Unit&) const {}
};

__device__ __forceinline__ unsigned cvt_pk_bf16(float lo, float hi) { unsigned r; asm volatile("v_cvt_pk_bf16_f32 %0, %1, %2" : "=v"(r) : "v"(lo), "v"(hi)); return r; }
template <class Epi, class Sched, bool ALIGN_EPI = false, bool SP2 = false>
__device__ __forceinline__ void gemm_phase(PG8_LAS unsigned char* lds, const Gemm g, const Sched& S, const Epi& E, const int tid, const unsigned delay = 0u) {
    const int wid = __builtin_amdgcn_readfirstlane(tid >> 6), lane = tid & 63, wr = wid >> 2, wc = wid & 3, fr = lane & 15, fq = lane >> 4;
    const int K = g.K, nt = K / BK;
    unsigned voffA[2], voffB[2];
#pragma unroll
    for (int i = 0; i < 2; ++i) { int R, C; stage_rc(tid * 16 + i * 8192, R, C); const int Rb = Epi::PERM ? ((R & ~31) + perm32(R & 31)) : R;
        voffA[i] = (unsigned)(R * K + C) * 2u; voffB[i] = (unsigned)(Rb * K + C) * 2u; }
    const size_t kstep = (size_t)(BK * 2);
    const size_t hstep = (size_t)HALF * K * 2;
    const size_t tstep = 2 * hstep;
    const unsigned ldsw = (unsigned)wid * 1024u;
    const int aoff = lds_byte(wr * 64 + fr, fq * 8), boff = lds_byte(wc * 32 + fr, fq * 8);
#define PG8_SA(b, h) (((b) * 2 + (h)) * HTB)
#define PG8_SB(b, h) ((4 + (b) * 2 + (h)) * HTB)
#define PG8_STAGE(bufoff, gbase, voff) do { _Pragma("unroll") for (int _i = 0; _i < 2; ++_i) \
        __builtin_amdgcn_global_load_lds((const unsigned*)((const char*)(gbase) + (voff)[_i]), (PG8_LAS unsigned*)(lds + (bufoff) + ldsw + _i * 8192), 16, 0, 0); } while (0)
#define PG8_LDA(dst, b, h) do { _Pragma("unroll") for (int m = 0; m < 4; ++m) _Pragma("unroll") for (int k = 0; k < 2; ++k) dst[m][k] = *(const PG8_LAS bf16x8*)(lds + PG8_SA(b, h) + aoff + m * 2048 + k * 1024); } while (0)
#define PG8_LDB(dst, b, h) do { _Pragma("unroll") for (int n = 0; n < 2; ++n) _Pragma("unroll") for (int k = 0; k < 2; ++k) dst[n][k] = *(const PG8_LAS bf16x8*)(lds + PG8_SB(b, h) + boff + n * 2048 + k * 1024); } while (0)
#define PG8_MMA(ai, bj, At, Bt) do { __builtin_amdgcn_s_setprio(1); _Pragma("unroll") for (int m = 0; m < 4; ++m) _Pragma("unroll") for (int n = 0; n < 2; ++n) _Pragma("unroll") for (int k = 0; k < 2; ++k) \
        acc[ai][bj][m][n] = __builtin_amdgcn_mfma_f32_16x16x32_bf16(Bt[n][k], At[m][k], acc[ai][bj][m][n], 0, 0, 0); __builtin_amdgcn_s_setprio(0); } while (0)
#define PG8_WAIT_V(n) asm volatile("s_waitcnt vmcnt(" #n ")" ::: "memory")
#define PG8_WAIT_L(n) asm volatile("s_waitcnt lgkmcnt(" #n ")" ::: "memory")
#define PG8_BAR __builtin_amdgcn_s_barrier()
#define PG8_SCHED __builtin_amdgcn_sched_barrier(0)
    Unit cur, nxt; int ui = 0;
    if (!S.next(0, cur)) return;
    if (delay) { if (tid == 0) { const unsigned long long t0 = __builtin_amdgcn_s_memrealtime(); while (__builtin_amdgcn_s_memrealtime() - t0 < delay) __builtin_amdgcn_s_sleep(8); } __syncthreads(); }
    unsigned long long rnext = 0ull;
    if constexpr (Epi::USE_R) { if (tid < 256) rnext = E.ssq[cur.pm * BM + tid]; }
    float cnext = 0.f;
    if constexpr (Epi::USE_C) cnext = E.c_load(cur, tid);
    f32x4 acc[2][2][4][2];
#pragma unroll
    for (int a = 0; a < 2; ++a)
#pragma unroll
        for (int b = 0; b < 2; ++b)
#pragma unroll
            for (int m = 0; m < 4; ++m)
#pragma unroll
                for (int n = 0; n < 2; ++n) acc[a][b][m][n] = (f32x4){0.f, 0.f, 0.f, 0.f};
    bf16x8 At[4][2], B0[2][2], B1[2][2];
    const char* cA = (const char*)g.A + (size_t)cur.pm * tstep; const char* cB = (const char*)g.Bt + (size_t)cur.pn * tstep;
    S.a_ready(cur);
    if constexpr (SP2) {
        PG8_STAGE(PG8_SB(0, 0), cB, voffB); PG8_STAGE(PG8_SB(0, 1), cB + hstep, voffB); PG8_STAGE(PG8_SA(0, 0), cA, voffA); PG8_STAGE(PG8_SA(0, 1), cA + hstep, voffA);
        if (wr == 1) PG8_BAR;
        PG8_WAIT_V(2); PG8_BAR;
        PG8_STAGE(PG8_SB(1, 0), cB + kstep, voffB); PG8_STAGE(PG8_SA(1, 0), cA + kstep, voffA); PG8_STAGE(PG8_SB(1, 1), cB + hstep + kstep, voffB);
        PG8_WAIT_V(6); PG8_BAR;
    } else {
        PG8_STAGE(PG8_SB(0, 0), cB, voffB); PG8_STAGE(PG8_SA(0, 0), cA, voffA); PG8_STAGE(PG8_SB(0, 1), cB + hstep, voffB); PG8_STAGE(PG8_SA(0, 1), cA + hstep, voffA);
        if (wr == 1) PG8_BAR;
        PG8_WAIT_V(4); PG8_BAR;
        PG8_STAGE(PG8_SB(1, 0), cB + kstep, voffB); PG8_STAGE(PG8_SA(1, 0), cA + kstep, voffA); PG8_STAGE(PG8_SB(1, 1), cB + hstep + kstep, voffB);
        PG8_WAIT_V(6); PG8_BAR;
    }
    for (;;) {
        const bool has_next = S.next(ui + 1, nxt);
        const char* nA = has_next ? (const char*)g.A + (size_t)nxt.pm * tstep : cA; const char* nB = has_next ? (const char*)g.Bt + (size_t)nxt.pn * tstep : cB;
        for (int t = 0; t < nt; t += 2) {
            const bool last = (t == nt - 2);
            const char* a1 = cA + (size_t)(t + 1) * kstep;
            const char* a2 = last ? nA : cA + (size_t)(t + 2) * kstep; const char* b2 = last ? nB : cB + (size_t)(t + 2) * kstep;
            const char* a3 = a2 + kstep; const char* b3 = b2 + kstep;
            if (last && has_next) S.a_ready(nxt);
            if constexpr (SP2) {
            PG8_LDB(B0, 0, 0); PG8_LDB(B1, 0, 1); PG8_SCHED; PG8_LDA(At, 0, 0); PG8_STAGE(PG8_SA(1, 1), a1 + hstep, voffA);
            PG8_WAIT_V(8); PG8_WAIT_L(0); PG8_BAR; PG8_MMA(0, 0, At, B0); PG8_MMA(0, 1, At, B1); PG8_BAR; PG8_SCHED;
            PG8_LDA(At, 0, 1); PG8_STAGE(PG8_SB(0, 0), b2, voffB); PG8_STAGE(PG8_SB(0, 1), b2 + hstep, voffB); PG8_STAGE(PG8_SA(0, 0), a2, voffA);
            PG8_WAIT_V(8); PG8_WAIT_L(0); PG8_BAR; PG8_MMA(1, 0, At, B0); PG8_MMA(1, 1, At, B1); PG8_BAR; PG8_SCHED;
            PG8_LDB(B0, 1, 0); PG8_LDB(B1, 1, 1); PG8_SCHED; PG8_LDA(At, 1, 0); PG8_STAGE(PG8_SA(0, 1), a2 + hstep, voffA);
            PG8_WAIT_V(8); PG8_WAIT_L(0); PG8_BAR; PG8_MMA(0, 0, At, B0); PG8_MMA(0, 1, At, B1); PG8_BAR; PG8_SCHED;
            PG8_LDA(At, 1, 1); PG8_STAGE(PG8_SB(1, 0), b3, voffB); PG8_STAGE(PG8_SB(1, 1), b3 + hstep, voffB); PG8_STAGE(PG8_SA(1, 0), a3, voffA);
            PG8_WAIT_V(8); PG8_WAIT_L(0); PG8_BAR; PG8_MMA(1, 0, At, B0); PG8_MMA(1, 1, At, B1); PG8_BAR; PG8_SCHED;
            } else {
            PG8_LDB(B0, 0, 0); PG8_SCHED; PG8_LDA(At, 0, 0); PG8_STAGE(PG8_SA(1, 1), a1 + hstep, voffA);
            PG8_WAIT_L(8); PG8_BAR; PG8_WAIT_L(0); PG8_MMA(0, 0, At, B0); PG8_BAR; PG8_SCHED;
            PG8_LDB(B1, 0, 1); PG8_STAGE(PG8_SB(0, 0), b2, voffB);
            PG8_BAR; PG8_WAIT_L(0); PG8_MMA(0, 1, At, B1); PG8_BAR;
            PG8_LDA(At, 0, 1); PG8_STAGE(PG8_SA(0, 0), a2, voffA);
            PG8_BAR; PG8_WAIT_L(0); PG8_MMA(1, 0, At, B0); PG8_BAR; PG8_SCHED;
            PG8_STAGE(PG8_SB(0, 1), b2 + hstep, voffB);
            PG8_WAIT_V(6); PG8_BAR; PG8_MMA(1, 1, At, B1); PG8_BAR;
            PG8_LDB(B0, 1, 0); PG8_SCHED; PG8_LDA(At, 1, 0); PG8_STAGE(PG8_SA(0, 1), a2 + hstep, voffA);
            PG8_WAIT_L(8); PG8_BAR; PG8_WAIT_L(0); PG8_MMA(0, 0, At, B0); PG8_BAR; PG8_SCHED;
            PG8_LDB(B1, 1, 1); PG8_STAGE(PG8_SB(1, 0), b3, voffB);
            PG8_BAR; PG8_WAIT_L(0); PG8_MMA(0, 1, At, B1); PG8_BAR;
            PG8_LDA(At, 1, 1); PG8_STAGE(PG8_SA(1, 0), a3, voffA);
            PG8_BAR; PG8_WAIT_L(0); PG8_MMA(1, 0, At, B0); PG8_BAR; PG8_SCHED;
            PG8_STAGE(PG8_SB(1, 1), b3 + hstep, voffB);
            PG8_WAIT_V(6); PG8_BAR; PG8_MMA(1, 1, At, B1); PG8_BAR;
            }
        }
        if constexpr (ALIGN_EPI) { if (wr == 0) PG8_BAR; }
        if constexpr (!Epi::AFTER_DRAIN) { if constexpr (Epi::USE_R) { if (tid < 256) ((PG8_LAS float*)(lds + 131072))[tid] = E.r_of(rnext); if constexpr (Epi::USE_C) ((PG8_LAS float*)(lds + 131072 + 1024))[tid] = cnext; __syncthreads(); }
        if (S.epi_all || cur.pass == 0) { E(acc, cur, wr, wc, fr, fq); if constexpr (Epi::TWICE) { asm volatile("" ::: "memory"); E(acc, cur, wr, wc, fr, fq); } } S.done(cur); }
        if (!has_next) break;
        if constexpr (Epi::USE_R) { if (tid < 256) rnext = E.ssq[nxt.pm * BM + tid]; }
        if constexpr (Epi::USE_C) cnext = E.c_load(nxt, tid);
#pragma unroll
        for (int a = 0; a < 2; ++a)
#pragma unroll
            for (int b = 0; b < 2; ++b)
#pragma unroll
                for (int m = 0; m < 4; ++m)
#pragma unroll
                    for (int n = 0; n < 2; ++n) acc[a][b][m][n] = (f32x4){0.f, 0.f, 0.f, 0.f};
        cur = nxt; cA = nA; cB = nB; ++ui;
        if constexpr (ALIGN_EPI) { if (wr == 1) PG8_BAR; }
    }
    PG8_WAIT_V(0);
    if constexpr (!ALIGN_EPI) { if (wr == 0) PG8_BAR; }
    PG8_BAR;
    if constexpr (Epi::AFTER_DRAIN) { E.fused(acc, cur, wr, wc, fr, fq, lds, wid, lane); S.done(cur); }
#undef PG8_SA
#undef PG8_SB
#undef PG8_STAGE
#undef PG8_LDA
#undef PG8_LDB
#undef PG8_MMA
#undef PG8_WAIT_V
#undef PG8_WAIT_L
#undef PG8_BAR
#undef PG8_SCHED
}
}
#ifndef EPI2_UP
#define EPI2_UP 0
#endif
#ifndef EPIALL_INB
#define EPIALL_INB 1
#endif
#ifndef NOSTORE_INB
#define NOSTORE_INB 0
#endif

#define LAS __attribute__((address_space(3)))
typedef unsigned short bf16_t;
typedef short bf16x8 __attribute__((ext_vector_type(8)));
typedef float f32x4 __attribute__((ext_vector_type(4)));
typedef float f32x16 __attribute__((ext_vector_type(16)));
typedef unsigned u32x4 __attribute__((ext_vector_type(4)));
typedef unsigned u32x2 __attribute__((ext_vector_type(2)));
using pg8::cvt_pk_bf16;

constexpr int NWAVES = 8, NTHR = 512;
constexpr int DM = 1024, DFF = 2816, SEQ = 4096, NB = 16, NBS = 32, DSEQ = 64;
constexpr int MP = NB * SEQ, MS = NBS * DSEQ, MT = MP + MS;
constexpr int NBLK64 = MT / 64;
constexpr float EPS = 1e-6f, LOG2E = 1.4426950408889634f;
constexpr int LDS_BYTES = 147456;

constexpr size_t OUT_Y = 0;
constexpr size_t OUT_MK = (size_t)MT * DM;
constexpr size_t OUT_MV = OUT_MK + (size_t)4 * 16 * 256 * 512;
constexpr size_t OUT_BK = OUT_MV + (size_t)4 * 16 * 256 * 512;
constexpr size_t OUT_BV = OUT_BK + (size_t)16 * 512 * 512;
constexpr size_t OUT_CP = OUT_BV + (size_t)16 * 512 * 512;
constexpr size_t OUT_AV = OUT_CP + (size_t)4 * 16 * 2 * DFF;
constexpr size_t OUT_SK = OUT_AV + (size_t)2 * 32 * 64 * 512;
constexpr size_t OUT_SV = OUT_SK + (size_t)32 * 64 * 512;
constexpr size_t OUT_CS = OUT_SV + (size_t)32 * 64 * 512;
constexpr size_t OUT_END = OUT_CS + (size_t)4 * 32 * 2 * DFF;

constexpr size_t al256(size_t x) { return (x + 255) & ~(size_t)255; }
constexpr size_t WS_BAR = 0, BAR_BYTES = 16384;
constexpr size_t WS_SSQ = BAR_BYTES;
constexpr size_t WS_RMEM = al256(WS_SSQ + (size_t)11 * MT * 8);
constexpr size_t WS_WINA = al256(WS_RMEM + 4096 * 4);
constexpr size_t WS_WB = WS_WINA + (size_t)2 * 1536 * 1024 * 2;
constexpr size_t WS_WMEM = WS_WB + (size_t)3072 * 1024 * 2;
constexpr size_t WS_WOUT = WS_WMEM + (size_t)4096 * 1024 * 2;
constexpr size_t WS_WUP = WS_WOUT + (size_t)4096 * 1024 * 2;
constexpr size_t WS_WDOWN = WS_WUP + (size_t)4 * 5632 * 1024 * 2;
constexpr size_t WS_WSB = WS_WDOWN + (size_t)4 * 1024 * 2816 * 2;
constexpr size_t WS_MPB = WS_WSB + (size_t)2 * 8 * 128 * 128 * 2;
constexpr size_t WS_HB = WS_MPB + (size_t)4096 * 1024 * 2;
constexpr size_t WS_MEMK = WS_HB + (size_t)MT * 1024 * 2;
constexpr size_t WS_MEMVT = WS_MEMK + (size_t)4 * 48 * 256 * 512 * 2;
constexpr size_t WS_PK = WS_MEMVT + (size_t)4 * 48 * 256 * 512 * 2;
constexpr size_t WS_PVT = WS_PK + (size_t)MP * 512 * 2;
constexpr size_t WS_SK = WS_PVT + (size_t)MP * 512 * 2;
constexpr size_t WS_SVT = WS_SK + (size_t)32 * 576 * 512 * 2;
constexpr size_t WS_TAIL = WS_SVT + (size_t)32 * 576 * 512 * 2;
constexpr size_t WS_HEAD = WS_TAIL + (size_t)NBLK64 * 2 * DFF * 4;
constexpr size_t WS_OVL = WS_HEAD + (size_t)NBLK64 * 4 * DFF * 4;
constexpr size_t WS_ACT = WS_OVL;
constexpr size_t WS_U = WS_OVL;
constexpr size_t WS_VT = WS_U + (size_t)MT * 512 * 2;
constexpr size_t WS_QM = WS_VT + (size_t)MT * 512 * 2;
constexpr size_t WS_CAT = WS_QM + (size_t)MT * 512 * 2;
constexpr size_t WS_END = WS_OVL + (size_t)MT * DFF * 2;
static_assert(WS_CAT + (size_t)MT * 1024 * 2 <= WS_END, "overlay");
static_assert(WS_END <= (size_t)1073741824, "workspace budget");

__device__ __forceinline__ float bf2f(unsigned short b) { return __builtin_bit_cast(float, (unsigned)b << 16); }
__device__ __forceinline__ unsigned short f2bf(float f) { unsigned u = __builtin_bit_cast(unsigned, f); return (unsigned short)((u + 0x7fffu + ((u >> 16) & 1u)) >> 16); }
__device__ __forceinline__ float gelu_t(float x) {
    const float t = x * (1.0f + 0.044715f * x * x);
    const float e = __builtin_amdgcn_exp2f(-2.302208198f * t);
    return x * __builtin_amdgcn_rcpf(1.0f + e);
}
typedef unsigned long long ssq_t;
__device__ __forceinline__ float rs_from(float ssq, float invn) { return rsqrtf(ssq * invn + EPS); }
__device__ __forceinline__ float rs_fromu(ssq_t v, float invn) { return rsqrtf((float)v * (invn * (1.0f / 1048576.0f)) + EPS); }
__device__ __forceinline__ ssq_t to_fix(float ss) { return (ssq_t)(ss * 1048576.0f); }
__device__ __forceinline__ u32x4 pack8(const f32x4& a, const f32x4& b) { u32x4 w; w.x = cvt_pk_bf16(a[0], a[1]); w.y = cvt_pk_bf16(a[2], a[3]); w.z = cvt_pk_bf16(b[0], b[1]); w.w = cvt_pk_bf16(b[2], b[3]); return w; }
__device__ __forceinline__ float wave_sum(float v) {
#pragma unroll
    for (int o = 1; o < 64; o <<= 1) v += __shfl_xor(v, o);
    return v;
}
#define MFMA32(a, b, c) __builtin_amdgcn_mfma_f32_32x32x16_bf16((a), (b), (c), 0, 0, 0)
__device__ __forceinline__ int crow(int r, int hi) { return (r & 3) + 8 * (r >> 2) + 4 * hi; }

typedef f32x4 AccT[2][2][4][2];

struct EpiInA {
    static constexpr bool PERM = true, AFTER_DRAIN = false, TWICE = false, USE_R = true, USE_C = false;
    const ssq_t* ssq; bf16_t* U; bf16_t* VT; bf16_t* QM; ssq_t* ssqv; float qscale; LAS const float* rtab;
    __device__ __forceinline__ float r_of(ssq_t v) const { return rs_fromu(v, 1.0f / 1024.0f); }
    __device__ __forceinline__ void operator()(const AccT& acc, const pg8::Unit& u, int wr, int wc, int fr, int fq) const {
        const int row0 = u.pm * 256 + wr * 64 + fr; const int ty = u.pn >> 1; const int cb = (u.pn & 1) * 256 + wc * 32 + 8 * fq;
#pragma unroll
        for (int ai = 0; ai < 2; ++ai)
#pragma unroll
            for (int m = 0; m < 4; ++m) {
                const int row = row0 + ai * 128 + m * 16; const float r = rtab[row - u.pm * 256];
                if (ty == 0) {
#pragma unroll
                    for (int bj = 0; bj < 2; ++bj) { f32x4 a = acc[ai][bj][m][0] * r, b = acc[ai][bj][m][1] * r;
#pragma unroll
                        for (int e = 0; e < 4; ++e) { a[e] = gelu_t(a[e]); b[e] = gelu_t(b[e]); }
                        *(u32x4*)(U + (size_t)row * 512 + cb + bj * 128) = pack8(a, b); }
                } else if (ty == 2) {
                    const float s = r * qscale;
#pragma unroll
                    for (int bj = 0; bj < 2; ++bj) { f32x4 a = acc[ai][bj][m][0] * s, b = acc[ai][bj][m][1] * s;
                        *(u32x4*)(QM + (size_t)row * 512 + cb + bj * 128) = pack8(a, b); }
                } else {
                    float ss = 0.f; bf16_t* vt = VT + (size_t)(row >> 7) * 512 * 128 + (row & 127);
#pragma unroll
                    for (int bj = 0; bj < 2; ++bj)
#pragma unroll
                        for (int n = 0; n < 2; ++n)
#pragma unroll
                            for (int e = 0; e < 4; ++e) { const unsigned short hb = f2bf(gelu_t(acc[ai][bj][m][n][e] * r)); const float vr = bf2f(hb); ss += vr * vr;
                                vt[(size_t)(cb + bj * 128 + 4 * n + e) * 128] = hb; }
                    ss += __shfl_xor(ss, 16); ss += __shfl_xor(ss, 32);
                    if (fq == 0) atomicAdd(ssqv + row, to_fix(ss));
                }
            }
    }
};

struct EpiInB {
    static constexpr bool PERM = true, AFTER_DRAIN = false, TWICE = false, USE_R = true, USE_C = false;
    const ssq_t* ssq; bf16_t* Q; bf16_t* QM; bf16_t* PK; bf16_t* PVT; bf16_t* SK; bf16_t* SVT; float* out; float qscale, mscale; LAS const float* rtab;
    __device__ __forceinline__ float r_of(ssq_t v) const { return rs_fromu(v, 1.0f / 1024.0f); }
    __device__ __forceinline__ void operator()(const AccT& acc, const pg8::Unit& u, int wr, int wc, int fr, int fq) const {
        const int row0 = u.pm * 256 + wr * 64 + fr; const int ty = u.pn >> 1; const int cb = (u.pn & 1) * 256 + wc * 32 + 8 * fq;
        const bool samp = u.pm >= 256;
#pragma unroll
        for (int ai = 0; ai < 2; ++ai)
#pragma unroll
            for (int m = 0; m < 4; ++m) {
                const int row = row0 + ai * 128 + m * 16; const float r = rtab[row - u.pm * 256];
                if (ty < 2) {
                    const float s = r * (ty == 0 ? qscale : mscale); bf16_t* dst = (ty == 0 ? Q : QM) + (size_t)row * 512 + cb;
#pragma unroll
                    for (int bj = 0; bj < 2; ++bj) { f32x4 a = acc[ai][bj][m][0] * s, b = acc[ai][bj][m][1] * s; const u32x4 pk_ = pack8(a, b); if (!NOSTORE_INB || u.pass == 0) *(u32x4*)(dst + bj * 128) = pk_; else asm volatile("" :: "v"(pk_)); }
                } else if (ty == 2) {
                    bf16_t* dst; float* fo = nullptr;
                    if (!samp) { dst = PK + (size_t)row * 512 + cb; const int t = row & 4095; if (t >= 3584) fo = out + OUT_BK + ((size_t)(row >> 12) * 512 + (t - 3584)) * 512 + cb; }
                    else { const int rs = row - MP, bs = rs >> 6, t = rs & 63; dst = SK + ((size_t)bs * 576 + 512 + t) * 512 + cb; fo = out + OUT_SK + (size_t)rs * 512 + cb; }
#pragma unroll
                    for (int bj = 0; bj < 2; ++bj) { f32x4 a = acc[ai][bj][m][0] * r, b = acc[ai][bj][m][1] * r; *(u32x4*)(dst + bj * 128) = pack8(a, b);
                        if (fo) { *(f32x4*)(fo + bj * 128) = a; *(f32x4*)(fo + bj * 128 + 4) = b; } }
                } else {
                    bf16_t* dst; size_t cst; float* fo = nullptr;
                    if (!samp) { const int b = row >> 12, t = row & 4095; dst = PVT + (size_t)b * 512 * 4096 + t; cst = 4096; if (t >= 3584) fo = out + OUT_BV + ((size_t)b * 512 + (t - 3584)) * 512 + cb; }
                    else { const int rs = row - MP, bs = rs >> 6, t = rs & 63; dst = SVT + (size_t)bs * 512 * 576 + 512 + t; cst = 576; fo = out + OUT_SV + (size_t)rs * 512 + cb; }
#pragma unroll
                    for (int bj = 0; bj < 2; ++bj) { f32x4 a = acc[ai][bj][m][0] * r, b = acc[ai][bj][m][1] * r;
#pragma unroll
                        for (int e = 0; e < 4; ++e) { dst[(size_t)(cb + bj * 128 + e) * cst] = f2bf(a[e]); dst[(size_t)(cb + bj * 128 + 4 + e) * cst] = f2bf(b[e]); }
                        if (fo) { *(f32x4*)(fo + bj * 128) = a; *(f32x4*)(fo + bj * 128 + 4) = b; } }
                }
            }
    }
};

struct EpiRes {
    static constexpr bool PERM = true, AFTER_DRAIN = false, TWICE = false, USE_R = false, USE_C = false;
    bf16_t* hb; ssq_t* ssq_next;
    __device__ __forceinline__ void operator()(const AccT& acc, const pg8::Unit& u, int wr, int wc, int fr, int fq) const {
        const int row0 = u.pm * 256 + wr * 64 + fr; const int cb = u.pn * 256 + wc * 32 + 8 * fq;
        bf16_t* base = hb + (size_t)row0 * 1024 + cb;
        u32x4 rw[2][4][2];
#pragma unroll
        for (int ai = 0; ai < 2; ++ai)
#pragma unroll
            for (int m = 0; m < 4; ++m)
#pragma unroll
                for (int bj = 0; bj < 2; ++bj) rw[ai][m][bj] = *(const u32x4*)(base + (size_t)(ai * 128 + m * 16) * 1024 + bj * 128);
        __builtin_amdgcn_sched_barrier(0);
#pragma unroll
        for (int ai = 0; ai < 2; ++ai)
#pragma unroll
            for (int m = 0; m < 4; ++m) {
                const int row = row0 + ai * 128 + m * 16; float ss = 0.f;
#pragma unroll
                for (int bj = 0; bj < 2; ++bj) { const u32x4 w = rw[ai][m][bj];
                    f32x4 a, b;
                    a[0] = __builtin_bit_cast(float, w.x << 16); a[1] = __builtin_bit_cast(float, w.x & 0xffff0000u); a[2] = __builtin_bit_cast(float, w.y << 16); a[3] = __builtin_bit_cast(float, w.y & 0xffff0000u);
                    b[0] = __builtin_bit_cast(float, w.z << 16); b[1] = __builtin_bit_cast(float, w.z & 0xffff0000u); b[2] = __builtin_bit_cast(float, w.w << 16); b[3] = __builtin_bit_cast(float, w.w & 0xffff0000u);
                    a = a + acc[ai][bj][m][0]; b = b + acc[ai][bj][m][1];
                    *(u32x4*)(base + (size_t)(ai * 128 + m * 16) * 1024 + bj * 128) = pack8(a, b);
                    ss += (a[0] * a[0] + a[1] * a[1]) + (a[2] * a[2] + a[3] * a[3]) + (b[0] * b[0] + b[1] * b[1]) + (b[2] * b[2] + b[3] * b[3]); }
                ss += __shfl_xor(ss, 16); ss += __shfl_xor(ss, 32);
                if (fq == 0) atomicAdd(ssq_next + row, to_fix(ss));
            }
    }
};

template <int CTRL> __device__ __forceinline__ float dpp_ror(float x) { return __int_as_float(__builtin_amdgcn_update_dpp(0, __float_as_int(x), CTRL, 0xf, 0xf, false)); }
struct EpiUp {
    static constexpr bool PERM = true, AFTER_DRAIN = false, TWICE = (EPI2_UP != 0), USE_R = true, USE_C = true;
    const ssq_t* ssq; const float* cw; const float* cbias; bf16_t* ACT; float* tail; float* head; LAS const float* rtab;
    __device__ __forceinline__ float r_of(ssq_t v) const { return rs_fromu(v, 1.0f / 1024.0f); }
    __device__ __forceinline__ float c_load(const pg8::Unit& u, int tid) const { const int f = u.pn * 128 + (tid & 127); return tid < 384 ? cw[(tid >> 7) * DFF + f] : cbias[f]; }
    __device__ __forceinline__ void operator()(const AccT& acc, const pg8::Unit& u, int wr, int wc, int fr, int fq) const {
        const int f0 = u.pn * 128 + wc * 32 + 8 * fq; const int lane = fq * 16 + fr;
        f32x4 w0[2], w1[2], w2[2], bb[2];
#pragma unroll
        for (int n = 0; n < 2; ++n) { LAS const float* ct = rtab + 256 + wc * 32 + 8 * fq + 4 * n; w0[n] = *(LAS const f32x4*)(ct); w1[n] = *(LAS const f32x4*)(ct + 128); w2[n] = *(LAS const f32x4*)(ct + 256); bb[n] = *(LAS const f32x4*)(ct + 384); }
#pragma unroll
        for (int ai = 0; ai < 2; ++ai) {
            const int blk = u.pm * 4 + ai * 2 + wr; const int rowb = blk * 64;
            f32x4 p1[2], p2[2];
#pragma unroll
            for (int n = 0; n < 2; ++n) { p1[n] = (f32x4){0.f, 0.f, 0.f, 0.f}; p2[n] = p1[n]; }
#pragma unroll
            for (int m = 0; m < 4; ++m) {
                const int row = rowb + 16 * m + fr; const float r = rtab[ai * 128 + wr * 64 + 16 * m + fr];
                f32x4 a[2], g[2], o[2], pp[2];
#pragma unroll
                for (int n = 0; n < 2; ++n) { a[n] = acc[ai][0][m][n] * r; g[n] = acc[ai][1][m][n] * r;
                    f32x4 c1, c2;
#pragma unroll
                    for (int e = 0; e < 4; ++e) { c1[e] = dpp_ror<0x121>(a[n][e]); c2[e] = dpp_ror<0x122>(a[n][e]); }
                    f32x4 a1, a2;
#pragma unroll
                    for (int e = 0; e < 4; ++e) { a1[e] = fr >= 1 ? c1[e] : p1[n][e]; a2[e] = fr >= 2 ? c2[e] : p2[n][e]; }
                    p1[n] = c1; p2[n] = c2;
                    pp[n] = bb[n] + w0[n] * a2 + w1[n] * a1 + w2[n] * a[n];
#pragma unroll
                    for (int e = 0; e < 4; ++e) o[n][e] = gelu_t(pp[n][e]) * g[n][e];
                }
                if (m == 0 && fr < 2) {
                    float* hp = head + ((size_t)(blk * 2 + fr) * 2) * DFF + f0;
                    *(f32x4*)(hp) = pp[0]; *(f32x4*)(hp + 4) = pp[1]; *(f32x4*)(hp + DFF) = g[0]; *(f32x4*)(hp + DFF + 4) = g[1];
                } else {
                    *(u32x4*)(ACT + (size_t)row * DFF + f0) = pack8(o[0], o[1]);
                }
                if (m == 3 && fr >= 14) { float* tp = tail + (size_t)(blk * 2 + (fr - 14)) * DFF + f0; *(f32x4*)(tp) = a[0]; *(f32x4*)(tp + 4) = a[1]; }
            }
        }
    }
};

struct EpiMem {
    static constexpr bool PERM = true, AFTER_DRAIN = false, TWICE = false, USE_R = false, USE_C = false;
    const float* rmem; float* out; bf16_t* MEMK; bf16_t* MEMVT;
    __device__ __forceinline__ void operator()(const AccT& acc, const pg8::Unit& u, int wr, int wc, int fr, int fq) const {
        const int row0 = u.pm * 256 + wr * 64 + fr; const int l = u.pn >> 2, kv = (u.pn >> 1) & 1; const int cb = (u.pn & 1) * 256 + wc * 32 + 8 * fq;
#pragma unroll
        for (int ai = 0; ai < 2; ++ai)
#pragma unroll
            for (int m = 0; m < 4; ++m) {
                const int row = row0 + ai * 128 + m * 16; const float r = rmem[row]; const int b = row >> 8, n = row & 255;
                float* fo = out + (kv ? OUT_MV : OUT_MK) + ((size_t)l * 4096 + row) * 512 + cb;
#pragma unroll
                for (int bj = 0; bj < 2; ++bj) { f32x4 x = acc[ai][bj][m][0] * r, y = acc[ai][bj][m][1] * r;
                    *(f32x4*)(fo + bj * 128) = x; *(f32x4*)(fo + bj * 128 + 4) = y;
                    if (!kv) *(u32x4*)(MEMK + (((size_t)l * 48 + b) * 256 + n) * 512 + cb + bj * 128) = pack8(x, y);
                    else { bf16_t* d = MEMVT + (((size_t)l * 48 + b) * 512 + cb + bj * 128) * 256 + n;
#pragma unroll
                        for (int e = 0; e < 4; ++e) { d[(size_t)e * 256] = f2bf(x[e]); d[(size_t)(4 + e) * 256] = f2bf(y[e]); } } }
            }
    }
};

__device__ __forceinline__ void tr_item(const float* src, int lsrc, int k0, int n0, const float* g, bf16_t* dst, int ldd, LAS float* scr, int lane) {
    float tv[32];
#pragma unroll
    for (int i = 0; i < 32; ++i) { const int kk = 2 * i + (lane >> 5); tv[i] = __builtin_nontemporal_load(src + (size_t)(k0 + kk) * lsrc + n0 + (lane & 31)); }
#pragma unroll
    for (int i = 0; i < 32; ++i) { const int kk = 2 * i + (lane >> 5); float v = tv[i]; if (g) v *= g[k0 + kk]; scr[kk * 33 + (lane & 31)] = v; }
    asm volatile("s_waitcnt lgkmcnt(0)" ::: "memory");
    const int c = lane & 7;
#pragma unroll
    for (int j = 0; j < 4; ++j) { const int n = (lane >> 3) + 8 * j; const LAS float* s = scr + (8 * c) * 33 + n;
        u32x4 o; o.x = cvt_pk_bf16(s[0 * 33], s[1 * 33]); o.y = cvt_pk_bf16(s[2 * 33], s[3 * 33]); o.z = cvt_pk_bf16(s[4 * 33], s[5 * 33]); o.w = cvt_pk_bf16(s[6 * 33], s[7 * 33]);
        *(u32x4*)(dst + (size_t)n * ldd + k0 + 8 * c) = o; }
    asm volatile("s_waitcnt lgkmcnt(0)" ::: "memory");
}
__device__ __forceinline__ void tr_plain(const float* src, int K, int N, const float* g, bf16_t* dst, int ldd, int item, LAS float* scr, int lane) {
    const int nblk = N / 32, kb = item / nblk, nb = item % nblk;
    tr_item(src, N, kb * 64, nb * 32, g, dst + (size_t)(nb * 32) * ldd, ldd, scr, lane);
}

struct Args { const float* in[26]; float* out; unsigned char* ws; int ph_lo, ph_hi, coop, pad; };
typedef __attribute__((address_space(4))) const Args* KArgs;

__device__ __forceinline__ void p0_prologue(KArgs a, LAS unsigned char* lds, int tid) {
    const int lane = tid & 63, wave = tid >> 6; const int G = gridDim.x;
    LAS float* scr = (LAS float*)(lds + wave * 8704);
    unsigned char* ws = a->ws;
    const int gw = blockIdx.x * NWAVES + wave, NGW = G * NWAVES;
    constexpr int I_INA = 16 * 48, I_SQ = 16 * 32, I_UP = 16 * 176, I_DN = 44 * 32, I_MV = 4 * 16, I_BV = 8 * 16;
    constexpr int N_INA = 2 * I_INA, N_B = 3 * I_SQ, N_MEM = 4 * I_SQ, N_OUT = 4 * I_SQ, N_UP = 4 * I_UP, N_DN = 4 * I_DN, N_MV = 128 * I_MV, N_BV = 32 * I_BV;
    constexpr int NITEMS = N_INA + N_B + N_MEM + N_OUT + N_UP + N_DN + N_MV + N_BV;
    for (int it = gw; it < NITEMS; it += NGW) {
        int r = it;
        if (r < N_INA) { const int l = r / I_INA; r %= I_INA; tr_plain(a->in[9] + (size_t)l * 1024 * 1536, 1024, 1536, a->in[8] + l * 1024, (bf16_t*)(ws + WS_WINA) + (size_t)l * 1536 * 1024, 1024, r, scr, lane); continue; } r -= N_INA;
        if (r < N_B) { const int s = r / I_SQ; r %= I_SQ;
            const float* src = s == 1 ? a->in[14] : a->in[15] + (size_t)(s >> 1) * 1024 * 1024; const float* g = s == 1 ? a->in[13] : a->in[8] + (2 + (s >> 1)) * 1024;
            tr_plain(src, 1024, 1024, g, (bf16_t*)(ws + WS_WB) + (size_t)s * 1024 * 1024, 1024, r, scr, lane); continue; } r -= N_B;
        if (r < N_MEM) { const int l = r / I_SQ; r %= I_SQ; tr_plain(a->in[18] + (size_t)l * 1024 * 1024, 1024, 1024, a->in[17] + l * 1024, (bf16_t*)(ws + WS_WMEM) + (size_t)l * 1024 * 1024, 1024, r, scr, lane); continue; } r -= N_MEM;
        if (r < N_OUT) { const int l = r / I_SQ; r %= I_SQ; tr_plain(a->in[19] + (size_t)l * 1024 * 1024, 1024, 1024, nullptr, (bf16_t*)(ws + WS_WOUT) + (size_t)l * 1024 * 1024, 1024, r, scr, lane); continue; } r -= N_OUT;
        if (r < N_UP) { const int l = r / I_UP; r %= I_UP; const int kb = r / 176, nb = r % 176; const int s0 = nb * 32; const int bj = s0 / DFF, f = s0 % DFF; const int drow = (f >> 7) * 256 + bj * 128 + (f & 127);
            tr_item(a->in[21] + (size_t)l * 1024 * 5632, 5632, kb * 64, s0, a->in[20] + l * 1024, (bf16_t*)(ws + WS_WUP) + ((size_t)l * 5632 + drow) * 1024, 1024, scr, lane); continue; } r -= N_UP;
        if (r < N_DN) { const int l = r / I_DN; r %= I_DN; tr_plain(a->in[24] + (size_t)l * DFF * 1024, DFF, 1024, nullptr, (bf16_t*)(ws + WS_WDOWN) + (size_t)l * 1024 * DFF, DFF, r, scr, lane); continue; } r -= N_DN;
        if (r < N_MV) { const int mi = r / I_MV; r %= I_MV; const int l = mi >> 5, bs = mi & 31;
            tr_plain(a->in[4] + (size_t)mi * 256 * 512, 256, 512, nullptr, (bf16_t*)(ws + WS_MEMVT) + ((size_t)l * 48 + 16 + bs) * 512 * 256, 256, r, scr, lane); continue; } r -= N_MV;
        { const int bs = r / I_BV; r %= I_BV; tr_plain(a->in[6] + (size_t)bs * 512 * 512, 512, 512, nullptr, (bf16_t*)(ws + WS_SVT) + (size_t)bs * 512 * 576, 576, r, scr, lane); }
    }
    for (int m0 = gw; m0 < MT + 4096; m0 += 4 * NGW) {
        f32x4 v[4][4]; float sq[4];
#pragma unroll
        for (int u = 0; u < 4; ++u) { const int m = m0 + u * NGW; if (m < MT + 4096) {
            const bool ismem = m >= MT; const int rr = ismem ? m - MT : m;
            const float* xr = ismem ? a->in[2] + (size_t)rr * 1024 : (rr < MP ? a->in[0] + (size_t)rr * 1024 : a->in[1] + (size_t)(rr - MP) * 1024);
#pragma unroll
            for (int j = 0; j < 4; ++j) v[u][j] = __builtin_nontemporal_load((const f32x4*)xr + lane + 64 * j); } }
#pragma unroll
        for (int u = 0; u < 4; ++u) { const int m = m0 + u * NGW; if (m < MT + 4096) {
            const bool ismem = m >= MT; const int rr = ismem ? m - MT : m;
            bf16_t* orow = (bf16_t*)(ws + (ismem ? WS_MPB : WS_HB)) + (size_t)rr * 1024;
            float s = 0.f;
#pragma unroll
            for (int j = 0; j < 4; ++j) s += (v[u][j][0] * v[u][j][0] + v[u][j][1] * v[u][j][1]) + (v[u][j][2] * v[u][j][2] + v[u][j][3] * v[u][j][3]);
            s = wave_sum(s); sq[u] = s;
#pragma unroll
            for (int j = 0; j < 4; ++j) { u32x2 o; o.x = cvt_pk_bf16(v[u][j][0], v[u][j][1]); o.y = cvt_pk_bf16(v[u][j][2], v[u][j][3]); *((u32x2*)orow + lane + 64 * j) = o; }
            if (lane == 0) { if (ismem) ((float*)(ws + WS_RMEM))[rr] = rs_from(sq[u], 1.0f / 1024.0f); else ((ssq_t*)(ws + WS_SSQ))[rr] = to_fix(sq[u]); } } }
    }
    const size_t gt = (size_t)blockIdx.x * NTHR + tid, NT = (size_t)G * NTHR;
    { ssq_t* z = (ssq_t*)(ws + WS_SSQ) + MT; for (size_t i = gt; i < (size_t)10 * MT; i += NT) z[i] = 0ull; }
    { bf16_t* wsb = (bf16_t*)(ws + WS_WSB); const float* w = a->in[11];
      for (size_t i = gt; i < (size_t)2 * 8 * 128 * 128; i += NT) { const int jj = (int)(i & 127), ii = (int)((i >> 7) & 127); wsb[i] = jj <= ii ? f2bf(w[i]) : (unsigned short)0; } }
    {
      const f32x4* src = (const f32x4*)a->in[3]; bf16_t* dst = (bf16_t*)(ws + WS_MEMK);
      constexpr size_t NV = (size_t)4 * 32 * 256 * 512 / 4;
      for (size_t i0 = gt; i0 < NV; i0 += 4 * NT) { f32x4 v[4];
#pragma unroll
          for (int k = 0; k < 4; ++k) { const size_t i = i0 + k * NT; if (i < NV) v[k] = __builtin_nontemporal_load(src + i); }
#pragma unroll
          for (int k = 0; k < 4; ++k) { const size_t i = i0 + k * NT; if (i < NV) { const size_t e = i * 4; const size_t mi = e / (256 * 512), rem = e % (256 * 512); const size_t l = mi >> 5, bs = mi & 31;
              u32x2 o; o.x = cvt_pk_bf16(v[k][0], v[k][1]); o.y = cvt_pk_bf16(v[k][2], v[k][3]); *(u32x2*)(dst + ((l * 48 + 16 + bs) * 256 * 512) + rem) = o; } } } }
    {
      const f32x4* src = (const f32x4*)a->in[5]; bf16_t* dst = (bf16_t*)(ws + WS_SK);
      constexpr size_t NV = (size_t)32 * 512 * 512 / 4;
      for (size_t i0 = gt; i0 < NV; i0 += 4 * NT) { f32x4 v[4];
#pragma unroll
          for (int k = 0; k < 4; ++k) { const size_t i = i0 + k * NT; if (i < NV) v[k] = __builtin_nontemporal_load(src + i); }
#pragma unroll
          for (int k = 0; k < 4; ++k) { const size_t i = i0 + k * NT; if (i < NV) { const size_t e = i * 4; const size_t bs = e / (512 * 512), rem = e % (512 * 512);
              u32x2 o; o.x = cvt_pk_bf16(v[k][0], v[k][1]); o.y = cvt_pk_bf16(v[k][2], v[k][3]); *(u32x2*)(dst + bs * 576 * 512 + rem) = o; } } } }
}

#ifndef REP_MEM
#define REP_MEM 1
#endif
#ifndef REP_GATE
#define REP_GATE 1
#endif
#ifndef REP_BAND
#define REP_BAND 1
#endif
template <int nib>
__device__ __forceinline__ void gate_unit(LAS unsigned char* lds, int tid, int chunk, int joff, int row0,
                                          const bf16_t* wsb, const bf16_t* VT, const bf16_t* U, const ssq_t* ssqv, const float* gv, const float* bs, bf16_t* CAT, float* av_out) {
    const int g = tid >> 6, lane = tid & 63, l32 = lane & 31, half = lane >> 5;
    LAS float* rv = (LAS float*)lds;
    __syncthreads();
    if (tid < nib * 32) rv[tid] = rs_fromu(ssqv[row0 + tid], 1.0f / 512.0f);
    __syncthreads();
    const bf16_t* vt_g = VT + ((size_t)chunk * 512 + g * 64) * 128 + joff;
    const bf16_t* w_g = wsb + (size_t)g * 128 * 128;
#pragma unroll
    for (int db = 0; db < 2; ++db) {
        f32x16 acc[4];
#pragma unroll
        for (int i = 0; i < 4; ++i)
#pragma unroll
            for (int e = 0; e < 16; ++e) acc[i][e] = 0.f;
        const bf16_t* vt_d = vt_g + (size_t)(db * 32 + l32) * 128 + half * 8;
        const bf16_t* w_d = w_g + (size_t)l32 * 128 + half * 8;
#pragma unroll
        for (int ks = 0; ks < 8; ++ks) {
            if (ks < nib * 2) {
                const int j0 = ks * 16 + half * 8;
                const u32x4 raw = *(const u32x4*)(vt_d + ks * 16);
                u32x4 sc;
#pragma unroll
                for (int q = 0; q < 4; ++q) { const float lo = __builtin_bit_cast(float, raw[q] << 16) * rv[j0 + 2 * q], hi = __builtin_bit_cast(float, raw[q] & 0xffff0000u) * rv[j0 + 2 * q + 1]; sc[q] = cvt_pk_bf16(lo, hi); }
                const bf16x8 bfr = __builtin_bit_cast(bf16x8, sc);
#pragma unroll
                for (int ib = 0; ib < 4; ++ib) {
                    if (ib < nib && ks < (ib + 1) * 2) {
                        const bf16x8 af = *(const bf16x8*)(w_d + ib * 32 * 128 + ks * 16);
                        acc[ib] = MFMA32(af, bfr, acc[ib]);
                    }
                }
            }
        }
        const int c = g * 64 + db * 32 + l32; const float gvc = gv[c];
        const bf16_t* ub = U + ((size_t)row0 + 4 * half) * 512 + c; bf16_t* cbp = CAT + ((size_t)row0 + 4 * half) * 1024 + c; const float* bsp = bs + g * 128 + 4 * half;
#pragma unroll
        for (int ib = 0; ib < nib; ++ib) {
            unsigned short uv[16]; float bv[16];
#pragma unroll
            for (int e = 0; e < 16; ++e) { const int i = ib * 32 + (e & 3) + 8 * (e >> 2); uv[e] = ub[(size_t)i * 512]; bv[e] = bsp[i]; }
#pragma unroll
            for (int e = 0; e < 16; ++e) { const int i = ib * 32 + (e & 3) + 8 * (e >> 2);
                const float s = acc[ib][e] * gvc + bv[e];
                cbp[(size_t)i * 1024] = f2bf(bf2f(uv[e]) * s); }
        }
    }
    if (av_out) {
        const int c = tid & 511; const float gvc = gv[c]; const bf16_t* vsrc = VT + ((size_t)chunk * 512 + c) * 128 + joff;
#pragma unroll 1
        for (int t0 = 0; t0 < 64; t0 += 16) {
            unsigned short vv[16];
#pragma unroll
            for (int k = 0; k < 16; ++k) vv[k] = vsrc[t0 + k];
#pragma unroll
            for (int k = 0; k < 16; ++k) av_out[(size_t)(t0 + k) * 512 + c] = bf2f(vv[k]) * rv[t0 + k] * gvc;
        }
    }
}

template <int D, bool BAND>
__device__ __forceinline__ void attn_unit(LAS unsigned char* lds, int tid, const bf16_t* Qw, bool hasq, const bf16_t* Kb, int ldk, const bf16_t* Vtb, int ldv,
                                          int jstart, int nkb, int jlo, int jhi, bf16_t* Ow, LAS const float* btab, int relq) {
    constexpr int KROW = (D + 8) * 2, VROW = 136, KBYTES = 64 * KROW, VBYTES = D * VROW, BUF = KBYTES + VBYTES, STAGE = 2 * BUF, NR = D / 64, KK = D / 16, DB = D / 32;
    const int lane = tid & 63, l32 = lane & 31, half = lane >> 5;
    bf16x8 qf[KK];
#pragma unroll
    for (int kk = 0; kk < KK; ++kk) qf[kk] = hasq ? *(const bf16x8*)(Qw + (size_t)l32 * 512 + kk * 16 + half * 8) : (bf16x8){0, 0, 0, 0, 0, 0, 0, 0};
    f32x16 O[DB];
#pragma unroll
    for (int d = 0; d < DB; ++d)
#pragma unroll
        for (int e = 0; e < 16; ++e) O[d][e] = 0.f;
    float mrun = -1e30f, lsum = 0.f;
    u32x4 kreg[2][NR], vreg[2][NR];
#define ATT_GLOAD(st) do { _Pragma("unroll") for (int bk = 0; bk < 2; ++bk) { const int j_ = 2 * (st) + bk; _Pragma("unroll") for (int i = 0; i < NR; ++i) { const int id = tid + i * NTHR; const int kr = id / (D / 8), kc = id % (D / 8); \
        kreg[bk][i] = *(const u32x4*)(Kb + (long)(j_ * 64 + kr) * ldk + kc * 8); const int vr = id >> 3, vc = id & 7; vreg[bk][i] = *(const u32x4*)(Vtb + (long)vr * ldv + j_ * 64 + vc * 8); } } } while (0)
#define ATT_LSTORE(buf) do { _Pragma("unroll") for (int bk = 0; bk < 2; ++bk) { LAS unsigned char* b_ = lds + (buf) * STAGE + bk * BUF; _Pragma("unroll") for (int i = 0; i < NR; ++i) { const int id = tid + i * NTHR; const int kr = id / (D / 8), kc = id % (D / 8); \
        *(LAS u32x4*)(b_ + kr * KROW + kc * 16) = kreg[bk][i]; const int vr = id >> 3, vc = id & 7; { const u32x4 v_ = vreg[bk][i]; *(LAS u32x2*)(b_ + KBYTES + vr * VROW + vc * 16) = (u32x2){v_.x, v_.y}; *(LAS u32x2*)(b_ + KBYTES + vr * VROW + vc * 16 + 8) = (u32x2){v_.z, v_.w}; } } } } while (0)
    const int st0 = jstart >> 1, nst = (nkb + 1) >> 1;
    __syncthreads();
    ATT_GLOAD(st0); ATT_LSTORE(0);
    __syncthreads();
    for (int st = st0; st < nst; ++st) {
        const int cur = (st - st0) & 1;
        if (st + 1 < nst) ATT_GLOAD(st + 1);
        if constexpr (D == 64) {
            const int j0 = 2 * st;
            const bool a0 = hasq && j0 >= jlo && j0 <= jhi, a1 = hasq && (j0 + 1) >= jlo && (j0 + 1) <= jhi;
            if (a0 || a1) {
                const LAS unsigned char* bb0 = lds + cur * STAGE;
                f32x16 S[4];
#pragma unroll
                for (int bk = 0; bk < 2; ++bk) {
                    const LAS unsigned char* b = bb0 + bk * BUF; const bool act = bk ? a1 : a0;
                    if (act) {
#pragma unroll
                        for (int s = 0; s < 2; ++s) {
                            bf16x8 kf[KK];
#pragma unroll
                            for (int kk = 0; kk < KK; ++kk) kf[kk] = *(const LAS bf16x8*)(b + (s * 32 + l32) * KROW + (kk * 16 + half * 8) * 2);
#pragma unroll
                            for (int e = 0; e < 16; ++e) S[bk * 2 + s][e] = 0.f;
#pragma unroll
                            for (int kk = 0; kk < KK; ++kk) S[bk * 2 + s] = MFMA32(kf[kk], qf[kk], S[bk * 2 + s]);
                        }
                        const int j = j0 + bk;
                        if (BAND) {
                            if (j <= jlo + 3) {
                                const float cbias = btab[0];
#pragma unroll
                                for (int s = 0; s < 2; ++s)
#pragma unroll
                                    for (int e = 0; e < 16; ++e) S[bk * 2 + s][e] += cbias;
                            } else {
                                const LAS float* bp = btab + (575 - relq + j * 64 + 4 * half);
#pragma unroll
                                for (int s = 0; s < 2; ++s)
#pragma unroll
                                    for (int e = 0; e < 16; ++e) S[bk * 2 + s][e] += bp[s * 32 + (e & 3) + 8 * (e >> 2)];
                            }
                        }
                    } else {
#pragma unroll
                        for (int s = 0; s < 2; ++s)
#pragma unroll
                            for (int e = 0; e < 16; ++e) S[bk * 2 + s][e] = -1e30f;
                    }
                }
                float mx = S[0][0];
#pragma unroll
                for (int q = 0; q < 4; ++q)
#pragma unroll
                    for (int e = 0; e < 16; ++e) mx = fmaxf(mx, S[q][e]);
                mx = fmaxf(mx, __shfl_xor(mx, 32));
                const float mnew = fmaxf(mrun, mx); const float alpha = __builtin_amdgcn_exp2f(mrun - mnew); mrun = mnew;
                float ps = 0.f;
#pragma unroll
                for (int q = 0; q < 4; ++q)
#pragma unroll
                    for (int e = 0; e < 16; ++e) { const float p = __builtin_amdgcn_exp2f(S[q][e] - mnew); S[q][e] = p; ps += p; }
                lsum = lsum * alpha + ps;
                if (__builtin_amdgcn_ballot_w64(alpha != 1.0f) != 0ull) {
#pragma unroll
                    for (int d = 0; d < DB; ++d)
#pragma unroll
                        for (int e = 0; e < 16; ++e) O[d][e] *= alpha;
                }
#pragma unroll
                for (int bk = 0; bk < 2; ++bk) {
                    const bool act = bk ? a1 : a0;
                    if (act) {
                        const LAS unsigned char* b = bb0 + bk * BUF;
#pragma unroll
                        for (int s = 0; s < 2; ++s)
#pragma unroll
                            for (int t = 0; t < 2; ++t) {
                                u32x2 vlo[DB], vhi[DB];
#pragma unroll
                                for (int d = 0; d < DB; ++d) { const LAS unsigned char* vp = b + KBYTES + (d * 32 + l32) * VROW + (s * 32 + 16 * t + 4 * half) * 2; vlo[d] = *(const LAS u32x2*)vp; vhi[d] = *(const LAS u32x2*)(vp + 16); }
                                u32x4 pk;
#pragma unroll
                                for (int q = 0; q < 4; ++q) pk[q] = cvt_pk_bf16(S[bk * 2 + s][8 * t + 2 * q], S[bk * 2 + s][8 * t + 2 * q + 1]);
                                const bf16x8 pb = __builtin_bit_cast(bf16x8, pk);
#pragma unroll
                                for (int d = 0; d < DB; ++d) { const u32x4 vv = {vlo[d].x, vlo[d].y, vhi[d].x, vhi[d].y}; O[d] = MFMA32(__builtin_bit_cast(bf16x8, vv), pb, O[d]); }
                            }
                    }
                }
            }
        } else {
#pragma unroll
        for (int bk = 0; bk < 2; ++bk) {
            const int j = 2 * st + bk;
            if (hasq && j >= jlo && j <= jhi) {
                const LAS unsigned char* b = lds + cur * STAGE + bk * BUF;
                f32x16 S[2];
#pragma unroll
                for (int s = 0; s < 2; ++s) {
#pragma unroll
                    for (int e = 0; e < 16; ++e) S[s][e] = 0.f;
#pragma unroll
                    for (int k0 = 0; k0 < KK; k0 += 4) {
                        bf16x8 kf[4];
#pragma unroll
                        for (int kk = 0; kk < 4; ++kk) kf[kk] = *(const LAS bf16x8*)(b + (s * 32 + l32) * KROW + ((k0 + kk) * 16 + half * 8) * 2);
#pragma unroll
                        for (int kk = 0; kk < 4; ++kk) S[s] = MFMA32(kf[kk], qf[k0 + kk], S[s]);
                    }
                }
                constexpr int NVS = (D == 64) ? 2 : 0;
                u32x2 vlo[2][2][DB], vhi[2][2][DB];
#pragma unroll
                for (int s = 0; s < NVS; ++s)
#pragma unroll
                    for (int t = 0; t < 2; ++t)
#pragma unroll
                        for (int d = 0; d < DB; ++d) { const LAS unsigned char* vp = b + KBYTES + (d * 32 + l32) * VROW + (s * 32 + 16 * t + 4 * half) * 2; vlo[s][t][d] = *(const LAS u32x2*)vp; vhi[s][t][d] = *(const LAS u32x2*)(vp + 16); }
                if (BAND) {
                    if (j <= jlo + 3) {
                        const float cbias = btab[0];
#pragma unroll
                        for (int s = 0; s < 2; ++s)
#pragma unroll
                            for (int e = 0; e < 16; ++e) S[s][e] += cbias;
                    } else {
                        const LAS float* bp = btab + (575 - relq + j * 64 + 4 * half);
#pragma unroll
                        for (int s = 0; s < 2; ++s)
#pragma unroll
                            for (int e = 0; e < 16; ++e) S[s][e] += bp[s * 32 + (e & 3) + 8 * (e >> 2)];
                    }
                }
                float mx = S[0][0];
#pragma unroll
                for (int e = 1; e < 16; ++e) mx = fmaxf(mx, S[0][e]);
#pragma unroll
                for (int e = 0; e < 16; ++e) mx = fmaxf(mx, S[1][e]);
                mx = fmaxf(mx, __shfl_xor(mx, 32));
                const float mnew = fmaxf(mrun, mx); const float alpha = __builtin_amdgcn_exp2f(mrun - mnew); mrun = mnew;
                float ps = 0.f;
#pragma unroll
                for (int s = 0; s < 2; ++s)
#pragma unroll
                    for (int e = 0; e < 16; ++e) { const float p = __builtin_amdgcn_exp2f(S[s][e] - mnew); S[s][e] = p; ps += p; }
                lsum = lsum * alpha + ps;
                if (__builtin_amdgcn_ballot_w64(alpha != 1.0f) != 0ull) {
#pragma unroll
                    for (int d = 0; d < DB; ++d)
#pragma unroll
                        for (int e = 0; e < 16; ++e) O[d][e] *= alpha;
                }
#pragma unroll
                for (int s = 0; s < 2; ++s) {
#pragma unroll
                    for (int t = 0; t < 2; ++t) {
                        if (s >= NVS) {
#pragma unroll
                            for (int d = 0; d < DB; ++d) { const LAS unsigned char* vp = b + KBYTES + (d * 32 + l32) * VROW + (s * 32 + 16 * t + 4 * half) * 2; vlo[s][t][d] = *(const LAS u32x2*)vp; vhi[s][t][d] = *(const LAS u32x2*)(vp + 16); }
                        }
                        u32x4 pk;
#pragma unroll
                        for (int q = 0; q < 4; ++q) pk[q] = cvt_pk_bf16(S[s][8 * t + 2 * q], S[s][8 * t + 2 * q + 1]);
                        const bf16x8 pb = __builtin_bit_cast(bf16x8, pk);
#pragma unroll
                        for (int d = 0; d < DB; ++d) {
                            const u32x4 vv = {vlo[s][t][d].x, vlo[s][t][d].y, vhi[s][t][d].x, vhi[s][t][d].y};
                            O[d] = MFMA32(__builtin_bit_cast(bf16x8, vv), pb, O[d]);
                        }
                    }
                }
            }
        }
        }
        if (st + 1 < nst) ATT_LSTORE(cur ^ 1);
        __syncthreads();
    }
#undef ATT_GLOAD
#undef ATT_LSTORE
    if (hasq) {
        const float l = lsum + __shfl_xor(lsum, 32); const float inv = 1.0f / l;
#pragma unroll
        for (int d = 0; d < DB; ++d)
#pragma unroll
            for (int gq = 0; gq < 4; ++gq) {
                u32x2 o; o.x = cvt_pk_bf16(O[d][4 * gq] * inv, O[d][4 * gq + 1] * inv); o.y = cvt_pk_bf16(O[d][4 * gq + 2] * inv, O[d][4 * gq + 3] * inv);
                *(u32x2*)(Ow + (size_t)l32 * 1024 + d * 32 + 8 * gq + 4 * half) = o;
            }
    }
}

__device__ __forceinline__ void mixer_phase(KArgs a, LAS unsigned char* lds, int tid_in, int l) {
    unsigned char* ws = a->ws; const int G = gridDim.x;
    bf16_t* CAT = (bf16_t*)(ws + WS_CAT);
    constexpr int N_MEMP = 16 * 16 * 4, N_MEMS = 32 * 4;
#ifndef NO_MEMATT
    {
        int tid = tid_in; asm volatile("" : "+v"(tid)); const int wave = tid >> 6;
        const bf16_t* QM = (const bf16_t*)(ws + WS_QM);
        for (int it = blockIdx.x; it < REP_MEM * (N_MEMP + N_MEMS); it += G) {
            int r = it % (N_MEMP + N_MEMS); int bb, h, q0, nq;
            if (r < N_MEMP) { h = r & 3; const int qb = (r >> 2) & 15; bb = r >> 6; q0 = bb * SEQ + qb * 256; nq = 256; }
            else { r -= N_MEMP; h = r & 3; const int bs = r >> 2; bb = 16 + bs; q0 = MP + bs * 64; nq = 64; }
            const bool hasq = wave * 32 < nq; const int qrow = q0 + wave * 32;
            attn_unit<128, false>(lds, tid, QM + (size_t)qrow * 512 + h * 128, hasq, (const bf16_t*)(ws + WS_MEMK) + ((size_t)l * 48 + bb) * 256 * 512 + h * 128, 512,
                                  (const bf16_t*)(ws + WS_MEMVT) + (((size_t)l * 48 + bb) * 512 + h * 128) * 256, 256, 0, 4, 0, 3, CAT + (size_t)qrow * 1024 + 512 + h * 128, nullptr, 0);
        }
    }
#endif
    if (l < 2) {
#ifndef NO_GATE
        int tid = tid_in; asm volatile("" : "+v"(tid));
        for (int r_ = G - 1 - (int)blockIdx.x; r_ < REP_GATE * (512 + 32); r_ += G) { const int r = r_ % (512 + 32);
            int chunk, joff, nib, row0; float* av = nullptr;
            if (r < 512) { chunk = r; joff = 0; nib = 4; row0 = r * 128; }
            else { const int bs = r - 512; chunk = 512 + (bs >> 1); joff = (bs & 1) * 64; nib = 2; row0 = MP + bs * 64; av = a->out + OUT_AV + ((size_t)l * 32 + bs) * 64 * 512; }
            if (nib == 4) gate_unit<4>(lds, tid, chunk, joff, row0, (const bf16_t*)(ws + WS_WSB) + (size_t)l * 8 * 128 * 128, (const bf16_t*)(ws + WS_VT), (const bf16_t*)(ws + WS_U),
                      (const ssq_t*)(ws + WS_SSQ) + (size_t)(9 + l) * MT, a->in[10] + l * 512, a->in[12] + l * 8 * 128, CAT, av);
            else gate_unit<2>(lds, tid, chunk, joff, row0, (const bf16_t*)(ws + WS_WSB) + (size_t)l * 8 * 128 * 128, (const bf16_t*)(ws + WS_VT), (const bf16_t*)(ws + WS_U),
                      (const ssq_t*)(ws + WS_SSQ) + (size_t)(9 + l) * MT, a->in[10] + l * 512, a->in[12] + l * 8 * 128, CAT, av);
        }
#endif
    } else {
#ifndef NO_BAND
        int tid = tid_in; asm volatile("" : "+v"(tid)); const int wave = tid >> 6;
        const int jl = l - 2; const bf16_t* Q = (const bf16_t*)(ws + WS_U);
        LAS float* btab = (LAS float*)(lds + 76800);
        for (int it = blockIdx.x; it < REP_BAND * (16 * 8 * 16 + 32 * 8); it += G) {
            int r = it % (16 * 8 * 16 + 32 * 8);
            int h, qrow, jstart, nkb, jlo, jhi, relq; const bf16_t* Kb; const bf16_t* Vtb; int ldv; bool hasq;
            if (r < 16 * 8 * 16) { h = r & 7; const int cg4 = (r >> 3) & 15; const int b = r >> 7; const int c0 = cg4 * 4;
                qrow = b * SEQ + c0 * 64 + wave * 32; hasq = true; nkb = 12; jstart = c0 >= 8 ? 0 : 8 - c0; jlo = wave >> 1; jhi = jlo + 8;
                Kb = (const bf16_t*)(ws + WS_PK) + ((long)b * SEQ + (long)(c0 - 8) * 64) * 512 + h * 64;
                Vtb = (const bf16_t*)(ws + WS_PVT) + ((long)b * 512 + h * 64) * 4096 + (long)(c0 - 8) * 64; ldv = 4096;
                relq = 512 + (wave >> 1) * 64 + (wave & 1) * 32 + (tid & 31); }
            else { r -= 16 * 8 * 16; h = r & 7; const int bs = r >> 3; qrow = MP + bs * 64 + wave * 32; hasq = wave < 2; nkb = 9; jstart = 0; jlo = 0; jhi = 8;
                Kb = (const bf16_t*)(ws + WS_SK) + (size_t)bs * 576 * 512 + h * 64; Vtb = (const bf16_t*)(ws + WS_SVT) + ((size_t)bs * 512 + h * 64) * 576; ldv = 576;
                relq = 512 + (wave & 1) * 32 + (tid & 31); }
            __syncthreads();
            for (int i = tid; i < 639; i += NTHR) { const int idx = 638 - i; btab[i] = a->in[16][((size_t)jl * 8 + h) * 513 + 193 + (idx > 319 ? 319 : idx)] * LOG2E; }
            attn_unit<64, true>(lds, tid, Q + (size_t)qrow * 512 + h * 64, hasq, Kb, 512, Vtb, ldv, jstart, nkb, jlo, jhi, CAT + (size_t)qrow * 1024 + h * 64, btab, relq);
        }
#endif
    }
}

__device__ __forceinline__ void fixup_phase(KArgs a, int tid, int l) {
    unsigned char* ws = a->ws; const float* tail = (const float*)(ws + WS_TAIL); const float* head = (const float*)(ws + WS_HEAD); bf16_t* ACT = (bf16_t*)(ws + WS_ACT);
    const float* cw = a->in[22] + (size_t)l * 3 * DFF; const float* sc = a->in[7] + (size_t)l * 32 * 2 * DFF;
    const size_t gt = (size_t)blockIdx.x * NTHR + tid, NT = (size_t)gridDim.x * NTHR;
    constexpr int FV = DFF / 4; constexpr size_t NI = (size_t)NBLK64 * FV;
    for (size_t i0 = gt; i0 < NI; i0 += 2 * NT) {
        f32x4 pm2[2], pm1[2], w0[2], w1[2], h0[2], g0[2], h1[2], g1[2], t0[2], t1[2]; int blk[2], f[2]; bool ok[2], st[2];
#pragma unroll
        for (int k = 0; k < 2; ++k) {
            const size_t i = i0 + k * NT; ok[k] = i < NI; blk[k] = 0; f[k] = 0; st[k] = false;
            if (ok[k]) {
                blk[k] = (int)(i / FV); f[k] = (int)(i % FV) * 4; const int b = blk[k], ff = f[k];
                if (b >= MP / 64) { const int bs = b - MP / 64; pm2[k] = *(const f32x4*)(sc + ((size_t)bs * 2 + 0) * DFF + ff); pm1[k] = *(const f32x4*)(sc + ((size_t)bs * 2 + 1) * DFF + ff); }
                else if ((b & 63) == 0) { pm2[k] = (f32x4){0.f, 0.f, 0.f, 0.f}; pm1[k] = pm2[k]; }
                else { pm2[k] = *(const f32x4*)(tail + ((size_t)(b - 1) * 2 + 0) * DFF + ff); pm1[k] = *(const f32x4*)(tail + ((size_t)(b - 1) * 2 + 1) * DFF + ff); }
                w0[k] = *(const f32x4*)(cw + ff); w1[k] = *(const f32x4*)(cw + DFF + ff);
                const float* hp = head + (size_t)b * 4 * DFF + ff;
                h0[k] = *(const f32x4*)hp; g0[k] = *(const f32x4*)(hp + DFF); h1[k] = *(const f32x4*)(hp + 2 * DFF); g1[k] = *(const f32x4*)(hp + 3 * DFF);
                st[k] = (b >= MP / 64) || ((b & 63) == 63);
                if (st[k]) { t0[k] = *(const f32x4*)(tail + ((size_t)b * 2 + 0) * DFF + ff); t1[k] = *(const f32x4*)(tail + ((size_t)b * 2 + 1) * DFF + ff); }
            }
        }
#pragma unroll
        for (int k = 0; k < 2; ++k) {
            if (ok[k]) {
                const int b = blk[k], ff = f[k];
                const f32x4 c0 = h0[k] + w0[k] * pm2[k] + w1[k] * pm1[k], c1 = h1[k] + w0[k] * pm1[k];
                u32x2 o0, o1;
                o0.x = cvt_pk_bf16(gelu_t(c0[0]) * g0[k][0], gelu_t(c0[1]) * g0[k][1]); o0.y = cvt_pk_bf16(gelu_t(c0[2]) * g0[k][2], gelu_t(c0[3]) * g0[k][3]);
                o1.x = cvt_pk_bf16(gelu_t(c1[0]) * g1[k][0], gelu_t(c1[1]) * g1[k][1]); o1.y = cvt_pk_bf16(gelu_t(c1[2]) * g1[k][2], gelu_t(c1[3]) * g1[k][3]);
                *(u32x2*)(ACT + (size_t)b * 64 * DFF + ff) = o0; *(u32x2*)(ACT + ((size_t)b * 64 + 1) * DFF + ff) = o1;
                if (st[k]) {
                    float* o = (b >= MP / 64) ? a->out + OUT_CS + ((size_t)l * 32 + (b - MP / 64)) * 2 * DFF + ff : a->out + OUT_CP + ((size_t)l * 16 + (b >> 6)) * 2 * DFF + ff;
                    *(f32x4*)o = t0[k]; *(f32x4*)(o + DFF) = t1[k];
                }
            }
        }
    }
}

__device__ __forceinline__ void final_phase(KArgs a, int tid) {
    const ssq_t* ssq = (const ssq_t*)(a->ws + WS_SSQ) + (size_t)4 * MT; const float* g = a->in[25]; const bf16_t* hb = (const bf16_t*)(a->ws + WS_HB);
    const int lane = tid & 63; const int gw = blockIdx.x * NWAVES + (tid >> 6), NGW = gridDim.x * NWAVES;
    f32x4 gg[4];
#pragma unroll
    for (int j = 0; j < 4; ++j) gg[j] = *((const f32x4*)g + lane + 64 * j);
    for (int m0 = gw; m0 < MT; m0 += 4 * NGW) {
        u32x2 w[4][4]; float r[4];
#pragma unroll
        for (int u = 0; u < 4; ++u) { const int m = m0 + u * NGW; if (m < MT) { r[u] = rs_fromu(ssq[m], 1.0f / 1024.0f); const u32x2* hr = (const u32x2*)(hb + (size_t)m * 1024);
#pragma unroll
            for (int j = 0; j < 4; ++j) w[u][j] = hr[lane + 64 * j]; } }
#pragma unroll
        for (int u = 0; u < 4; ++u) { const int m = m0 + u * NGW; if (m < MT) { f32x4* row = (f32x4*)(a->out + (size_t)m * 1024);
#pragma unroll
            for (int j = 0; j < 4; ++j) { f32x4 v; v[0] = __builtin_bit_cast(float, w[u][j].x << 16); v[1] = __builtin_bit_cast(float, w[u][j].x & 0xffff0000u); v[2] = __builtin_bit_cast(float, w[u][j].y << 16); v[3] = __builtin_bit_cast(float, w[u][j].y & 0xffff0000u);
                __builtin_nontemporal_store(v * r[u] * gg[j], row + lane + 64 * j); } } }
    }
}


#define XB_TMO      128
#define XB_XCNT(j)  (256  + 64 * (j))
#define XB_XSUB(j)  (1280 + 64 * (j))
#define XB_XGEN(j)  (2304 + 64 * (j))
#define XB_TOP      3328
#define XB_TOPGEN   3392
#define XCD_BAR_WORDS 3456
#define XB_SPIN_CAP (1u << 18)

__device__ __forceinline__ unsigned xb_ld(unsigned* p)              { return __hip_atomic_load(p, __ATOMIC_RELAXED, __HIP_MEMORY_SCOPE_AGENT); }
__device__ __forceinline__ unsigned xb_add(unsigned* p, unsigned v) { return __hip_atomic_fetch_add(p, v, __ATOMIC_RELAXED, __HIP_MEMORY_SCOPE_AGENT); }
__device__ __forceinline__ unsigned xb_xcc_id() { return (unsigned)__builtin_amdgcn_s_getreg((3 << 11) | 20) & 0xFu; }
#define XB_SPIN(cond, bar) do { unsigned _sp = 0; while (cond) { __builtin_amdgcn_s_sleep(1); \
    if ((++_sp & 255u) == 0u) { if (xb_ld(&(bar)[XB_TMO])) break; if (_sp > XB_SPIN_CAP) { atomicAdd(&(bar)[XB_TMO], 1u); break; } } } } while (0)

struct XcdBarrier {
    unsigned* bar; unsigned x;
    volatile LAS unsigned* st;
};

__device__ __forceinline__ XcdBarrier xcd_barrier_post(unsigned* bar, volatile LAS unsigned* st) {
    XcdBarrier b; b.bar = bar; b.x = xb_xcc_id(); b.st = st;
    if (threadIdx.x == 0) (void)xb_add(&bar[XB_XCNT(b.x)], 1u);
    return b;
}
__device__ __forceinline__ void xcd_barrier_complete(unsigned* bar, unsigned x, unsigned& nloc, unsigned& nx) {
    const unsigned G = gridDim.x * gridDim.y * gridDim.z;
    unsigned sum, cnt, mine, sp = 0u;
    for (;;) {
        sum = 0u; cnt = 0u; mine = 0u;
#pragma unroll
        for (unsigned j = 0; j < 16; ++j) { const unsigned c = xb_ld(&bar[XB_XCNT(j)]); sum += c; cnt += (c > 0u) ? 1u : 0u; mine = (j == x) ? c : mine; }
        if (sum == G) break;
        __builtin_amdgcn_s_sleep(1);
        if ((++sp & 255u) == 0u) { if (xb_ld(&bar[XB_TMO])) break; if (sp > XB_SPIN_CAP) { atomicAdd(&bar[XB_TMO], 1u); break; } }
    }
    nloc = mine > 0u ? mine : 1u; nx = cnt > 0u ? cnt : 1u;
}

__device__ __forceinline__ void xcd_barrier(const XcdBarrier& b) {
    asm volatile("s_waitcnt vmcnt(0)" ::: "memory");
    __syncthreads();
    if (threadIdx.x == 0) {
        unsigned* bar = b.bar;
        __builtin_amdgcn_s_waitcnt(0);
        unsigned nloc = b.st[0], nx = b.st[1];
        if (nloc == 0u) { xcd_barrier_complete(bar, b.x, nloc, nx); b.st[0] = nloc; b.st[1] = nx; }
        const unsigned old = xb_add(&bar[XB_XSUB(b.x)], 1u);
        const unsigned gen = old / nloc;
        if (old + 1u == (gen + 1u) * nloc) {
            __builtin_amdgcn_fence(__ATOMIC_RELEASE, "agent");
            asm volatile("s_waitcnt vmcnt(0)" ::: "memory");
            const unsigned og = xb_add(&bar[XB_TOP], 1u);
            const unsigned tg = og / nx;
            if (og + 1u == (tg + 1u) * nx) xb_add(&bar[XB_TOPGEN], 1u);
            else XB_SPIN(xb_ld(&bar[XB_TOPGEN]) == tg, bar);
            __builtin_amdgcn_fence(__ATOMIC_ACQUIRE, "agent");
            xb_add(&bar[XB_XGEN(b.x)], 1u);
            asm volatile("s_waitcnt vmcnt(0)" ::: "memory");
        } else {
            XB_SPIN(xb_ld(&bar[XB_XGEN(b.x)]) == gen, bar);
            __builtin_amdgcn_fence(__ATOMIC_ACQUIRE, "agent");
            asm volatile("s_waitcnt vmcnt(0)" ::: "memory");
        }
    }
    __syncthreads();
}

#ifndef REP_P0
#define REP_P0 1
#endif
#ifndef REP_MIX
#define REP_MIX 1
#endif
#ifndef REP_UP
#define REP_UP 1
#endif
#ifndef STAG_IN
#define STAG_IN 0
#endif
#ifndef STAG_OUT
#define STAG_OUT 0
#endif
#ifndef STAG_UP
#define STAG_UP 0
#endif
#ifndef STAG_DOWN
#define STAG_DOWN 0
#endif
#define STAG(d) ((((unsigned)blockIdx.x >> 3) & 1u) * (unsigned)(d))
#ifndef REP_FIX
#define REP_FIX 1
#endif
#ifndef REP_INA
#define REP_INA 1
#endif
#ifndef REP_INB
#define REP_INB 1
#endif
#ifndef REP_OUT
#define REP_OUT 1
#endif
#ifndef REP_DOWN
#define REP_DOWN 1
#endif
__device__ __forceinline__ void launder(int& t) { asm volatile("" : "+v"(t)); }
__global__ void __launch_bounds__(NTHR, 2) fwd_kernel(Args a) {
    extern __shared__ __attribute__((aligned(16))) unsigned char lds_raw[];
    LAS unsigned char* lds = (LAS unsigned char*)lds_raw;
    int tid = threadIdx.x; const int G = gridDim.x;
    KArgs kp = (KArgs)__builtin_amdgcn_kernarg_segment_ptr();
    volatile LAS unsigned* bst = (volatile LAS unsigned*)(lds + LDS_BYTES - 64);
    if (tid < 2) bst[tid] = 0u;
    __syncthreads();
    XcdBarrier bar; bar.bar = (unsigned*)(a.ws + WS_BAR); bar.x = 0; bar.st = bst;
    if (a.coop) bar = xcd_barrier_post((unsigned*)(a.ws + WS_BAR), bst);
#define PH_ARGS() KArgs q = kp; asm volatile("" : "+s"(q)); unsigned char* ws = q->ws; ssq_t* ssqb = (ssq_t*)(ws + WS_SSQ); bf16_t* HB = (bf16_t*)(ws + WS_HB); (void)ssqb; (void)HB;
    int ph = 0;
#ifndef REP_SYNC
#define REP_SYNC 1
#endif
#define SEAM() do { if (a.coop && ph + 1 < a.ph_hi) { for (int rs_ = 0; rs_ < REP_SYNC; ++rs_) { if (a.coop == 2) cg::this_grid().sync(); else xcd_barrier(bar); } } } while (0)
#define IN_PH() (launder(tid), ph >= a.ph_lo && ph < a.ph_hi)
#ifndef EN_MASK
#define EN_MASK 0xffff
#endif
#define EN(k) ((EN_MASK >> (k)) & 1)

    if (IN_PH()) { PH_ARGS(); for (int rep = 0; rep < REP_P0; ++rep) p0_prologue(q, lds, tid); SEAM(); } ++ph;

#pragma unroll 1
    for (int l = 0; l < 4; ++l) {
        if (IN_PH()) { PH_ARGS();
            if (l < 2) { if (EN(1)) {
                pg8::Gemm g{HB, (const bf16_t*)(ws + WS_WINA) + (size_t)l * 1536 * 1024, MT, 1536, 1024}; pg8::StaticOrder S; S.init(MT, 1536, G, (int)blockIdx.x);
                EpiInA E{ssqb + (size_t)l * MT, (bf16_t*)(ws + WS_U), (bf16_t*)(ws + WS_VT), (bf16_t*)(ws + WS_QM), ssqb + (size_t)(9 + l) * MT, 0.08838834764831845f * LOG2E, (LAS const float*)(lds + 131072)};
                S.rep = REP_INA; S.epi_all = 1; pg8::gemm_phase<EpiInA, pg8::StaticOrder, true, true>(lds, g, S, E, tid, STAG(STAG_IN)); }
                if (EN(2) && l == 0) {
                    pg8::Gemm g2{(const bf16_t*)(ws + WS_MPB), (const bf16_t*)(ws + WS_WMEM), 4096, 4096, 1024}; pg8::StaticOrder S2; S2.init(4096, 4096, G, (int)blockIdx.x);
                    EpiMem E2{(const float*)(ws + WS_RMEM), q->out, (bf16_t*)(ws + WS_MEMK), (bf16_t*)(ws + WS_MEMVT)};
                    pg8::gemm_phase<EpiMem, pg8::StaticOrder, true, true>(lds, g2, S2, E2, tid);
                }
            } else if (EN(3)) {
                const int N = l == 2 ? 2048 : 1024;
                pg8::Gemm g{HB, (const bf16_t*)(ws + WS_WB) + (size_t)(l == 2 ? 0 : 2048) * 1024, MT, N, 1024}; pg8::StaticOrder S; S.init(MT, N, G, (int)blockIdx.x);
                EpiInB E{ssqb + (size_t)l * MT, (bf16_t*)(ws + WS_U), (bf16_t*)(ws + WS_QM), (bf16_t*)(ws + WS_PK), (bf16_t*)(ws + WS_PVT), (bf16_t*)(ws + WS_SK), (bf16_t*)(ws + WS_SVT), q->out,
                         0.125f * LOG2E, 0.08838834764831845f * LOG2E, (LAS const float*)(lds + 131072)};
                S.rep = REP_INB; S.epi_all = EPIALL_INB; pg8::gemm_phase<EpiInB, pg8::StaticOrder, true, true>(lds, g, S, E, tid, STAG(STAG_IN));
            }
            SEAM();
        } ++ph;
        if (IN_PH()) { PH_ARGS(); for (int rep = 0; rep < REP_MIX; ++rep) mixer_phase(q, lds, tid, l); SEAM(); } ++ph;
        if (IN_PH()) { PH_ARGS(); if (EN(5)) {
            pg8::Gemm g{(const bf16_t*)(ws + WS_CAT), (const bf16_t*)(ws + WS_WOUT) + (size_t)l * 1024 * 1024, MT, 1024, 1024}; pg8::StaticOrder S; S.init(MT, 1024, G, (int)blockIdx.x);
            EpiRes E{HB, ssqb + (size_t)(5 + l) * MT};
            S.rep = REP_OUT; S.epi_all = 1; pg8::gemm_phase<EpiRes, pg8::StaticOrder, true, true>(lds, g, S, E, tid, STAG(STAG_OUT)); }
            SEAM();
        } ++ph;
        if (IN_PH()) { PH_ARGS(); if (EN(6)) {
            pg8::Gemm g{HB, (const bf16_t*)(ws + WS_WUP) + (size_t)l * 5632 * 1024, MT, 5632, 1024}; pg8::StaticOrder S; S.init(MT, 5632, G, (int)blockIdx.x);
            EpiUp E{ssqb + (size_t)(5 + l) * MT, q->in[22] + (size_t)l * 3 * DFF, q->in[23] + (size_t)l * DFF, (bf16_t*)(ws + WS_ACT), (float*)(ws + WS_TAIL), (float*)(ws + WS_HEAD), (LAS const float*)(lds + 131072)};
            S.rep = REP_UP; pg8::gemm_phase<EpiUp, pg8::StaticOrder, true, true>(lds, g, S, E, tid, STAG(STAG_UP)); }
            SEAM();
        } ++ph;
        if (IN_PH()) { PH_ARGS(); for (int rep = 0; rep < REP_FIX; ++rep) fixup_phase(q, tid, l); SEAM(); } ++ph;
        if (IN_PH()) { PH_ARGS(); if (EN(8)) {
            pg8::Gemm g{(const bf16_t*)(ws + WS_ACT), (const bf16_t*)(ws + WS_WDOWN) + (size_t)l * 1024 * DFF, MT, 1024, DFF}; pg8::StaticOrder S; S.init(MT, 1024, G, (int)blockIdx.x);
            EpiRes E{HB, ssqb + (size_t)(l + 1) * MT};
            S.rep = REP_DOWN; S.epi_all = 1; pg8::gemm_phase<EpiRes, pg8::StaticOrder, true, true>(lds, g, S, E, tid, STAG(STAG_DOWN)); }
            SEAM();
        } ++ph;
    }
    if (IN_PH()) { PH_ARGS(); for (int rep = 0; rep < REP_FIX; ++rep) final_phase(q, tid); } ++ph;
#undef SEAM
#undef IN_PH
}
constexpr int N_PHASES = 26;

#ifndef MK_MULTI
#define MK_MULTI 0
#endif

extern "C" void kernel_launch(void* const* d_in, const int* in_sizes, int n_in, void* d_out, int out_size, void* d_ws, size_t ws_size, hipStream_t stream) {
    static int grid = 0;
    if (grid == 0) {
        if (n_in != 26 || (size_t)out_size != OUT_END || ws_size < WS_END) { fprintf(stderr, "kernel_launch: unexpected sizes n_in %d out %d ws %zu (need %zu)\n", n_in, out_size, ws_size, (size_t)WS_END); grid = -1; return; }
        int dev = 0, cus = 0, per_cu = 0;
        if (hipGetDevice(&dev) != hipSuccess || hipDeviceGetAttribute(&cus, hipDeviceAttributeMultiprocessorCount, dev) != hipSuccess) { grid = -1; return; }
        if (hipFuncSetAttribute((const void*)fwd_kernel, hipFuncAttributeMaxDynamicSharedMemorySize, LDS_BYTES) != hipSuccess) { fprintf(stderr, "kernel_launch: hipFuncSetAttribute failed\n"); grid = -1; return; }
        if (hipOccupancyMaxActiveBlocksPerMultiprocessor(&per_cu, (const void*)fwd_kernel, NTHR, LDS_BYTES) != hipSuccess || per_cu < 1) { fprintf(stderr, "kernel_launch: occupancy query says %d\n", per_cu); per_cu = 1; }
        (void)hipGetLastError();
        grid = cus * 1;
    }
    if (grid < 0) return;
    Args a{};
    for (int i = 0; i < 26; ++i) a.in[i] = (const float*)d_in[i];
    a.out = (float*)d_out; a.ws = (unsigned char*)d_ws;
#if MK_MULTI
    for (int p = 0; p < N_PHASES; ++p) { a.ph_lo = p; a.ph_hi = p + 1; a.coop = 0; hipLaunchKernelGGL(fwd_kernel, dim3(grid), dim3(NTHR), LDS_BYTES, stream, a); }
#else
    a.ph_lo = 0; a.ph_hi = N_PHASES; a.coop = 1;
    if (hipMemsetAsync((char*)d_ws + WS_BAR, 0, BAR_BYTES, stream) != hipSuccess) { fprintf(stderr, "memset failed\n"); return; }
    void* args[] = {&a};
    hipError_t e = hipLaunchCooperativeKernel((const void*)fwd_kernel, dim3(grid), dim3(NTHR), args, LDS_BYTES, stream);
    if (e != hipSuccess) fprintf(stderr, "cooperative launch failed: %s (grid %d)\n", hipGetErrorString(e), grid);
#endif
}
```
